# Optimizing an MI355X kernel written in HIP

```python
import math
import jax
import jax.numpy as jnp
from jax import lax
import numpy as np

D_MODEL = 1024
BATCH = 8
SEQ = 4096
DEPTH = 4

GRID_W = 64
CTX_LEN = 256
N_GROUPS = 4
GROUP_W = D_MODEL // N_GROUPS
MIX_W = N_GROUPS * GROUP_W
N_H = 4
HEAD_DIM = GROUP_W // N_H
ROT_DIM = HEAD_DIM // 2
ROPE_THETA = 10000.0
Q_BLOCK = 128
DIFF_QK = HEAD_DIM // 2
MLA_Q_RANK = D_MODEL // 4
MLA_KV_RANK = D_MODEL // 8
MLA_NOPE = HEAD_DIM
MLA_ROPE = ROT_DIM
GLA_DK = HEAD_DIM // 2
GLA_GATE_RANK = 16
GLA_GATE_NORM = 16.0
RET_DK = HEAD_DIM // 2
CHUNK = 64
FFN_HIDDEN = -(-8 * D_MODEL // (3 * 256)) * 256
RMS_EPS = 1e-6

IN_SIZES = (
    N_H * 2 * DIFF_QK, N_H * 2 * DIFF_QK, N_H * HEAD_DIM,
    MLA_Q_RANK, MLA_KV_RANK, MLA_ROPE,
    N_H * GLA_DK, N_H * GLA_DK, N_H * HEAD_DIM, N_H * HEAD_DIM,
    GLA_GATE_RANK, GLA_GATE_RANK,
    N_H * RET_DK, N_H * RET_DK, N_H * HEAD_DIM, N_H * HEAD_DIM,
)
IN_WIDTH = sum(IN_SIZES)
IN_SPLITS = tuple(int(s) for s in np.cumsum(IN_SIZES)[:-1])

kernel_name = 'hybrid_parallel_group_dit_trunk'


def rms_norm(x, g):
    xf = x.astype(jnp.float32)
    y = xf * lax.rsqrt(jnp.mean(xf * xf, axis=-1, keepdims=True) + RMS_EPS)
    return (y * g.astype(jnp.float32)).astype(x.dtype)


def modulate(h, shift, scale):
    return h * (1.0 + scale) + shift


def axial_rope(rows, rot_dim):
    row = jnp.repeat(jnp.arange(rows, dtype=jnp.float32), GRID_W)
    col = jnp.tile(jnp.arange(GRID_W, dtype=jnp.float32), rows)
    n_freq = rot_dim // 4
    freqs = ROPE_THETA ** (-jnp.arange(n_freq, dtype=jnp.float32) / n_freq)
    ang = jnp.concatenate([row[:, None] * freqs, col[:, None] * freqs], axis=-1)
    return jnp.cos(ang), jnp.sin(ang)


def apply_rope(t, cos, sin):
    t1, t2 = jnp.split(t, 2, axis=-1)
    c, s = cos[:, None, :], sin[:, None, :]
    return jnp.concatenate([t1 * c - t2 * s, t1 * s + t2 * c], axis=-1).astype(t.dtype)


def attend(q, k, v, map_w):
    s = jnp.einsum('bqhmd,bkhmd->bhmqk', q, k).astype(jnp.float32)
    p = jax.nn.softmax(s, axis=-1)
    w = jnp.einsum('bhmqk,mh->bhqk', p, map_w.astype(jnp.float32))
    return jnp.einsum('bhqk,bkhd->bqhd', w.astype(v.dtype), v)


def blocked_attend(q, k, v, map_w):
    B, Lq = q.shape[:2]
    qb = q.reshape((B, Lq // Q_BLOCK, Q_BLOCK) + q.shape[2:]).swapaxes(0, 1)
    ob = lax.map(lambda qi: attend(qi, k, v, map_w), qb)
    return ob.swapaxes(0, 1).reshape((B, Lq) + ob.shape[3:])


def _chunks(t):
    B, L, H, d = t.shape
    return t.reshape(B, L // CHUNK, CHUNK, H, d).transpose(1, 0, 3, 2, 4)


def _unchunk(t):
    n, B, H, C, d = t.shape
    return t.transpose(1, 0, 3, 2, 4).reshape(B, n * C, H, d)


def gla_chunk_scan(q, k, v, log_a, state0):
    causal = jnp.tril(jnp.ones((CHUNK, CHUNK), dtype=bool))[:, :, None]

    def step(S, blk):
        qc, kc, vc, ac = blk
        b = jnp.cumsum(ac, axis=2)
        rel = jnp.where(causal, b[:, :, :, None, :] - b[:, :, None, :, :], -jnp.inf)
        scores = jnp.einsum('bhid,bhjd,bhijd->bhij', qc, kc, jnp.exp(rel))
        b_end = b[:, :, -1:, :]
        o = (jnp.einsum('bhij,bhje->bhie', scores, vc)
             + jnp.einsum('bhid,bhde->bhie', qc * jnp.exp(b), S))
        S_new = (jnp.exp(b_end)[:, :, 0, :, None] * S
                 + jnp.einsum('bhjd,bhje->bhde', kc * jnp.exp(b_end - b), vc))
        return S_new, o

    S_fin, out = lax.scan(step, state0, (_chunks(q), _chunks(k), _chunks(v), _chunks(log_a)))
    return _unchunk(out).astype(v.dtype), S_fin


def retention_chunk_scan(q, k, v, log_gamma, state0):
    pos = jnp.arange(CHUNK, dtype=jnp.float32)
    rel = pos[:, None] - pos[None, :]
    decay_in = jnp.exp(jnp.where(rel >= 0, rel * log_gamma[:, None, None], -jnp.inf))
    decay_q = jnp.exp((pos[None, :] + 1.0) * log_gamma[:, None])[None, :, :, None]
    decay_k = jnp.exp((CHUNK - 1.0 - pos[None, :]) * log_gamma[:, None])[None, :, :, None]
    decay_chunk = jnp.exp(CHUNK * log_gamma)[None, :, None, None]

    def step(S, blk):
        qc, kc, vc = blk
        inner = jnp.einsum('bhid,bhjd->bhij', qc, kc) * decay_in
        o = (jnp.einsum('bhij,bhje->bhie', inner, vc)
             + jnp.einsum('bhid,bhde->bhie', qc, S) * decay_q)
        S_new = decay_chunk * S + jnp.einsum('bhjd,bhje->bhde', kc * decay_k, vc)
        return S_new, o

    S_fin, out = lax.scan(step, state0, (_chunks(q), _chunks(k), _chunks(v)))
    return _unchunk(out).astype(v.dtype), S_fin


def bidirectional_scan(scan, ctx_in, lat_in, with_ctx):
    def rev(t):
        return jnp.flip(t, 1) if t.ndim == 4 else t
    qc, kc, vc, dcf, dcb = ctx_in
    ql, kl, vl, dlf, dlb = lat_in
    s0 = jnp.zeros((qc.shape[0], qc.shape[2], qc.shape[3], vc.shape[3]), jnp.float32)
    oc_f, sc_f = scan(qc, kc, vc, dcf, s0)
    oc_b, sc_b = scan(rev(qc), rev(kc), rev(vc), rev(dcb), s0)
    ol_f, _ = scan(ql, kl, vl, dlf, sc_f)
    ol_b, _ = scan(rev(ql), rev(kl), rev(vl), rev(dlb), sc_b)
    o_ctx = (oc_f + rev(oc_b)) if with_ctx else None
    return o_ctx, ol_f + rev(ol_b)


def diff_attention(p_ctx, p_lat, rope, lam_vecs, sub_g, lambda_init, with_ctx):
    def prep(q, k, v, rotate):
        B, L = q.shape[:2]
        q = q.reshape(B, L, 2 * N_H, DIFF_QK)
        k = k.reshape(B, L, 2 * N_H, DIFF_QK)
        if rotate:
            q, k = apply_rope(q, *rope), apply_rope(k, *rope)
        return (q.reshape(B, L, N_H, 2, DIFF_QK) * DIFF_QK ** -0.5,
                k.reshape(B, L, N_H, 2, DIFF_QK),
                v.reshape(B, L, N_H, HEAD_DIM))

    lq1, lk1, lq2, lk2 = lam_vecs.astype(jnp.float32)
    lam = jnp.exp(jnp.sum(lq1 * lk1)) - jnp.exp(jnp.sum(lq2 * lk2)) + lambda_init
    map_w = jnp.stack([jnp.ones((N_H,), jnp.float32), jnp.broadcast_to(-lam, (N_H,))])

    def finish(o):
        return (rms_norm(o, sub_g) * (1.0 - lambda_init)).reshape(o.shape[0], o.shape[1], GROUP_W)

    qc, kc, vc = prep(*p_ctx, False)
    ql, kl, vl = prep(*p_lat, True)
    o_lat = blocked_attend(ql, jnp.concatenate([kc, kl], 1), jnp.concatenate([vc, vl], 1), map_w)
    o_ctx = finish(attend(qc, kc, vc, map_w)) if with_ctx else None
    return o_ctx, finish(o_lat)


def latent_attention(p_ctx, p_lat, rope, q_g, kv_g, w_uq, w_ukv, with_ctx):
    scale = (MLA_NOPE + MLA_ROPE) ** -0.5

    def prep(q_c, kv_c, k_r, rotate):
        B, L = q_c.shape[:2]
        q = (rms_norm(q_c, q_g) @ w_uq).reshape(B, L, N_H, MLA_NOPE + MLA_ROPE)
        kv = (rms_norm(kv_c, kv_g) @ w_ukv).reshape(B, L, N_H, MLA_NOPE + HEAD_DIM)
        q_nope, q_rope = q[..., :MLA_NOPE], q[..., MLA_NOPE:]
        k_nope, v = kv[..., :MLA_NOPE], kv[..., MLA_NOPE:]
        k_rope = k_r[:, :, None, :]
        if rotate:
            q_rope, k_rope = apply_rope(q_rope, *rope), apply_rope(k_rope, *rope)
        k_rope = jnp.broadcast_to(k_rope, (B, L, N_H, MLA_ROPE))
        q = jnp.concatenate([q_nope, q_rope], -1)[:, :, :, None, :] * scale
        k = jnp.concatenate([k_nope, k_rope], -1)[:, :, :, None, :]
        return q, k, v

    map_w = jnp.ones((1, N_H), jnp.float32)
    qc, kc, vc = prep(*p_ctx, False)
    ql, kl, vl = prep(*p_lat, True)
    o_lat = blocked_attend(ql, jnp.concatenate([kc, kl], 1), jnp.concatenate([vc, vl], 1), map_w)

    def flat(o):
        return o.reshape(o.shape[0], o.shape[1], GROUP_W)
    o_ctx = flat(attend(qc, kc, vc, map_w)) if with_ctx else None
    return o_ctx, flat(o_lat)


def gated_linear_attention(p_ctx, p_lat, w_gate, b_gate, out_g, with_ctx):
    def prep(q, k, v, r, g_f, g_b):
        B, L = q.shape[:2]
        gates = [jax.nn.log_sigmoid((g @ w_gate[d] + b_gate[d]).astype(jnp.float32))
                 .reshape(B, L, N_H, GLA_DK) / GLA_GATE_NORM for d, g in enumerate((g_f, g_b))]
        return (q.reshape(B, L, N_H, GLA_DK) * GLA_DK ** -0.5, k.reshape(B, L, N_H, GLA_DK),
                v.reshape(B, L, N_H, HEAD_DIM), gates[0], gates[1]), r

    def finish(o, r):
        B, L = o.shape[:2]
        return (rms_norm(o, out_g) * jax.nn.silu(r).reshape(B, L, N_H, HEAD_DIM)).reshape(B, L, GROUP_W)

    ctx_in, r_c = prep(*p_ctx)
    lat_in, r_l = prep(*p_lat)
    o_ctx, o_lat = bidirectional_scan(gla_chunk_scan, ctx_in, lat_in, with_ctx)
    return (finish(o_ctx, r_c) if with_ctx else None), finish(o_lat, r_l)


def retention(p_ctx, p_lat, rope, decay_logits, out_g, with_ctx):
    log_gamma = jax.nn.log_sigmoid(decay_logits.astype(jnp.float32))

    def prep(q, k, v, g, rotate):
        B, L = q.shape[:2]
        q = q.reshape(B, L, N_H, RET_DK)
        k = k.reshape(B, L, N_H, RET_DK) * RET_DK ** -0.5
        if rotate:
            q, k = apply_rope(q, *rope), apply_rope(k, *rope)
        return (q, k, v.reshape(B, L, N_H, HEAD_DIM), log_gamma[0], log_gamma[1]), g

    def finish(o, g):
        B, L = o.shape[:2]
        return (rms_norm(o, out_g) * jax.nn.silu(g).reshape(B, L, N_H, HEAD_DIM)).reshape(B, L, GROUP_W)

    ctx_in, g_c = prep(*p_ctx, False)
    lat_in, g_l = prep(*p_lat, True)
    o_ctx, o_lat = bidirectional_scan(retention_chunk_scan, ctx_in, lat_in, with_ctx)
    return (finish(o_ctx, g_c) if with_ctx else None), finish(o_lat, g_l)


def hybrid_mixer(hc, hl, rope, lambda_init, with_ctx, w_in, diff_lam, diff_norm,
                 mla_q_norm, mla_kv_norm, mla_w_uq, mla_w_ukv,
                 gla_w_gate, gla_b_gate, gla_norm, ret_decay, ret_norm, w_out):
    pc = jnp.split(hc @ w_in, IN_SPLITS, axis=-1)
    pl = jnp.split(hl @ w_in, IN_SPLITS, axis=-1)
    dc, dl = diff_attention(pc[0:3], pl[0:3], rope, diff_lam, diff_norm, lambda_init, with_ctx)
    mc, ml = latent_attention(pc[3:6], pl[3:6], rope, mla_q_norm, mla_kv_norm, mla_w_uq, mla_w_ukv, with_ctx)
    gc, gl = gated_linear_attention(pc[6:12], pl[6:12], gla_w_gate, gla_b_gate, gla_norm, with_ctx)
    rc, rl = retention(pc[12:16], pl[12:16], rope, ret_decay, ret_norm, with_ctx)
    out_l = jnp.concatenate([dl, ml, gl, rl], axis=-1) @ w_out
    out_c = (jnp.concatenate([dc, mc, gc, rc], axis=-1) @ w_out) if with_ctx else None
    return out_c, out_l


def swiglu(h, w_in, w_out):
    gate, up = jnp.split(h @ w_in, 2, axis=-1)
    return (jax.nn.silu(gate) * up) @ w_out


def setup_inputs(seed: int = 0) -> dict:
    key = jax.random.key(seed)
    ks = jax.random.split(key, 22)

    def nrm(k, shape, s):
        return jax.random.normal(k, shape, jnp.float32) * s

    eps = 2.0 ** (-5.0 - np.arange(N_H))
    ret_logit = jnp.asarray(np.log((1.0 - eps) / eps).astype(np.float32))
    return {
        'x': nrm(ks[0], (BATCH, SEQ, D_MODEL), 1.0),
        'c': nrm(ks[1], (BATCH, D_MODEL), 1.0),
        'ctx': nrm(ks[2], (BATCH, CTX_LEN, D_MODEL), 1.0),
        'c_ctx': nrm(ks[3], (D_MODEL,), 1.0),
        'ada_w': nrm(ks[4], (DEPTH, D_MODEL, 6 * D_MODEL), 0.5 * D_MODEL ** -0.5),
        'ada_b': nrm(ks[5], (DEPTH, 6 * D_MODEL), 0.02),
        'norm_g': 1.0 + nrm(ks[6], (DEPTH, 4, D_MODEL), 0.02),
        'w_in': nrm(ks[7], (DEPTH, D_MODEL, IN_WIDTH), D_MODEL ** -0.5),
        'diff_lam': nrm(ks[8], (DEPTH, 4, DIFF_QK), 0.1),
        'diff_norm': 1.0 + nrm(ks[9], (DEPTH, HEAD_DIM), 0.02),
        'mla_q_norm': 1.0 + nrm(ks[10], (DEPTH, MLA_Q_RANK), 0.02),
        'mla_kv_norm': 1.0 + nrm(ks[11], (DEPTH, MLA_KV_RANK), 0.02),
        'mla_w_uq': nrm(ks[12], (DEPTH, MLA_Q_RANK, N_H * (MLA_NOPE + MLA_ROPE)), MLA_Q_RANK ** -0.5),
        'mla_w_ukv': nrm(ks[13], (DEPTH, MLA_KV_RANK, N_H * (MLA_NOPE + HEAD_DIM)), MLA_KV_RANK ** -0.5),
        'gla_w_gate': nrm(ks[14], (DEPTH, 2, GLA_GATE_RANK, N_H * GLA_DK), GLA_GATE_RANK ** -0.5),
        'gla_b_gate': nrm(ks[15], (DEPTH, 2, N_H * GLA_DK), 0.1),
        'gla_norm': 1.0 + nrm(ks[16], (DEPTH, HEAD_DIM), 0.02),
        'ret_decay': ret_logit + nrm(ks[17], (DEPTH, 2, N_H), 0.01),
        'ret_norm': 1.0 + nrm(ks[18], (DEPTH, HEAD_DIM), 0.02),
        'w_out': nrm(ks[19], (DEPTH, MIX_W, D_MODEL), MIX_W ** -0.5),
        'ffn_w_in': nrm(ks[20], (DEPTH, D_MODEL, 2 * FFN_HIDDEN), D_MODEL ** -0.5),
        'ffn_w_out': nrm(ks[21], (DEPTH, FFN_HIDDEN, D_MODEL), FFN_HIDDEN ** -0.5),
    }


def reference(x, c, ctx, c_ctx, ada_w, ada_b, norm_g, w_in, diff_lam, diff_norm,
              mla_q_norm, mla_kv_norm, mla_w_uq, mla_w_ukv, gla_w_gate, gla_b_gate,
              gla_norm, ret_decay, ret_norm, w_out, ffn_w_in, ffn_w_out):
    rows = x.shape[1] // GRID_W
    rope = axial_rope(rows, ROT_DIM)
    s_lat = jax.nn.silu(c)
    s_ctx = jax.nn.silu(c_ctx)
    xl, xc = x, ctx
    for l in range(DEPTH):
        with_ctx = l < DEPTH - 1
        lambda_init = 0.8 - 0.6 * math.exp(-0.3 * l)
        mod_l = jnp.split((s_lat @ ada_w[l] + ada_b[l])[:, None, :], 6, axis=-1)
        mod_c = jnp.split(s_ctx @ ada_w[l] + ada_b[l], 6, axis=-1)
        g = norm_g[l]
        hl = modulate(rms_norm(xl, g[0]), mod_l[0], mod_l[1])
        hc = modulate(rms_norm(xc, g[0]), mod_c[0], mod_c[1])
        mc, ml = hybrid_mixer(hc, hl, rope, lambda_init, with_ctx, w_in[l], diff_lam[l], diff_norm[l],
                              mla_q_norm[l], mla_kv_norm[l], mla_w_uq[l], mla_w_ukv[l],
                              gla_w_gate[l], gla_b_gate[l], gla_norm[l], ret_decay[l], ret_norm[l], w_out[l])
        xl = xl + mod_l[2] * rms_norm(ml, g[1])
        hl = modulate(rms_norm(xl, g[2]), mod_l[3], mod_l[4])
        xl = xl + mod_l[5] * rms_norm(swiglu(hl, ffn_w_in[l], ffn_w_out[l]), g[3])
        if with_ctx:
            xc = xc + mod_c[2] * rms_norm(mc, g[1])
            hc = modulate(rms_norm(xc, g[2]), mod_c[3], mod_c[4])
            xc = xc + mod_c[5] * rms_norm(swiglu(hc, ffn_w_in[l], ffn_w_out[l]), g[3])
    return xl
```

```cpp
#include <hip/hip_runtime.h>
#include <hip/hip_cooperative_groups.h>
#include <cstdio>
#include <cstdint>
namespace cg = cooperative_groups;
namespace pg8 {
#define PG8_LAS __attribute__((address_space(3)))
typedef unsigned short bf16_t;
typedef short bf16x8 __attribute__((ext_vector_type(8)));
typedef float f32x4 __attribute__((ext_vector_type(4)));
typedef unsigned u32x4 __attribute__((ext_vector_type(4)));
constexpr int BM = 256, BK = 64, HALF = 128, HTB = HALF * BK * 2  , STAGE_BYTES = 8 * HTB, NXCD = 8, WGM = 8;

__host__ __device__ __forceinline__ int lds_byte(int r, int c) { const int st = (r >> 4) * 2 + (c >> 5), rr = r & 15, cc = c & 31, ob = rr * 64 + cc * 2; return st * 1024 + (ob ^ (((ob >> 9) & 1) << 5)); }
__host__ __device__ __forceinline__ void stage_rc(int b, int& R, int& C) { const int st = b / 1024, sb = b % 1024, swz = sb ^ (((sb >> 9) & 1) << 5); R = (st >> 1) * 16 + swz / 64; C = (st & 1) * 32 + (swz % 64) / 2; }
__host__ __device__ __forceinline__ int perm32(int rho) { const int n = rho >> 4, i = rho & 15; return 8 * (i >> 2) + 4 * n + (i & 3); }

struct Unit { int pm, pn; };
struct Gemm { const bf16_t* A; const bf16_t* Bt; int M, N, K, lda; };

struct StaticOrder {
    int nM, nN, nwg, G, c;
    __host__ __device__ void init(int M, int N, int G_, int c_) { nM = M / BM; nN = N / BM; nwg = nM * nN; G = G_; c = c_; }
    __host__ __device__ bool next(int i, Unit& u) const {
        const long L = (long)i * G + c; if (L >= nwg) return false;
        int wgid = (int)L; { const int q = nwg / NXCD, r = nwg % NXCD, xcd = wgid % NXCD, off = wgid / NXCD; wgid = (xcd < r ? xcd * (q + 1) : r * (q + 1) + (xcd - r) * q) + off; }
        const int nig = WGM * nN, gid = wgid / nig, fm = gid * WGM, gsz = (nM - fm) < WGM ? (nM - fm) : WGM;
        u.pm = fm + ((wgid % nig) % gsz); u.pn = (wgid % nig) / gsz; return true;
    }
    __device__ __forceinline__ void a_ready(const Unit&) const {}
    __device__ __forceinline__ void done(const Unit&) const {}
};

__device__ __forceinline__ unsigned cvt_pk_bf16(float lo, float hi) { unsigned r; asm volatile("v_cvt_pk_bf16_f32 %0, %1, %2" : "=v"(r) : "v"(lo), "v"(hi)); return r; }
typedef float f32x2 __attribute__((ext_vector_type(2)));
template <class Epi, class Sched, bool ALIGN_EPI = false, bool SP2 = false>
__device__ __forceinline__ void gemm_phase(PG8_LAS unsigned char* lds, const Gemm g, const Sched& S, const Epi& E) {
    int tid_ = threadIdx.x; asm volatile("" : "+v"(tid_)); const int tid = tid_, wid = __builtin_amdgcn_readfirstlane(tid >> 6), lane = tid & 63, wr = wid >> 2, wc = wid & 3, fr = lane & 15, fq = lane >> 4;
    const int K = g.K, nt = K / BK;
    unsigned voffA[2], voffB[2];
#pragma unroll
    for (int i = 0; i < 2; ++i) { int R, C; stage_rc(tid * 16 + i * 8192, R, C); const int Rb = Epi::PERM ? ((R & ~31) + perm32(R & 31)) : R;
        voffA[i] = (unsigned)(R * g.lda + C) * 2u; voffB[i] = (unsigned)(Rb * K + C) * 2u; }
    const size_t kstep = (size_t)(BK * 2);
    const size_t hstepB = (size_t)HALF * K * 2, hstepA = (size_t)HALF * g.lda * 2;
    const size_t tstepB = 2 * hstepB, tstepA = 2 * hstepA;
    const unsigned ldsw = (unsigned)wid * 1024u;
    const int aoff = lds_byte(wr * 64 + fr, fq * 8), boff = lds_byte(wc * 32 + fr, fq * 8);
#define PG8_SA(b, h) (((b) * 2 + (h)) * HTB)
#define PG8_SB(b, h) ((4 + (b) * 2 + (h)) * HTB)
#define PG8_STAGE(bufoff, gbase, voff) do { _Pragma("unroll") for (int _i = 0; _i < 2; ++_i) \
        __builtin_amdgcn_global_load_lds((const unsigned*)((const char*)(gbase) + (voff)[_i]), (PG8_LAS unsigned*)(lds + (bufoff) + ldsw + _i * 8192), 16, 0, 0); } while (0)
#define PG8_LDA(dst, b, h) do { _Pragma("unroll") for (int m = 0; m < 4; ++m) _Pragma("unroll") for (int k = 0; k < 2; ++k) dst[m][k] = *(const PG8_LAS bf16x8*)(lds + PG8_SA(b, h) + aoff + m * 2048 + k * 1024); } while (0)
#define PG8_LDB(dst, b, h) do { _Pragma("unroll") for (int n = 0; n < 2; ++n) _Pragma("unroll") for (int k = 0; k < 2; ++k) dst[n][k] = *(const PG8_LAS bf16x8*)(lds + PG8_SB(b, h) + boff + n * 2048 + k * 1024); } while (0)
#define PG8_MMA(ai, bj, At, Bt) do { __builtin_amdgcn_s_setprio(1); _Pragma("unroll") for (int m = 0; m < 4; ++m) _Pragma("unroll") for (int n = 0; n < 2; ++n) _Pragma("unroll") for (int k = 0; k < 2; ++k) \
        acc[ai][bj][m][n] = __builtin_amdgcn_mfma_f32_16x16x32_bf16(Bt[n][k], At[m][k], acc[ai][bj][m][n], 0, 0, 0); __builtin_amdgcn_s_setprio(0); } while (0)
#define PG8_WAIT_V(n) asm volatile("s_waitcnt vmcnt(" #n ")" ::: "memory")
#define PG8_WAIT_L(n) asm volatile("s_waitcnt lgkmcnt(" #n ")" ::: "memory")
#define PG8_BAR __builtin_amdgcn_s_barrier()
#define PG8_SCHED __builtin_amdgcn_sched_barrier(0)
    Unit cur, nxt; int ui = 0;
    if (!S.next(0, cur)) return;
    f32x4 acc[2][2][4][2];
#pragma unroll
    for (int a = 0; a < 2; ++a)
#pragma unroll
        for (int b = 0; b < 2; ++b)
#pragma unroll
            for (int m = 0; m < 4; ++m)
#pragma unroll
                for (int n = 0; n < 2; ++n) acc[a][b][m][n] = (f32x4){0.f, 0.f, 0.f, 0.f};
    bf16x8 At[4][2], B0[2][2], B1[2][2];
    const char* cA = (const char*)g.A + (size_t)cur.pm * tstepA; const char* cB = (const char*)g.Bt + (size_t)cur.pn * tstepB;
    S.a_ready(cur);
    if constexpr (SP2) {
        PG8_STAGE(PG8_SB(0, 0), cB, voffB); PG8_STAGE(PG8_SB(0, 1), cB + hstepB, voffB); PG8_STAGE(PG8_SA(0, 0), cA, voffA); PG8_STAGE(PG8_SA(0, 1), cA + hstepA, voffA);
        if (wr == 1) PG8_BAR;
        PG8_WAIT_V(2); PG8_BAR;
        PG8_STAGE(PG8_SB(1, 0), cB + kstep, voffB); PG8_STAGE(PG8_SA(1, 0), cA + kstep, voffA); PG8_STAGE(PG8_SB(1, 1), cB + hstepB + kstep, voffB);
        PG8_WAIT_V(6); PG8_BAR;
    } else {
        PG8_STAGE(PG8_SB(0, 0), cB, voffB); PG8_STAGE(PG8_SA(0, 0), cA, voffA); PG8_STAGE(PG8_SB(0, 1), cB + hstepB, voffB); PG8_STAGE(PG8_SA(0, 1), cA + hstepA, voffA);
        if (wr == 1) PG8_BAR;
        PG8_WAIT_V(4); PG8_BAR;
        PG8_STAGE(PG8_SB(1, 0), cB + kstep, voffB); PG8_STAGE(PG8_SA(1, 0), cA + kstep, voffA); PG8_STAGE(PG8_SB(1, 1), cB + hstepB + kstep, voffB);
        PG8_WAIT_V(6); PG8_BAR;
    }
    for (;;) {
        const bool has_next = S.next(ui + 1, nxt);
        const char* nA = has_next ? (const char*)g.A + (size_t)nxt.pm * tstepA : cA; const char* nB = has_next ? (const char*)g.Bt + (size_t)nxt.pn * tstepB : cB;
        for (int t = 0; t < nt; t += 2) {
            const bool last = (t == nt - 2);
            const char* a1 = cA + (size_t)(t + 1) * kstep;
            const char* a2 = last ? nA : cA + (size_t)(t + 2) * kstep; const char* b2 = last ? nB : cB + (size_t)(t + 2) * kstep;
            const char* a3 = a2 + kstep; const char* b3 = b2 + kstep;
            if (last && has_next) S.a_ready(nxt);
            if constexpr (SP2) {
            PG8_LDB(B0, 0, 0); PG8_LDB(B1, 0, 1); PG8_SCHED; PG8_LDA(At, 0, 0); PG8_STAGE(PG8_SA(1, 1), a1 + hstepA, voffA);
            PG8_WAIT_V(8); PG8_WAIT_L(0); PG8_BAR; PG8_MMA(0, 0, At, B0); PG8_MMA(0, 1, At, B1); PG8_BAR; PG8_SCHED;
            PG8_LDA(At, 0, 1); PG8_STAGE(PG8_SB(0, 0), b2, voffB); PG8_STAGE(PG8_SB(0, 1), b2 + hstepB, voffB); PG8_STAGE(PG8_SA(0, 0), a2, voffA);
            PG8_WAIT_V(8); PG8_WAIT_L(0); PG8_BAR; PG8_MMA(1, 0, At, B0); PG8_MMA(1, 1, At, B1); PG8_BAR; PG8_SCHED;
            PG8_LDB(B0, 1, 0); PG8_LDB(B1, 1, 1); PG8_SCHED; PG8_LDA(At, 1, 0); PG8_STAGE(PG8_SA(0, 1), a2 + hstepA, voffA);
            PG8_WAIT_V(8); PG8_WAIT_L(0); PG8_BAR; PG8_MMA(0, 0, At, B0); PG8_MMA(0, 1, At, B1); PG8_BAR; PG8_SCHED;
            PG8_LDA(At, 1, 1); PG8_STAGE(PG8_SB(1, 0), b3, voffB); PG8_STAGE(PG8_SB(1, 1), b3 + hstepB, voffB); PG8_STAGE(PG8_SA(1, 0), a3, voffA);
            PG8_WAIT_V(8); PG8_WAIT_L(0); PG8_BAR; PG8_MMA(1, 0, At, B0); PG8_MMA(1, 1, At, B1); PG8_BAR; PG8_SCHED;
            } else {
            PG8_LDB(B0, 0, 0); PG8_SCHED; PG8_LDA(At, 0, 0); PG8_STAGE(PG8_SA(1, 1), a1 + hstepA, voffA);
            PG8_WAIT_L(8); PG8_BAR; PG8_WAIT_L(0); PG8_MMA(0, 0, At, B0); PG8_BAR; PG8_SCHED;
            PG8_LDB(B1, 0, 1); PG8_STAGE(PG8_SB(0, 0), b2, voffB);
            PG8_BAR; PG8_WAIT_L(0); PG8_MMA(0, 1, At, B1); PG8_BAR;
            PG8_LDA(At, 0, 1); PG8_STAGE(PG8_SA(0, 0), a2, voffA);
            PG8_BAR; PG8_WAIT_L(0); PG8_MMA(1, 0, At, B0); PG8_BAR; PG8_SCHED;
            PG8_STAGE(PG8_SB(0, 1), b2 + hstepB, voffB);
            PG8_WAIT_V(6); PG8_BAR; PG8_MMA(1, 1, At, B1); PG8_BAR;
            PG8_LDB(B0, 1, 0); PG8_SCHED; PG8_LDA(At, 1, 0); PG8_STAGE(PG8_SA(0, 1), a2 + hstepA, voffA);
            PG8_WAIT_L(8); PG8_BAR; PG8_WAIT_L(0); PG8_MMA(0, 0, At, B0); PG8_BAR; PG8_SCHED;
            PG8_LDB(B1, 1, 1); PG8_STAGE(PG8_SB(1, 0), b3, voffB);
            PG8_BAR; PG8_WAIT_L(0); PG8_MMA(0, 1, At, B1); PG8_BAR;
            PG8_LDA(At, 1, 1); PG8_STAGE(PG8_SA(1, 0), a3, voffA);
            PG8_BAR; PG8_WAIT_L(0); PG8_MMA(1, 0, At, B0); PG8_BAR; PG8_SCHED;
            PG8_STAGE(PG8_SB(1, 1), b3 + hstepB, voffB);
            PG8_WAIT_V(6); PG8_BAR; PG8_MMA(1, 1, At, B1); PG8_BAR;
            }
        }
        if constexpr (ALIGN_EPI) { if (wr == 0) PG8_BAR; }
        if constexpr (!Epi::AFTER_DRAIN) { E(acc, cur, wr, wc, fr, fq); S.done(cur); }
        if (!has_next) break;
#pragma unroll
        for (int a = 0; a < 2; ++a)
#pragma unroll
            for (int b = 0; b < 2; ++b)
#pragma unroll
                for (int m = 0; m < 4; ++m)
#pragma unroll
                    for (int n = 0; n < 2; ++n) acc[a][b][m][n] = (f32x4){0.f, 0.f, 0.f, 0.f};
        cur = nxt; cA = nA; cB = nB; ++ui;
        if constexpr (ALIGN_EPI) { if (wr == 1) PG8_BAR; }
    }
    PG8_WAIT_V(0);
    if constexpr (!ALIGN_EPI) { if (wr == 0) PG8_BAR; }
    PG8_BAR;
    if constexpr (Epi::AFTER_DRAIN) { E.fused(acc, cur, wr, wc, fr, fq, lds, wid, lane); S.done(cur); }
#undef PG8_SA
#undef PG8_SB
#undef PG8_STAGE
#undef PG8_LDA
#undef PG8_LDB
#undef PG8_MMA
#undef PG8_WAIT_V
#undef PG8_WAIT_L
#undef PG8_BAR
#undef PG8_SCHED
}
}

typedef unsigned short bf16_t;
typedef short bf16x8 __attribute__((ext_vector_type(8)));
typedef short s16x4 __attribute__((ext_vector_type(4)));
typedef float f32x4 __attribute__((ext_vector_type(4)));
typedef float f32x16 __attribute__((ext_vector_type(16)));
typedef unsigned u32x4 __attribute__((ext_vector_type(4)));
typedef unsigned u32x2 __attribute__((ext_vector_type(2)));
typedef float f32x2_t __attribute__((ext_vector_type(2)));
typedef __bf16 bf16x2_t __attribute__((ext_vector_type(2)));
#define DI __device__ __forceinline__
template <class T> DI T* opq2(T* q) { asm volatile("" : "+s"(q)); return q; }
DI int ltid() { int t = threadIdx.x; asm volatile("" : "+v"(t)); return t; }

constexpr int NB = 8, SEQL = 4096, CTXL = 256, DM = 1024, NLAYER = 4;
constexpr int ML = NB * SEQL, MC = NB * CTXL, MT = ML + MC;
constexpr int POSN = SEQL + CTXL;
constexpr int INW = 2752, INWP = 2816, FFH = 2816;
constexpr float EPS = 1e-6f;
constexpr float LOG2E = 1.4426950408889634f;

constexpr size_t OFF_CTL = 0;
constexpr size_t OFF_MODS = 4096;
constexpr size_t OFF_ROPE = OFF_MODS + 884736;
constexpr size_t OFF_STQ = OFF_ROPE + 524288;
constexpr size_t OFF_STKV = OFF_STQ + 1114112;
constexpr size_t OFF_XCTX = OFF_STKV + 557056;
constexpr size_t OFF_W = OFF_XCTX + 8388608;
constexpr size_t W_IN = 0, W_OUT = 5767168, W_F1 = 7864320, W_F2 = 19398656, W_UQ = 25165824, W_UKV = 25427968, W_TOTAL = 25559040;
constexpr size_t OFF_HC = OFF_W + W_TOTAL;
constexpr size_t OFF_PA = OFF_HC + 71303168;
constexpr size_t OFF_Y = OFF_PA + 196083712;
constexpr size_t OFF_MLAQ = OFF_Y + 71303168;
constexpr size_t OFF_MLAK = OFF_MLAQ + 26738688;
constexpr size_t OFF_VT = OFF_MLAK + 17825792;
constexpr size_t VT_TYPE_ELEMS = (size_t)NB * 4 * 64 * POSN;
constexpr size_t WS_END = OFF_VT + 4 * VT_TYPE_ELEMS * 2;
constexpr size_t OFF_BAR = WS_END, WS_END2 = WS_END + 16384;
static_assert(WS_END2 <= 536870912, "workspace map");

#ifndef USE_CG_SYNC
#define USE_CG_SYNC 0
#endif
#ifndef REP_SYNC
#define REP_SYNC 0
#endif
#ifndef REP_C
#define REP_C 1
#endif
#ifndef REP_CONV
#define REP_CONV 1
#endif
#ifndef REP_RP0
#define REP_RP0 0
#endif
#ifndef REP_MIX_ONLY
#define REP_MIX_ONLY 0
#endif
#ifndef REP_MIX
#define REP_MIX 1
#endif
#ifndef REP_GEMM
#define REP_GEMM 1
#endif
#ifndef REP_G3
#define REP_G3 REP_GEMM
#endif
#ifndef REP_G7
#define REP_G7 REP_GEMM
#endif
#ifndef REP_G9
#define REP_G9 REP_GEMM
#endif
#ifndef REP_G10
#define REP_G10 REP_GEMM
#endif
#ifndef PHMASK
#define PHMASK 0xFFFF
#endif
#define PH(k) ((PHMASK >> (k)) & 1)
constexpr int LDS_BYTES = 147456;
constexpr int LDS_CTL_OFF = 131072;

struct Params { const float* in[22]; float* out; unsigned char* ws; };
enum { I_X = 0, I_C, I_CTX, I_CCTX, I_ADAW, I_ADAB, I_NORMG, I_WIN, I_DLAM, I_DNORM, I_MQN, I_MKVN, I_WUQ, I_WUKV, I_GWG, I_GBG, I_GNORM, I_RDEC, I_RNORM, I_WOUT, I_FIN, I_FOUT };

typedef const unsigned char __attribute__((address_space(4)))* kaptr_t;
DI kaptr_t kargs() { kaptr_t ka = (kaptr_t)__builtin_amdgcn_kernarg_segment_ptr(); asm volatile("" : "+s"(ka)); return ka; }
#define KIN(k) (*(const float* const __attribute__((address_space(4)))*)(kargs() + 8 * (k)))
#define KOUT (*(float* const __attribute__((address_space(4)))*)(kargs() + 8 * 22))
#define KWS (*(unsigned char* const __attribute__((address_space(4)))*)(kargs() + 8 * 23))
DI unsigned pk2(float lo, float hi) { f32x2_t v = {lo, hi}; bf16x2_t b = __builtin_convertvector(v, bf16x2_t); return __builtin_bit_cast(unsigned, b); }
DI unsigned f2bf(float f) { return pk2(f, f) & 0xffffu; }
DI float bflo(unsigned w) { return __uint_as_float(w << 16); }
DI float bfhi(unsigned w) { return __uint_as_float(w & 0xffff0000u); }
DI int crow(int i, int h) { return (i & 3) + 8 * (i >> 2) + 4 * h; }
DI float wave_sum(float v) {
#pragma unroll
    for (int o = 1; o < 64; o <<= 1) v += __shfl_xor(v, o);
    return v;
}
DI float silu_f(float x) { return x / (1.f + __expf(-x)); }
DI float logsig_f(float x) { return fminf(x, 0.f) - __logf(1.f + __expf(-fabsf(x))); }
#define LBAR() asm volatile("s_waitcnt lgkmcnt(0)\n\ts_barrier" ::: "memory")
#define MFMA32(a, b, c) __builtin_amdgcn_mfma_f32_32x32x16_bf16((a), (b), (c), 0, 0, 0)

DI void row_bpos(int row, int& b, int& pos) { if (row < ML) { b = row >> 12; pos = CTXL + (row & 4095); } else { const int r = row - ML; b = r >> 8; pos = r & 255; } }
DI int pos_row(int b, int pos) { return pos < CTXL ? ML + b * CTXL + pos : b * SEQL + pos - CTXL; }

namespace pg8 {
struct EpiY {
    static constexpr bool PERM = true, AFTER_DRAIN = false;
    bf16_t* O; int ldc;
    __device__ __forceinline__ void operator()(const f32x4 (&acc)[2][2][4][2], const Unit& u, int wr, int wc, int fr, int fq) const {
        const int row0 = u.pm * BM + wr * 64 + fr, col0 = u.pn * BM + wc * 32 + 8 * fq;
#pragma unroll
        for (int ai = 0; ai < 2; ++ai)
#pragma unroll
            for (int m = 0; m < 4; ++m) { bf16_t* rowp = O + (size_t)(row0 + ai * HALF + m * 16) * ldc + col0;
#pragma unroll
                for (int bj = 0; bj < 2; ++bj) { const f32x4 v0 = acc[ai][bj][m][0], v1 = acc[ai][bj][m][1];
                    u32x4 w; w.x = pk2(v0[0], v0[1]); w.y = pk2(v0[2], v0[3]); w.z = pk2(v1[0], v1[1]); w.w = pk2(v1[2], v1[3]);
                    *(u32x4*)(rowp + bj * HALF) = w; } }
    }
};
struct EpiSwiglu {
    static constexpr bool PERM = true, AFTER_DRAIN = false;
    bf16_t* O;
    __device__ __forceinline__ void operator()(const f32x4 (&acc)[2][2][4][2], const Unit& u, int wr, int wc, int fr, int fq) const {
        const int row0 = u.pm * BM + wr * 64 + fr, col0 = u.pn * HALF + wc * 32 + 8 * fq;
#pragma unroll
        for (int ai = 0; ai < 2; ++ai)
#pragma unroll
            for (int m = 0; m < 4; ++m) { bf16_t* rowp = O + (size_t)(row0 + ai * HALF + m * 16) * FFH + col0;
                float r[8];
#pragma unroll
                for (int n = 0; n < 2; ++n)
#pragma unroll
                    for (int i = 0; i < 4; ++i) { const float g = acc[ai][0][m][n][i], up = acc[ai][1][m][n][i]; r[4 * n + i] = g / (1.f + __expf(-g)) * up; }
                u32x4 w; w.x = pk2(r[0], r[1]); w.y = pk2(r[2], r[3]); w.z = pk2(r[4], r[5]); w.w = pk2(r[6], r[7]);
                *(u32x4*)rowp = w; }
    }
};
DI void rope_pair(f32x4& a, f32x4& b, const float* rc, const float* rs, int row, int fq) {
    if (row < ML) { const int t = row & 4095; const f32x4 c = *(const f32x4*)(rc + t * 16 + 4 * fq), s = *(const f32x4*)(rs + t * 16 + 4 * fq);
        const f32x4 x1 = a, x2 = b; a = x1 * c - x2 * s; b = x1 * s + x2 * c; }
}
DI void store4(bf16_t* p, const f32x4& v) { u32x2 w; w.x = pk2(v[0], v[1]); w.y = pk2(v[2], v[3]); *(u32x2*)p = w; }
DI void store_vt(bf16_t* VT, int type, int hd, int e0, int row, const f32x4& v) {
    int b, pos; row_bpos(row, b, pos);
    pos = (pos & ~12) | ((pos & 4) << 1) | ((pos & 8) >> 1);
    bf16_t* q = VT + ((size_t)((type * NB + b) * 4 + hd) * 64 + e0) * POSN + pos;
#pragma unroll
    for (int i = 0; i < 4; ++i) q[(size_t)i * POSN] = (bf16_t)f2bf(v[i]);
}
DI void store_vt_tile(bf16_t* VT, int type, int hd, int e0, int row0, const f32x4& v0, const f32x4& v1, bf16_t* scr, int fr, int c0, int c1, int lane) {
    const int pr = (fr & ~12) | ((fr & 4) << 1) | ((fr & 8) >> 1);
#pragma unroll
    for (int i = 0; i < 4; ++i) { scr[(c0 + i) * 24 + pr] = (bf16_t)f2bf(v0[i]); scr[(c1 + i) * 24 + pr] = (bf16_t)f2bf(v1[i]); }
    asm volatile("s_waitcnt lgkmcnt(0)" ::: "memory");
    const int col = lane >> 1, half = lane & 1;
    const u32x4 w = *(const u32x4*)(scr + col * 24 + 8 * half);
    int b, pos; row_bpos(row0, b, pos);
    *(u32x4*)(VT + ((size_t)((type * NB + b) * 4 + hd) * 64 + e0 + col) * POSN + pos + 8 * half) = w;
    asm volatile("s_waitcnt lgkmcnt(0)" ::: "memory");
}
struct EpiProj {
    static constexpr bool PERM = true, AFTER_DRAIN = false;
    bf16_t* PROJ; bf16_t* VT; float* stq; float* stkv; const float* rc; const float* rs; unsigned char* scr;
    __device__ __forceinline__ void operator()(const f32x4 (&acc)[2][2][4][2], const Unit& u, int wr, int wc, int fr, int fq) const {
#pragma unroll
        for (int bj = 0; bj < 2; ++bj) {
            const int g = u.pn * 8 + bj * 4 + wc;
            if (g >= 86) continue;
            const int colbase = g * 32;
            int kind = 0; float scale = 1.f; int vtype = 0, vc0 = 0, slot = 0;
            if (g < 8) { kind = 1; scale = 0.17677669529663687f * LOG2E; }
            else if (g < 16) { kind = 1; }
            else if (g < 24) { kind = 2; vtype = 0; vc0 = colbase - 512; }
            else if (g < 32) { kind = 3; slot = g - 24; }
            else if (g < 36) { kind = 4; slot = g - 32; }
            else if (g == 36) { kind = 1; }
            else if (g < 41) { kind = 0; scale = 0.17677669529663687f; }
            else if (g < 45) { kind = 0; }
            else if (g < 53) { kind = 2; vtype = 2; vc0 = colbase - 1440; }
            else if (g < 62) { kind = 0; }
            else if (g < 66) { kind = 1; scale = 0.17677669529663687f; }
            else if (g < 70) { kind = 1; }
            else if (g < 78) { kind = 2; vtype = 3; vc0 = colbase - 2240; }
            else { kind = 0; }
#pragma unroll
            for (int ai = 0; ai < 2; ++ai)
#pragma unroll
                for (int m = 0; m < 4; ++m) {
                    const int row = u.pm * BM + ai * HALF + wr * 64 + m * 16 + fr;
                    f32x4 v0 = acc[ai][bj][m][0], v1 = acc[ai][bj][m][1];
                    if (kind == 1) {
                        f32x4 w0, w1;
#pragma unroll
                        for (int i = 0; i < 4; ++i) { w0[i] = __shfl_xor(v0[i], 32); w1[i] = __shfl_xor(v1[i], 32); }
                        if (row < ML) { const int t = row & 4095; const float* cb = rc + t * 16 + 8 * (fq & 1); const float* sb = rs + t * 16 + 8 * (fq & 1);
                            const f32x4 c0 = *(const f32x4*)cb, c1 = *(const f32x4*)(cb + 4), s0 = *(const f32x4*)sb, s1 = *(const f32x4*)(sb + 4);
                            if (fq < 2) { v0 = v0 * c0 - w0 * s0; v1 = v1 * c1 - w1 * s1; } else { v0 = w0 * s0 + v0 * c0; v1 = w1 * s1 + v1 * c1; } }
                    }
                    v0 = v0 * scale; v1 = v1 * scale;
                    if (kind == 2) {
                        store_vt_tile(VT, vtype, vc0 >> 6, vc0 & 63, row - fr, v0, v1, (bf16_t*)(scr + (wr * 4 + wc) * 1536), fr, 8 * fq, 8 * fq + 4, fr + 16 * fq);
                    } else {
                        { u32x4 ww; ww.x = pk2(v0[0], v0[1]); ww.y = pk2(v0[2], v0[3]); ww.z = pk2(v1[0], v1[1]); ww.w = pk2(v1[2], v1[3]);
                          *(u32x4*)(PROJ + (size_t)row * INWP + colbase + 8 * fq) = ww; }
                        if (kind >= 3) {
                            float ss = (v0[0] * v0[0] + v0[1] * v0[1]) + (v0[2] * v0[2] + v0[3] * v0[3]) + (v1[0] * v1[0] + v1[1] * v1[1]) + (v1[2] * v1[2] + v1[3] * v1[3]);
                            ss += __shfl_xor(ss, 16); ss += __shfl_xor(ss, 32);
                            if (fq == 0) { if (kind == 3) stq[(size_t)row * 8 + slot] = ss; else stkv[(size_t)row * 4 + slot] = ss; }
                        }
                    }
                    asm volatile("" ::: "memory");
                }
        }
    }
};
struct EpiUpQ {
    static constexpr bool PERM = false, AFTER_DRAIN = false;
    bf16_t* MQ; const float* stq; const float* rc; const float* rs;
    __device__ __forceinline__ void operator()(const f32x4 (&acc)[2][2][4][2], const Unit& u, int wr, int wc, int fr, int fq) const {
#pragma unroll
        for (int ai = 0; ai < 2; ++ai)
#pragma unroll
            for (int m = 0; m < 4; ++m) {
                const int row = u.pm * BM + ai * HALF + wr * 64 + m * 16 + fr;
                const f32x4 s0 = *(const f32x4*)(stq + (size_t)row * 8), s1 = *(const f32x4*)(stq + (size_t)row * 8 + 4);
                const float ss = ((s0[0] + s0[1]) + (s0[2] + s0[3])) + ((s1[0] + s1[1]) + (s1[2] + s1[3]));
                const float sc = rsqrtf(ss * (1.f / 256.f) + EPS) * (0.10206207261596575f * LOG2E);
#pragma unroll
                for (int bj = 0; bj < 2; ++bj) {
                    const int g = u.pn * 8 + bj * 4 + wc;
                    if (g >= 12) continue;
                    f32x4 v0 = acc[ai][bj][m][0], v1 = acc[ai][bj][m][1];
                    if ((g % 3) == 2) rope_pair(v0, v1, rc, rs, row, fq);
                    v0 = v0 * sc; v1 = v1 * sc;
                    bf16_t* pp = MQ + (size_t)row * 384 + g * 32 + 4 * fq;
                    store4(pp, v0); store4(pp + 16, v1);
                }
                asm volatile("" ::: "memory");
            }
    }
};
struct EpiUpKV {
    static constexpr bool PERM = false, AFTER_DRAIN = false;
    bf16_t* MK; bf16_t* VT; const float* stkv; unsigned char* scr;
    __device__ __forceinline__ void operator()(const f32x4 (&acc)[2][2][4][2], const Unit& u, int wr, int wc, int fr, int fq) const {
#pragma unroll
        for (int ai = 0; ai < 2; ++ai)
#pragma unroll
            for (int m = 0; m < 4; ++m) {
                const int row = u.pm * BM + ai * HALF + wr * 64 + m * 16 + fr;
                const f32x4 s0 = *(const f32x4*)(stkv + (size_t)row * 4);
                const float sc = rsqrtf(((s0[0] + s0[1]) + (s0[2] + s0[3])) * (1.f / 128.f) + EPS);
#pragma unroll
                for (int bj = 0; bj < 2; ++bj) {
                    const int g = u.pn * 8 + bj * 4 + wc, hd = g >> 2, part = g & 3;
                    const f32x4 v0 = acc[ai][bj][m][0] * sc, v1 = acc[ai][bj][m][1] * sc;
                    if (part < 2) { bf16_t* pp = MK + (size_t)row * 256 + hd * 64 + part * 32 + 4 * fq; store4(pp, v0); store4(pp + 16, v1); }
                    else { store_vt_tile(VT, 1, hd, (part - 2) * 32, row - fr, v0, v1, (bf16_t*)(scr + (wr * 4 + wc) * 1536), fr, 4 * fq, 16 + 4 * fq, fr + 16 * fq); }
                }
                asm volatile("" ::: "memory");
            }
    }
};
}

DI void phase0(const Params& p, unsigned char* lds) {
    const int tid = ltid(); const size_t gt = (size_t)blockIdx.x * 512 + tid, gn = (size_t)gridDim.x * 512;
    if (blockIdx.x == 0) for (int i = tid; i < 1024; i += 512) ((unsigned*)(KWS + OFF_CTL))[i] = 0u;
    float* rc = (float*)(KWS + OFF_ROPE); float* rs = rc + 4096 * 16;
    for (size_t i = gt; i < 65536; i += gn) { const int t = (int)(i >> 4), jj = (int)(i & 15), k = jj & 7;
        const float freq = powf(10000.f, -(float)k * 0.125f); const float pos = jj < 8 ? (float)(t >> 6) : (float)(t & 63); const float a = pos * freq;
        rc[i] = cosf(a); rs[i] = sinf(a); }
    float* S = (float*)lds;
    float* red = S + 9216;
    for (int i = tid; i < 9216; i += 512) { const int r = i >> 10, k = i & 1023; const float c = r < 8 ? KIN(I_C)[r * 1024 + k] : KIN(I_CCTX)[k]; S[i] = c / (1.f + expf(-c)); }
    __syncthreads();
    float* MODS = (float*)(KWS + OFF_MODS);
    for (int item = blockIdx.x; item < 384; item += gridDim.x) {
        const int l = item / 96, n0 = (item % 96) * 64, kg = tid >> 6, c = tid & 63;
        const float* W = KIN(I_ADAW) + (size_t)l * 1024 * 6144 + n0 + c;
        float acc[9];
#pragma unroll
        for (int r = 0; r < 9; ++r) acc[r] = 0.f;
#pragma unroll 8
        for (int kk = 0; kk < 128; ++kk) { const int k = kg * 128 + kk; const float w = __builtin_nontemporal_load(W + (size_t)k * 6144);
#pragma unroll
            for (int r = 0; r < 9; ++r) acc[r] += S[r * 1024 + k] * w; }
#pragma unroll
        for (int r = 0; r < 9; ++r) red[(kg * 9 + r) * 64 + c] = acc[r];
        __syncthreads();
        for (int o = tid; o < 576; o += 512) { const int r = o >> 6, cc = o & 63; float s = 0.f;
#pragma unroll
            for (int k2 = 0; k2 < 8; ++k2) s += red[(k2 * 9 + r) * 64 + cc];
            MODS[(size_t)(l * 9 + r) * 6144 + n0 + cc] = s + KIN(I_ADAB)[l * 6144 + n0 + cc]; }
        __syncthreads();
    }
}

DI void tr_item(const float* W, int K, int N, bf16_t* WT, int k0, int n0, int drow0, const float* kscale, float* scr, int lane) {
#pragma unroll 8
    for (int i = 0; i < 32; ++i) { const int kk = 2 * i + (lane >> 5); float v = __builtin_nontemporal_load(W + (size_t)(k0 + kk) * N + n0 + (lane & 31)); if (kscale) v *= kscale[k0 + kk]; scr[kk * 33 + (lane & 31)] = v; }
    asm volatile("s_waitcnt lgkmcnt(0)" ::: "memory");
    const int c = lane & 7;
#pragma unroll
    for (int j = 0; j < 4; ++j) { const int n = (lane >> 3) + 8 * j; const float* s = scr + (8 * c) * 33 + n;
        u32x4 o; o.x = pk2(s[0 * 33], s[1 * 33]); o.y = pk2(s[2 * 33], s[3 * 33]); o.z = pk2(s[4 * 33], s[5 * 33]); o.w = pk2(s[6 * 33], s[7 * 33]);
        *(u32x4*)(WT + (size_t)(drow0 + n) * K + k0 + 8 * c) = o; }
    asm volatile("s_waitcnt lgkmcnt(0)" ::: "memory");
}
DI void convert_weights(const Params& p, int l, unsigned char* lds) {
    asm volatile("" : "+s"(l));
    const int tid = ltid(), wave = tid >> 6, lane = tid & 63; const int gw = blockIdx.x * 8 + wave, NGW = gridDim.x * 8;
    float* scr = (float*)lds + wave * 2112;
    bf16_t* Wb = (bf16_t*)(KWS + OFF_W);
    bf16_t* WT_IN = Wb + W_IN / 2; bf16_t* WT_OUT = Wb + W_OUT / 2; bf16_t* WT_F1 = Wb + W_F1 / 2; bf16_t* WT_F2 = Wb + W_F2 / 2; bf16_t* WT_UQ = Wb + W_UQ / 2; bf16_t* WT_UKV = Wb + W_UKV / 2;
    for (int it = gw; it < 6192; it += NGW) {
        int r = it;
        if (r < 1376) { tr_item(KIN(I_WIN) + (size_t)l * 1024 * INW, 1024, INW, WT_IN, 64 * (r / 86), 32 * (r % 86), 32 * (r % 86), nullptr, scr, lane); continue; } r -= 1376;
        if (r < 512) { tr_item(KIN(I_WOUT) + (size_t)l * 1024 * 1024, 1024, 1024, WT_OUT, 64 * (r / 32), 32 * (r % 32), 32 * (r % 32), nullptr, scr, lane); continue; } r -= 512;
        if (r < 2816) { const int n0 = 32 * (r % 176); const int j = n0 < FFH ? n0 : n0 - FFH; const int drow = 256 * (j / 128) + (j % 128) + (n0 < FFH ? 0 : 128);
            tr_item(KIN(I_FIN) + (size_t)l * 1024 * 5632, 1024, 5632, WT_F1, 64 * (r / 176), n0, drow, nullptr, scr, lane); continue; } r -= 2816;
        if (r < 1408) { tr_item(KIN(I_FOUT) + (size_t)l * FFH * 1024, FFH, 1024, WT_F2, 64 * (r / 32), 32 * (r % 32), 32 * (r % 32), nullptr, scr, lane); continue; } r -= 1408;
        if (r < 48) { tr_item(KIN(I_WUQ) + (size_t)l * 256 * 384, 256, 384, WT_UQ, 64 * (r / 12), 32 * (r % 12), 32 * (r % 12), KIN(I_MQN) + l * 256, scr, lane); continue; } r -= 48;
        tr_item(KIN(I_WUKV) + (size_t)l * 128 * 512, 128, 512, WT_UKV, 64 * (r / 16), 32 * (r % 16), 32 * (r % 16), KIN(I_MKVN) + l * 128, scr, lane);
    }
    const size_t gt = (size_t)blockIdx.x * 512 + tid, gn = (size_t)gridDim.x * 512; unsigned zz = 0u; asm volatile("" : "+v"(zz)); const u32x4 z = {zz, zz, zz, zz};
    for (size_t i = gt; i < 8192; i += gn) ((u32x4*)(WT_IN + (size_t)INW * 1024))[i] = z;
    for (size_t i = gt; i < 4096; i += gn) ((u32x4*)(WT_UQ + (size_t)384 * 256))[i] = z;
}

DI void rowpass(int row_begin, int row_end, int vblock, int vgrid, const float* xinL, const float* xinC, float* xoutL, float* xoutC, const bf16_t* Y, const float* mgate, const float* gpost,
                bf16_t* H, const float* gpre, const float* mshift, const float* mscale) {
    const int tid = ltid(), wave = tid >> 6, lane = tid & 63; const int gw = vblock * 8 + wave, NGW = vgrid * 8;
    f32x4 vn[4]; u32x2 yn[4];
    auto fetch = [&](int row) {
        const float* xr = row < ML ? xinL + (size_t)row * DM : xinC + (size_t)(row - ML) * DM;
#pragma unroll
        for (int j = 0; j < 4; ++j) vn[j] = __builtin_nontemporal_load((const f32x4*)(xr + 4 * lane + 256 * j));
        if (Y) {
#pragma unroll
            for (int j = 0; j < 4; ++j) yn[j] = __builtin_nontemporal_load((const u32x2*)(Y + (size_t)row * DM + 4 * lane + 256 * j)); }
    };
    int row = row_begin + gw;
    if (row < row_end) fetch(row);
    for (; row < row_end; row += NGW) {
        const int mb = row < ML ? (row >> 12) : 8;
        f32x4 v[4]; u32x2 yw[4];
#pragma unroll
        for (int j = 0; j < 4; ++j) { v[j] = vn[j]; yw[j] = yn[j]; }
        if (row + NGW < row_end) fetch(row + NGW);
        if (Y) {
            f32x4 y[4]; float ss = 0.f;
#pragma unroll
            for (int j = 0; j < 4; ++j) { const u32x2 w = yw[j]; y[j] = (f32x4){bflo(w.x), bfhi(w.x), bflo(w.y), bfhi(w.y)};
                ss += (y[j][0] * y[j][0] + y[j][1] * y[j][1]) + (y[j][2] * y[j][2] + y[j][3] * y[j][3]); }
            const float ry = rsqrtf(wave_sum(ss) * (1.f / DM) + EPS);
            float* xo = row < ML ? xoutL + (size_t)row * DM : xoutC + (size_t)(row - ML) * DM;
#pragma unroll
            for (int j = 0; j < 4; ++j) { const f32x4 gt = *(const f32x4*)(mgate + (size_t)mb * 6144 + 4 * lane + 256 * j), gp = *(const f32x4*)(gpost + 4 * lane + 256 * j);
                v[j] = v[j] + gt * (y[j] * ry * gp); __builtin_nontemporal_store(v[j], (f32x4*)(xo + 4 * lane + 256 * j)); }
        }
        if (H) {
            float ss = 0.f;
#pragma unroll
            for (int j = 0; j < 4; ++j) ss += (v[j][0] * v[j][0] + v[j][1] * v[j][1]) + (v[j][2] * v[j][2] + v[j][3] * v[j][3]);
            const float rx = rsqrtf(wave_sum(ss) * (1.f / DM) + EPS);
#pragma unroll
            for (int j = 0; j < 4; ++j) { const int c = 4 * lane + 256 * j; const f32x4 g = *(const f32x4*)(gpre + c), sh = *(const f32x4*)(mshift + (size_t)mb * 6144 + c), sc = *(const f32x4*)(mscale + (size_t)mb * 6144 + c);
                const f32x4 hv = v[j] * rx * g * (sc + 1.f) + sh; u32x2 w; w.x = pk2(hv[0], hv[1]); w.y = pk2(hv[2], hv[3]); *(u32x2*)(H + (size_t)row * DM + c) = w; }
        }
    }
}

template <int TYPE>
DI void attn_unit(const Params& p, unsigned char* lds, int l, int b, int hd, int qrow0, int NT) {
    asm volatile("" : "+s"(l), "+s"(b), "+s"(hd), "+s"(qrow0), "+s"(NT));
    constexpr int NMAP = TYPE == 0 ? 2 : 1, KS = TYPE == 0 ? 2 : 6, DQ = NMAP * KS * 16, KP = DQ + 8, CPR = DQ / 8;
    constexpr int TK = TYPE == 0 ? 64 : 128, VP = TK + 8, KCH = TK * CPR / 512, VCPR = TK / 8, VCH = 64 * VCPR / 512;
    const int tid = ltid(), lane = tid & 63, w = tid >> 6, r32 = lane & 31, h = lane >> 5;
    bf16_t* Kl = (bf16_t*)lds;
    bf16_t* Vl = (bf16_t*)(lds + 2 * TK * KP * 2);
    const bf16_t* PROJ = (const bf16_t*)(KWS + OFF_PA);
    const bf16_t* MQ = (const bf16_t*)(KWS + OFF_MLAQ);
    const bf16_t* MK = (const bf16_t*)(KWS + OFF_MLAK);
    const bf16_t* VTb = (const bf16_t*)(KWS + OFF_VT) + ((size_t)((TYPE * NB + b) * 4 + hd) * 64) * POSN;
    bf16_t* CC = (bf16_t*)(KWS + OFF_HC);
    bf16x8 qf[NMAP][KS];
    const int qrow = qrow0 + 32 * w + r32;
#pragma unroll
    for (int mp = 0; mp < NMAP; ++mp)
#pragma unroll
        for (int s = 0; s < KS; ++s)
            qf[mp][s] = TYPE == 0 ? *(const bf16x8*)(PROJ + (size_t)qrow * INWP + 64 * hd + mp * 32 + 16 * s + 8 * h)
                                  : *(const bf16x8*)(MQ + (size_t)qrow * 384 + 96 * hd + 16 * s + 8 * h);
    float mrun[NMAP], lsum[NMAP]; f32x16 o[NMAP][2];
#pragma unroll
    for (int mp = 0; mp < NMAP; ++mp) { mrun[mp] = 0.f; lsum[mp] = 0.f;
#pragma unroll
        for (int i = 0; i < 16; ++i) { o[mp][0][i] = 0.f; o[mp][1][i] = 0.f; } }
    u32x4 kreg[KCH], vreg[VCH];
    auto gload = [&](int t) {
#pragma unroll
        for (int i = 0; i < KCH; ++i) { const int c = tid + 512 * i, kr = c / CPR, cc = c % CPR; const int grow = pos_row(b, TK * t + kr);
            if (TYPE == 0) kreg[i] = *(const u32x4*)(PROJ + (size_t)grow * INWP + 256 + 64 * hd + 8 * cc);
            else kreg[i] = cc < 8 ? *(const u32x4*)(MK + (size_t)grow * 256 + 64 * hd + 8 * cc) : *(const u32x4*)(PROJ + (size_t)grow * INWP + 1152 + 8 * (cc - 8)); }
#pragma unroll
        for (int i = 0; i < VCH; ++i) { const int c = tid + 512 * i, e = c / VCPR, jc = c % VCPR; vreg[i] = *(const u32x4*)(VTb + (size_t)e * POSN + TK * t + 8 * jc); }
    };
    auto lstore = [&](int buf) {
#pragma unroll
        for (int i = 0; i < KCH; ++i) { const int c = tid + 512 * i, kr = c / CPR, cc = c % CPR; *(u32x4*)(Kl + (size_t)buf * TK * KP + kr * KP + 8 * cc) = kreg[i]; }
#pragma unroll
        for (int i = 0; i < VCH; ++i) { const int c = tid + 512 * i, e = c / VCPR, jc = c % VCPR; *(u32x4*)(Vl + (size_t)buf * 64 * VP + e * VP + 8 * jc) = vreg[i]; }
    };
    const int NTI = NT * 64 / TK;
    gload(0); lstore(0); __syncthreads();
    bool shifted = false;
    for (int t = 0; t < NTI; ++t) {
        const int buf = t & 1;
        if (t + 1 < NTI) gload(t + 1);
        const bf16_t* Kb = Kl + (size_t)buf * TK * KP; const bf16_t* Vb = Vl + (size_t)buf * 64 * VP;
        bf16x8 pbd[2][4];
        f32x16 a0, a1, b0, b1;
        auto kfrag = [&](int st, int half, int s) { return TYPE == 0 ? *(const bf16x8*)(Kb + (32 * half + r32) * KP + st * 32 + 16 * s + 8 * h)
                                                                       : *(const bf16x8*)(Kb + (64 * st + 32 * half + r32) * KP + 16 * s + 8 * h); };
        auto vfrag = [&](int st, int eb, int s) { return *(const bf16x8*)(Vb + (32 * eb + r32) * VP + (TYPE == 0 ? 0 : 64 * st) + 16 * s + 8 * h); };
        auto sub_ref = [&](f32x16& x0, f32x16& x1, int mi) {
            if (__builtin_expect(shifted, 0)) { asm volatile("" ::: "memory");
#pragma unroll
                for (int i = 0; i < 16; ++i) { x0[i] -= mrun[mi]; x1[i] -= mrun[mi]; } } };
        auto pack8 = [&](const f32x16& x, int base) { u32x4 tt; tt.x = pk2(x[base], x[base + 1]); tt.y = pk2(x[base + 2], x[base + 3]); tt.z = pk2(x[base + 4], x[base + 5]); tt.w = pk2(x[base + 6], x[base + 7]); return __builtin_bit_cast(bf16x8, tt); };
        auto slow = [&](int st, f32x16& x0, f32x16& x1, float& ps) {
            const int mi = TYPE == 0 ? st : 0;
#pragma unroll
            for (int i = 0; i < 16; ++i) { x0[i] = 0.f; x1[i] = 0.f; }
#pragma unroll
            for (int s2 = 0; s2 < KS; ++s2) { x0 = MFMA32(kfrag(st, 0, s2), qf[mi][s2], x0); x1 = MFMA32(kfrag(st, 1, s2), qf[mi][s2], x1); }
            sub_ref(x0, x1, mi);
            float tm = fmaxf(x0[0], x1[0]);
#pragma unroll
            for (int i = 1; i < 16; ++i) tm = fmaxf(tm, fmaxf(x0[i], x1[i]));
            tm = fmaxf(tm, __shfl_xor(tm, 32));
            const bool first = (t == 0) && (TYPE == 0 || st == 0);
            const float dl = first ? tm : fmaxf(tm, 0.f);
            mrun[mi] += dl;
            if (!first) { const float alpha = __builtin_amdgcn_exp2f(-dl); lsum[mi] *= alpha;
#pragma unroll
                for (int i = 0; i < 16; ++i) { o[mi][0][i] *= alpha; o[mi][1][i] *= alpha; } }
            ps = 0.f;
#pragma unroll
            for (int i = 0; i < 16; ++i) { x0[i] = __builtin_amdgcn_exp2f(x0[i] - dl); x1[i] = __builtin_amdgcn_exp2f(x1[i] - dl); ps += x0[i] + x1[i]; }
            shifted = true;
        };
        constexpr int M0 = 0, M1 = TYPE == 0 ? 1 : 0;
#pragma unroll
        for (int i = 0; i < 16; ++i) { a0[i] = 0.f; a1[i] = 0.f; b0[i] = 0.f; b1[i] = 0.f; }
#pragma unroll
        for (int s2 = 0; s2 < KS; ++s2) { a0 = MFMA32(kfrag(0, 0, s2), qf[M0][s2], a0); a1 = MFMA32(kfrag(0, 1, s2), qf[M0][s2], a1); }
        sub_ref(a0, a1, M0);
        float psa = 0.f;
#pragma unroll
        for (int n = 0; n < 2 * KS; ++n) {
            if (n & 1) b1 = MFMA32(kfrag(1, 1, n >> 1), qf[M1][n >> 1], b1); else b0 = MFMA32(kfrag(1, 0, n >> 1), qf[M1][n >> 1], b0);
#pragma unroll
            for (int r = (32 * n) / (2 * KS); r < (32 * (n + 1)) / (2 * KS); ++r) {
                if (r < 16) { a0[r] = __builtin_amdgcn_exp2f(a0[r]); psa += a0[r]; } else { a1[r - 16] = __builtin_amdgcn_exp2f(a1[r - 16]); psa += a1[r - 16]; } }
        }
        {   const bool firstA = (t == 0);
            if (__builtin_expect(__any(!(psa <= 1e13f) || (firstA && psa < 1e-13f)), 0)) slow(0, a0, a1, psa); }
        lsum[M0] += psa;
        pbd[0][0] = pack8(a0, 0); pbd[0][1] = pack8(a0, 8); pbd[0][2] = pack8(a1, 0); pbd[0][3] = pack8(a1, 8);
        sub_ref(b0, b1, M1);
        float psb = 0.f;
#pragma unroll
        for (int eb = 0; eb < 2; ++eb)
#pragma unroll
            for (int s2 = 0; s2 < 4; ++s2) {
                o[M0][eb] = MFMA32(vfrag(0, eb, s2), pbd[0][s2], o[M0][eb]);
                const int q4 = (eb * 4 + s2) * 4;
#pragma unroll
                for (int i = 0; i < 4; ++i) { const int r = q4 + i; if (r < 16) { b0[r] = __builtin_amdgcn_exp2f(b0[r]); psb += b0[r]; } else { b1[r - 16] = __builtin_amdgcn_exp2f(b1[r - 16]); psb += b1[r - 16]; } }
            }
        {   const bool firstB = (t == 0) && TYPE == 0;
            if (__builtin_expect(__any(!(psb <= 1e13f) || (firstB && psb < 1e-13f)), 0)) slow(1, b0, b1, psb); }
        lsum[M1] += psb;
        pbd[1][0] = pack8(b0, 0); pbd[1][1] = pack8(b0, 8); pbd[1][2] = pack8(b1, 0); pbd[1][3] = pack8(b1, 8);
#pragma unroll
        for (int eb = 0; eb < 2; ++eb)
#pragma unroll
            for (int s2 = 0; s2 < 4; ++s2) o[M1][eb] = MFMA32(vfrag(1, eb, s2), pbd[1][s2], o[M1][eb]);
        if (t + 1 < NTI) lstore(buf ^ 1);
        __syncthreads();
    }
    float inv[NMAP];
#pragma unroll
    for (int mp = 0; mp < NMAP; ++mp) { const float lt = lsum[mp] + __shfl_xor(lsum[mp], 32); inv[mp] = 1.f / lt; }
    if (TYPE == 1) {
        bf16_t* op = CC + (size_t)qrow * DM + 256 + 64 * hd;
#pragma unroll
        for (int eb = 0; eb < 2; ++eb)
#pragma unroll
            for (int g = 0; g < 4; ++g) { const f32x4 v = {o[0][eb][4 * g] * inv[0], o[0][eb][4 * g + 1] * inv[0], o[0][eb][4 * g + 2] * inv[0], o[0][eb][4 * g + 3] * inv[0]};
                pg8::store4(op + 32 * eb + 8 * g + 4 * h, v); }
    } else {
        int l2 = l; asm volatile("" : "+s"(l2));
        const float* dl = opq2(KIN(I_DLAM)) + l2 * 128; float d1 = 0.f, d2 = 0.f;
        for (int i = 0; i < 32; ++i) { d1 += dl[i] * dl[32 + i]; d2 += dl[64 + i] * dl[96 + i]; }
        float c08 = 0.8f, c06 = 0.6f; asm volatile("" : "+v"(c08), "+v"(c06));
        const float lam_init = c08 - c06 * __expf(-0.3f * (float)l2);
        const float lam = __expf(d1) - __expf(d2) + lam_init;
        const float* sg = opq2(KIN(I_DNORM)) + l2 * 64;
        float ss = 0.f; const float li1 = lam * inv[NMAP - 1];
#pragma unroll
        for (int eb = 0; eb < 2; ++eb)
#pragma unroll
            for (int i = 0; i < 16; ++i) { const float v = o[0][eb][i] * inv[0] - li1 * o[NMAP - 1][eb][i]; o[0][eb][i] = v; ss += v * v; }
        ss += __shfl_xor(ss, 32);
        const float rn = rsqrtf(ss * (1.f / 64.f) + EPS) * (1.f - lam_init);
        bf16_t* op = CC + (size_t)qrow * DM + 64 * hd;
#pragma unroll
        for (int eb = 0; eb < 2; ++eb)
#pragma unroll
            for (int g = 0; g < 4; ++g) { const int e0 = 32 * eb + 8 * g + 4 * h; const f32x4 gg = *(const f32x4*)(sg + e0);
                const f32x4 v = {o[0][eb][4 * g] * rn * gg[0], o[0][eb][4 * g + 1] * rn * gg[1], o[0][eb][4 * g + 2] * rn * gg[2], o[0][eb][4 * g + 3] * rn * gg[3]};
                pg8::store4(op + e0, v); }
    }
}

DI void scan_unit(const Params& p, unsigned char* lds, int l, int mixer, int b, int hd, int item) {
    asm volatile("" : "+s"(l), "+s"(mixer), "+s"(b), "+s"(hd), "+s"(item));
    const int tid = ltid(), dir = tid >> 8, td = tid & 255, lane = tid & 63, wd = (tid >> 6) & 3, r32 = lane & 31, h = lane >> 5;
    unsigned char* L = lds + dir * 55296;
    bf16_t* QT = (bf16_t*)(L);
    bf16_t* KT = (bf16_t*)(L + 5120);
    bf16_t* KH = (bf16_t*)(L + 10240);
    bf16_t* ST = (bf16_t*)(L + 14848);
    bf16_t* VTt = (bf16_t*)(L + 19968);
    bf16_t* SC = (bf16_t*)(L + 29184);
    float* OL = (float*)(L + 19968);
    float* BB = (float*)(L + 38400);
    float* SEG = (float*)(L + 46592);
    float* BEND = (float*)(L + 47616);
    float* WG = (float*)(L + 47744);
    float* GT = (float*)(L + 49920);
    const bf16_t* PROJ = (const bf16_t*)(KWS + OFF_PA);
    bf16_t* CC = (bf16_t*)(KWS + OFF_HC);
    float* OTMP = (float*)(KWS + OFF_Y) + (size_t)item * 68 * 4096;
    const int qcol = (mixer == 0 ? 1184 : 1984) + 32 * hd, kcol = (mixer == 0 ? 1312 : 2112) + 32 * hd, ogcol = (mixer == 0 ? 1696 : 2496) + 64 * hd;
    const int ccol = 512 + 256 * mixer + 64 * hd;
    const bf16_t* VTb = (const bf16_t*)(KWS + OFF_VT) + ((size_t)(((mixer == 0 ? 2 : 3) * NB + b) * 4 + hd) * 64) * POSN;
    const float* og = (mixer == 0 ? KIN(I_GNORM) : KIN(I_RNORM)) + l * 64;
    float lg = 0.f;
    float ogr[16];
#pragma unroll
    for (int i = 0; i < 16; ++i) ogr[i] = og[16 * (td & 3) + i];
    float wg[16], wb = 0.f;
#pragma unroll
    for (int r = 0; r < 16; ++r) wg[r] = 0.f;
    if (mixer == 0) {
        const float* gw = KIN(I_GWG) + (size_t)((l * 2 + dir) * 16) * 128 + 32 * hd + (td & 31);
#pragma unroll
        for (int r = 0; r < 16; ++r) wg[r] = gw[r * 128];
        wb = KIN(I_GBG)[(l * 2 + dir) * 128 + 32 * hd + (td & 31)];
    } else lg = logsig_f(KIN(I_RDEC)[(l * 2 + dir) * 4 + hd]);
    for (int idx = td; idx < 64 * 40; idx += 256) ST[idx] = 0;
    f32x16 Sacc;
#pragma unroll
    for (int i = 0; i < 16; ++i) Sacc[i] = 0.f;
    u32x4 qreg, kreg, vreg0, vreg1, greg;
    auto chunk_of = [&](int s) { return dir == 0 ? s : (s < 4 ? 3 - s : 71 - s); };
    auto chunk_row0 = [&](int g) { return g < 4 ? ML + b * CTXL + 64 * g : b * SEQL + 64 * (g - 4); };
    auto gload = [&](int s) {
        const int g = chunk_of(s), row0 = chunk_row0(g);
        qreg = *(const u32x4*)(PROJ + (size_t)(row0 + (td >> 2)) * INWP + qcol + 8 * (td & 3));
        kreg = *(const u32x4*)(PROJ + (size_t)(row0 + (td >> 2)) * INWP + kcol + 8 * (td & 3));
        vreg0 = *(const u32x4*)(VTb + (size_t)(td >> 3) * POSN + 64 * g + 8 * (td & 7));
        vreg1 = *(const u32x4*)(VTb + (size_t)(32 + (td >> 3)) * POSN + 64 * g + 8 * (td & 7));
        if (mixer == 0 && td < 128) greg = *(const u32x4*)(PROJ + (size_t)(row0 + (td >> 1)) * INWP + 1952 + 16 * dir + 8 * (td & 1));
    };
    gload(0);
    __syncthreads();
    for (int s = 0; s < 68; ++s) {
        const int g = chunk_of(s), row0 = chunk_row0(g);
        *(u32x4*)(VTt + (td >> 3) * 72 + 8 * (td & 7)) = vreg0;
        *(u32x4*)(VTt + (32 + (td >> 3)) * 72 + 8 * (td & 7)) = vreg1;
        if (mixer == 0 && td < 128) { float* gp = GT + (td >> 1) * 16 + 8 * (td & 1);
            gp[0] = bflo(greg.x); gp[1] = bfhi(greg.x); gp[2] = bflo(greg.y); gp[3] = bfhi(greg.y); gp[4] = bflo(greg.z); gp[5] = bfhi(greg.z); gp[6] = bflo(greg.w); gp[7] = bfhi(greg.w); }
        const u32x4 qc = qreg, kc = kreg;
        if (s + 1 < 68) gload(s + 1);
        const int s_other = dir == 0 ? (g < 4 ? 3 - g : 71 - g) : g;
        const bool fin = s_other < s;
        float* ot = OTMP + (size_t)g * 4096 + (td >> 2) * 64 + 16 * (td & 3);
        f32x4 pf0, pf1, pf2, pf3; u32x4 g0, g1;
        LBAR();
        { const int d = td & 31, seg = td >> 5; float a[8];
          if (mixer == 0) {
#pragma unroll
              for (int i = 0; i < 8; ++i) { const float* gr = GT + (8 * seg + i) * 16;
                  const f32x4 x0 = *(const f32x4*)gr, x1 = *(const f32x4*)(gr + 4), x2 = *(const f32x4*)(gr + 8), x3 = *(const f32x4*)(gr + 12);
                  float acc = wb;
                  acc += x0[0] * wg[0]; acc += x0[1] * wg[1]; acc += x0[2] * wg[2]; acc += x0[3] * wg[3];
                  acc += x1[0] * wg[4]; acc += x1[1] * wg[5]; acc += x1[2] * wg[6]; acc += x1[3] * wg[7];
                  acc += x2[0] * wg[8]; acc += x2[1] * wg[9]; acc += x2[2] * wg[10]; acc += x2[3] * wg[11];
                  acc += x3[0] * wg[12]; acc += x3[1] * wg[13]; acc += x3[2] * wg[14]; acc += x3[3] * wg[15];
                  a[i] = logsig_f(acc) * (1.f / 16.f); }
          } else {
#pragma unroll
              for (int i = 0; i < 8; ++i) a[i] = lg;
          }
          float run = 0.f;
          if (dir == 0) {
#pragma unroll
              for (int i = 0; i < 8; ++i) { run += a[i]; a[i] = run; }
          } else {
#pragma unroll
              for (int i = 7; i >= 0; --i) { run += a[i]; a[i] = run; }
          }
          SEG[seg * 32 + d] = run;
          LBAR();
          float off = 0.f, tot = 0.f;
#pragma unroll
          for (int s2 = 0; s2 < 8; ++s2) { const float sv = SEG[s2 * 32 + d]; tot += sv; if (dir == 0 ? (s2 < seg) : (s2 > seg)) off += sv; }
#pragma unroll
          for (int i = 0; i < 8; ++i) BB[(8 * seg + i) * 32 + d] = a[i] + off;
          if (seg == 0) { BEND[d] = tot; BEND[32 + d] = __expf(tot); } }
        LBAR();
        { const int j = td >> 2, cc = td & 3;
          float qv[8] = {bflo(qc.x), bfhi(qc.x), bflo(qc.y), bfhi(qc.y), bflo(qc.z), bfhi(qc.z), bflo(qc.w), bfhi(qc.w)};
          float kv[8] = {bflo(kc.x), bfhi(kc.x), bflo(kc.y), bfhi(kc.y), bflo(kc.z), bfhi(kc.z), bflo(kc.w), bfhi(kc.w)};
          float k1[8];
#pragma unroll
          for (int i = 0; i < 8; ++i) { const int d = 8 * cc + i; const float bv = BB[j * 32 + d], ee = BEND[32 + d];
              const float eb = __expf(bv), en = __builtin_amdgcn_rcpf(eb); qv[i] *= eb; k1[i] = kv[i] * en; KH[d * 72 + ((j & ~12) | ((j & 4) << 1) | ((j & 8) >> 1))] = (bf16_t)f2bf(kv[i] * (ee * en)); }
          u32x4 wq, wk; wq.x = pk2(qv[0], qv[1]); wq.y = pk2(qv[2], qv[3]); wq.z = pk2(qv[4], qv[5]); wq.w = pk2(qv[6], qv[7]);
          wk.x = pk2(k1[0], k1[1]); wk.y = pk2(k1[2], k1[3]); wk.z = pk2(k1[4], k1[5]); wk.w = pk2(k1[6], k1[7]);
          *(u32x4*)(QT + j * 40 + 8 * cc) = wq; *(u32x4*)(KT + j * 40 + 8 * cc) = wk; }
        __syncthreads();
        if (fin) { pf0 = *(const f32x4*)(ot); pf1 = *(const f32x4*)(ot + 4); pf2 = *(const f32x4*)(ot + 8); pf3 = *(const f32x4*)(ot + 12);
            const bf16_t* gp = PROJ + (size_t)(row0 + (td >> 2)) * INWP + ogcol + 16 * (td & 3); g0 = *(const u32x4*)gp; g1 = *(const u32x4*)(gp + 8); }
        { const int jb = wd >> 1, ib = wd & 1; const bool skip = dir == 0 ? (jb > ib) : (jb < ib);
          f32x16 pa;
#pragma unroll
          for (int i = 0; i < 16; ++i) pa[i] = 0.f;
          if (!skip) {
#pragma unroll
              for (int s2 = 0; s2 < 2; ++s2) { const bf16x8 a = *(const bf16x8*)(KT + (32 * jb + r32) * 40 + 16 * s2 + 8 * h), bq = *(const bf16x8*)(QT + (32 * ib + r32) * 40 + 16 * s2 + 8 * h);
                  pa = MFMA32(a, bq, pa); }
          }
          const int itok = 32 * ib + r32;
#pragma unroll
          for (int gq = 0; gq < 4; ++gq) { f32x4 v;
#pragma unroll
              for (int i = 0; i < 4; ++i) { const int j = 32 * jb + 8 * gq + 4 * h + i; const bool keep = dir == 0 ? (j <= itok) : (j >= itok); v[i] = keep ? pa[4 * gq + i] : 0.f; }
              pg8::store4(SC + itok * 72 + 32 * jb + 16 * (gq >> 1) + 8 * h + 4 * (gq & 1), v); } }
        LBAR();
        f32x16 oacc;
        { const int eb = wd >> 1, ib = wd & 1;
#pragma unroll
          for (int i = 0; i < 16; ++i) oacc[i] = 0.f;
#pragma unroll
          for (int s2 = 0; s2 < 4; ++s2) { const bf16x8 a = *(const bf16x8*)(VTt + (32 * eb + r32) * 72 + 16 * s2 + 8 * h), bb = *(const bf16x8*)(SC + (32 * ib + r32) * 72 + 16 * s2 + 8 * h);
              oacc = MFMA32(a, bb, oacc); }
#pragma unroll
          for (int s2 = 0; s2 < 2; ++s2) { const bf16x8 a = *(const bf16x8*)(ST + (32 * eb + r32) * 40 + 16 * s2 + 8 * h), bb = *(const bf16x8*)(QT + (32 * ib + r32) * 40 + 16 * s2 + 8 * h);
              oacc = MFMA32(a, bb, oacc); }
          if (wd < 2) { const float dec = BEND[32 + r32];
#pragma unroll
              for (int i = 0; i < 16; ++i) Sacc[i] *= dec;
#pragma unroll
              for (int s2 = 0; s2 < 4; ++s2) { const bf16x8 a = *(const bf16x8*)(VTt + (32 * wd + r32) * 72 + 16 * s2 + 8 * h), bb = *(const bf16x8*)(KH + r32 * 72 + 16 * s2 + 8 * h);
                  Sacc = MFMA32(a, bb, Sacc); } } }
        LBAR();
        { const int eb = wd >> 1, ib = wd & 1;
#pragma unroll
          for (int gq = 0; gq < 4; ++gq) *(f32x4*)(OL + (32 * ib + r32) * 68 + 32 * eb + 8 * gq + 4 * h) = (f32x4){oacc[4 * gq], oacc[4 * gq + 1], oacc[4 * gq + 2], oacc[4 * gq + 3]};
          if (wd < 2) {
#pragma unroll
              for (int i = 0; i < 16; ++i) ST[(32 * wd + crow(i, h)) * 40 + r32] = (bf16_t)f2bf(Sacc[i]); } }
        LBAR();
        { const int j = td >> 2, e0 = 16 * (td & 3); float ov[16];
#pragma unroll
          for (int q4 = 0; q4 < 4; ++q4) { const f32x4 v = *(const f32x4*)(OL + j * 68 + e0 + 4 * q4); ov[4 * q4] = v[0]; ov[4 * q4 + 1] = v[1]; ov[4 * q4 + 2] = v[2]; ov[4 * q4 + 3] = v[3]; }
          if (fin) {
              float ss = 0.f;
              const float pv[16] = {pf0[0], pf0[1], pf0[2], pf0[3], pf1[0], pf1[1], pf1[2], pf1[3], pf2[0], pf2[1], pf2[2], pf2[3], pf3[0], pf3[1], pf3[2], pf3[3]};
#pragma unroll
              for (int i = 0; i < 16; ++i) { ov[i] += pv[i]; ss += ov[i] * ov[i]; }
              ss += __shfl_xor(ss, 1); ss += __shfl_xor(ss, 2);
              const float rn = rsqrtf(ss * (1.f / 64.f) + EPS);
              const int row = row0 + j;
              const float gv[16] = {bflo(g0.x), bfhi(g0.x), bflo(g0.y), bfhi(g0.y), bflo(g0.z), bfhi(g0.z), bflo(g0.w), bfhi(g0.w),
                                    bflo(g1.x), bfhi(g1.x), bflo(g1.y), bfhi(g1.y), bflo(g1.z), bfhi(g1.z), bflo(g1.w), bfhi(g1.w)};
              float r[16];
#pragma unroll
              for (int i = 0; i < 16; ++i) r[i] = ov[i] * rn * ogr[i] * silu_f(gv[i]);
              u32x4 w0, w1; w0.x = pk2(r[0], r[1]); w0.y = pk2(r[2], r[3]); w0.z = pk2(r[4], r[5]); w0.w = pk2(r[6], r[7]);
              w1.x = pk2(r[8], r[9]); w1.y = pk2(r[10], r[11]); w1.z = pk2(r[12], r[13]); w1.w = pk2(r[14], r[15]);
              *(u32x4*)(CC + (size_t)row * DM + ccol + e0) = w0; *(u32x4*)(CC + (size_t)row * DM + ccol + e0 + 8) = w1;
          } else {
#pragma unroll
              for (int q4 = 0; q4 < 4; ++q4) *(f32x4*)(ot + 4 * q4) = (f32x4){ov[4 * q4], ov[4 * q4 + 1], ov[4 * q4 + 2], ov[4 * q4 + 3]};
          } }
        LBAR();
    }
    __syncthreads();
}

DI void mixer_phase(const Params& p, unsigned char* lds, int l, int rep) {
    asm volatile("" : "+s"(l));
    const int tid = ltid();
    unsigned* ctr = (unsigned*)(KWS + OFF_CTL) + 64 * (l + 1 + 4 * rep);
    volatile int* s_item = (volatile int*)(lds + LDS_CTL_OFF);
    const bool with_ctx = l < NLAYER - 1;
    const int nitems = 64 + 1024 + (with_ctx ? 64 : 0);
    for (;;) {
        if (tid == 0) *s_item = (int)atomicAdd(ctr, 1u);
        __syncthreads();
        const int it = __builtin_amdgcn_readfirstlane(*s_item);
        __syncthreads();
        if (it >= nitems) break;
        if (rep > 0 && ((REP_MIX_ONLY == 1 && it >= 64) || (REP_MIX_ONLY == 2 && it < 64))) continue;
        if (it < 64) { if (PH(11)) scan_unit(p, lds, l, it >> 5, (it >> 2) & 7, it & 3, it); }
        else { int type, b, hd, qrow0, NT;
            if (it < 64 + 1024) { const int u = it - 64, rem = u & 511, qb = rem & 15; type = u >> 9; b = rem >> 6; hd = (rem >> 4) & 3; qrow0 = b * SEQL + 256 * qb; NT = POSN / 64; }
            else { const int u = it - 1088; type = u >> 5; b = (u >> 2) & 7; hd = u & 3; qrow0 = ML + b * CTXL; NT = CTXL / 64; }
            if (type == 0) { if (PH(12)) attn_unit<0>(p, lds, l, b, hd, qrow0, NT); } else { if (PH(13)) attn_unit<1>(p, lds, l, b, hd, qrow0, NT); } }
    }
}

#define LAS __attribute__((address_space(3)))
#define XB_TMO      128
#define XB_XCNT(j)  (256  + 64 * (j))
#define XB_XSUB(j)  (1280 + 64 * (j))
#define XB_XGEN(j)  (2304 + 64 * (j))
#define XB_TOP      3328
#define XB_TOPGEN   3392
#define XCD_BAR_WORDS 3456
#define XB_SPIN_CAP (1u << 18)

__device__ __forceinline__ unsigned xb_ld(unsigned* p)              { return __hip_atomic_load(p, __ATOMIC_RELAXED, __HIP_MEMORY_SCOPE_AGENT); }
__device__ __forceinline__ unsigned xb_add(unsigned* p, unsigned v) { return __hip_atomic_fetch_add(p, v, __ATOMIC_RELAXED, __HIP_MEMORY_SCOPE_AGENT); }
__device__ __forceinline__ unsigned xb_xcc_id() { return (unsigned)__builtin_amdgcn_s_getreg((3 << 11) | 20) & 0xFu; }
#define XB_SPIN(cond, bar) do { unsigned _sp = 0; while (cond) { __builtin_amdgcn_s_sleep(1); \
    if ((++_sp & 255u) == 0u) { if (xb_ld(&(bar)[XB_TMO])) break; if (_sp > XB_SPIN_CAP) { atomicAdd(&(bar)[XB_TMO], 1u); break; } } } } while (0)

struct XcdBarrier {
    unsigned* bar; unsigned x;
    volatile LAS unsigned* st;
};

__device__ __forceinline__ XcdBarrier xcd_barrier_post(unsigned* bar, volatile LAS unsigned* st) {
    XcdBarrier b; b.bar = bar; b.x = xb_xcc_id(); b.st = st;
    if (threadIdx.x == 0) (void)xb_add(&bar[XB_XCNT(b.x)], 1u);
    return b;
}
__device__ __forceinline__ void xcd_barrier_complete(unsigned* bar, unsigned x, unsigned& nloc, unsigned& nx) {
    const unsigned G = gridDim.x * gridDim.y * gridDim.z;
    unsigned sum, cnt, mine, sp = 0u;
    for (;;) {
        sum = 0u; cnt = 0u; mine = 0u;
#pragma unroll
        for (unsigned j = 0; j < 16; ++j) { const unsigned c = xb_ld(&bar[XB_XCNT(j)]); sum += c; cnt += (c > 0u) ? 1u : 0u; mine = (j == x) ? c : mine; }
        if (sum == G) break;
        __builtin_amdgcn_s_sleep(1);
        if ((++sp & 255u) == 0u) { if (xb_ld(&bar[XB_TMO])) break; if (sp > XB_SPIN_CAP) { atomicAdd(&bar[XB_TMO], 1u); break; } }
    }
    nloc = mine > 0u ? mine : 1u; nx = cnt > 0u ? cnt : 1u;
}

__device__ __forceinline__ void xcd_barrier(const XcdBarrier& b) {
    asm volatile("s_waitcnt vmcnt(0)" ::: "memory");
    __syncthreads();
    if (threadIdx.x == 0) {
        unsigned* bar = b.bar;
        __builtin_amdgcn_s_waitcnt(0);
        unsigned nloc = b.st[0], nx = b.st[1];
        if (nloc == 0u) { xcd_barrier_complete(bar, b.x, nloc, nx); b.st[0] = nloc; b.st[1] = nx; }
        const unsigned old = xb_add(&bar[XB_XSUB(b.x)], 1u);
        const unsigned gen = old / nloc;
        if (old + 1u == (gen + 1u) * nloc) {
            __builtin_amdgcn_fence(__ATOMIC_RELEASE, "agent");
            asm volatile("s_waitcnt vmcnt(0)" ::: "memory");
            const unsigned og = xb_add(&bar[XB_TOP], 1u);
            const unsigned tg = og / nx;
            if (og + 1u == (tg + 1u) * nx) xb_add(&bar[XB_TOPGEN], 1u);
            else XB_SPIN(xb_ld(&bar[XB_TOPGEN]) == tg, bar);
            __builtin_amdgcn_fence(__ATOMIC_ACQUIRE, "agent");
            xb_add(&bar[XB_XGEN(b.x)], 1u);
            asm volatile("s_waitcnt vmcnt(0)" ::: "memory");
        } else {
            XB_SPIN(xb_ld(&bar[XB_XGEN(b.x)]) == gen, bar);
            __builtin_amdgcn_fence(__ATOMIC_ACQUIRE, "agent");
            asm volatile("s_waitcnt vmcnt(0)" ::: "memory");
        }
    }
    __syncthreads();
}

template <class T> DI T* opq(T* q) { asm volatile("" : "+s"(q)); return q; }
__global__ void __launch_bounds__(512, 2) mega(Params p) {
    extern __shared__ __attribute__((aligned(16))) unsigned char lds[];
    cg::grid_group grid = cg::this_grid();
    { volatile LAS unsigned* z = (volatile LAS unsigned*)((LAS unsigned char*)lds + LDS_CTL_OFF); if (threadIdx.x < 16) z[threadIdx.x] = 0u; }
    __syncthreads();
    const XcdBarrier xbar = xcd_barrier_post((unsigned*)(KWS + OFF_BAR), (volatile LAS unsigned*)((LAS unsigned char*)lds + LDS_CTL_OFF + 32));
#if USE_CG_SYNC
#define GSYNC() grid.sync()
#else
#define GSYNC() xcd_barrier(xbar)
#endif
    PG8_LAS unsigned char* lds3 = (PG8_LAS unsigned char*)lds;
    const int G = gridDim.x, c = blockIdx.x;
#define WSB(off) (opq(KWS) + (off))
#define WGT(off) ((bf16_t*)(opq(KWS) + OFF_W + (off)))

    if (PH(0)) phase0(p, lds);
    grid.sync();
#pragma unroll 1
    for (int l = 0; l < NLAYER; ++l) {
        const bool with_ctx = l < NLAYER - 1;
        const int Mrows = with_ctx ? MT : ML;
        if (PH(1)) {
            const float* ng = opq(KIN(I_NORMG)) + (size_t)l * 4 * DM; const float* MODS = (const float*)WSB(OFF_MODS); const float* ml = MODS + (size_t)l * 9 * 6144;
            bf16_t* HC = (bf16_t*)WSB(OFF_HC); float* XC = (float*)WSB(OFF_XCTX); float* outp = opq(KOUT);
            if (l == 0) rowpass(0, MT, c, G, KIN(I_X), KIN(I_CTX), nullptr, nullptr, nullptr, nullptr, nullptr, HC, ng, ml, ml + 1024);
            else {
                if (c < 32) { pg8::Gemm g{(const bf16_t*)WSB(OFF_PA) + (size_t)ML * FFH, WGT(W_F2), MC, DM, FFH, FFH}; pg8::StaticOrder S; S.init(MC, DM, G, c);
                    pg8::EpiY E{(bf16_t*)WSB(OFF_Y) + (size_t)ML * DM, DM};
                    pg8::gemm_phase<pg8::EpiY, pg8::StaticOrder, true, true>(lds3, g, S, E); }
                else rowpass(0, ML, c - 32, G - 32, outp, XC, outp, XC, (const bf16_t*)WSB(OFF_Y), MODS + (size_t)(l - 1) * 9 * 6144 + 5 * 1024, ng - DM, HC, ng, ml, ml + 1024);
                GSYNC();
                rowpass(ML, MT, c, G, outp, XC, outp, XC, (const bf16_t*)WSB(OFF_Y), MODS + (size_t)(l - 1) * 9 * 6144 + 5 * 1024, ng - DM, HC, ng, ml, ml + 1024);
            }
        }
        for (int rep = 0; rep < REP_CONV; ++rep) { if (PH(2)) convert_weights(p, l, lds); }
        for (int rep = 0; rep < REP_RP0; ++rep) { const float* ng = opq(KIN(I_NORMG)); const float* ml = (const float*)WSB(OFF_MODS); rowpass(0, MT, c, G, KIN(I_X), KIN(I_CTX), nullptr, nullptr, nullptr, nullptr, nullptr, (bf16_t*)WSB(OFF_Y), ng, ml, ml + 1024); }
        GSYNC();
        for (int rep = 0; rep < REP_SYNC; ++rep) GSYNC();
        for (int rep = 0; rep < REP_G3; ++rep) { if (rep) GSYNC();
        if (PH(3)) { pg8::Gemm g{(const bf16_t*)WSB(OFF_HC), WGT(W_IN), MT, INWP, DM, DM}; pg8::StaticOrder S; S.init(MT, INWP, G, c);
          const float* rc = (const float*)WSB(OFF_ROPE);
          pg8::EpiProj E{(bf16_t*)WSB(OFF_PA), (bf16_t*)WSB(OFF_VT), (float*)WSB(OFF_STQ), (float*)WSB(OFF_STKV), rc, rc + 4096 * 16, lds + LDS_CTL_OFF + 256};
          pg8::gemm_phase<pg8::EpiProj, pg8::StaticOrder, true, true>(lds3, g, S, E); } }
        GSYNC();
        for (int rep = 0; rep < REP_C; ++rep) {
        if (PH(4)) { int Kq = 256; asm volatile("" : "+s"(Kq)); pg8::Gemm g{(const bf16_t*)WSB(OFF_PA) + 768, WGT(W_UQ), MT, 512, Kq, INWP}; pg8::StaticOrder S; S.init(MT, 512, G, c);
          const float* rc = (const float*)WSB(OFF_ROPE);
          pg8::EpiUpQ E{(bf16_t*)WSB(OFF_MLAQ), (const float*)WSB(OFF_STQ), rc, rc + 4096 * 16};
          pg8::gemm_phase<pg8::EpiUpQ, pg8::StaticOrder, true, true>(lds3, g, S, E); }
        if (PH(5)) { int Kq = 128; asm volatile("" : "+s"(Kq)); pg8::Gemm g{(const bf16_t*)WSB(OFF_PA) + 1024, WGT(W_UKV), MT, 512, Kq, INWP}; pg8::StaticOrder S; S.init(MT, 512, G, (c + G / 2) % G);
          pg8::EpiUpKV E{(bf16_t*)WSB(OFF_MLAK), (bf16_t*)WSB(OFF_VT), (const float*)WSB(OFF_STKV), lds + LDS_CTL_OFF + 256};
          pg8::gemm_phase<pg8::EpiUpKV, pg8::StaticOrder, true, true>(lds3, g, S, E); }
        GSYNC(); }
        for (int rep = 0; rep < REP_MIX; ++rep) { if (PH(6)) mixer_phase(p, lds, l, rep); GSYNC(); }
        for (int rep = 0; rep < REP_G7; ++rep) { if (rep) GSYNC();
        if (PH(7)) { pg8::Gemm g{(const bf16_t*)WSB(OFF_HC), WGT(W_OUT), Mrows, DM, DM, DM}; pg8::StaticOrder S; S.init(Mrows, DM, G, c);
          pg8::EpiY E{(bf16_t*)WSB(OFF_Y), DM};
          pg8::gemm_phase<pg8::EpiY, pg8::StaticOrder, true, true>(lds3, g, S, E); } }
        GSYNC();
        if (PH(8)) {
            const float* ng = opq(KIN(I_NORMG)) + (size_t)l * 4 * DM; const float* ml = (const float*)WSB(OFF_MODS) + (size_t)l * 9 * 6144;
            float* XC = (float*)WSB(OFF_XCTX); float* outp = opq(KOUT);
            rowpass(0, Mrows, c, G, l == 0 ? KIN(I_X) : outp, l == 0 ? KIN(I_CTX) : XC, outp, XC, (const bf16_t*)WSB(OFF_Y), ml + 2 * 1024, ng + DM, (bf16_t*)WSB(OFF_HC), ng + 2 * DM, ml + 3 * 1024, ml + 4 * 1024);
        }
        GSYNC();
        for (int rep = 0; rep < REP_G9; ++rep) { if (rep) GSYNC();
        if (PH(9)) { pg8::Gemm g{(const bf16_t*)WSB(OFF_HC), WGT(W_F1), Mrows, 2 * FFH, DM, DM}; pg8::StaticOrder S; S.init(Mrows, 2 * FFH, G, c);
          pg8::EpiSwiglu E{(bf16_t*)WSB(OFF_PA)};
          pg8::gemm_phase<pg8::EpiSwiglu, pg8::StaticOrder, true, true>(lds3, g, S, E); } }
        GSYNC();
        for (int rep = 0; rep < REP_G10; ++rep) { if (rep) GSYNC();
        if (PH(10)) { pg8::Gemm g{(const bf16_t*)WSB(OFF_PA), WGT(W_F2), ML, DM, FFH, FFH}; pg8::StaticOrder S; S.init(ML, DM, G, c);
          pg8::EpiY E{(bf16_t*)WSB(OFF_Y), DM};
          pg8::gemm_phase<pg8::EpiY, pg8::StaticOrder, true, true>(lds3, g, S, E); } }
        GSYNC();
    }
    { float* XC = (float*)WSB(OFF_XCTX); float* outp = opq(KOUT);
      rowpass(0, ML, c, G, outp, XC, outp, XC, (const bf16_t*)WSB(OFF_Y), (const float*)WSB(OFF_MODS) + (size_t)3 * 9 * 6144 + 5 * 1024, KIN(I_NORMG) + (size_t)3 * 4 * DM + 3 * DM, nullptr, nullptr, nullptr, nullptr); }
}

extern "C" void kernel_launch(void* const* d_in, const int* in_sizes, int n_in, void* d_out, int out_size, void* d_ws, size_t ws_size, hipStream_t stream) {
    static int grid_blocks = 0;
    if (!grid_blocks) {
        if (n_in != 22 || ws_size < WS_END2) { fprintf(stderr, "kernel_launch: unexpected n_in %d or ws_size %zu (need %zu)\n", n_in, ws_size, (size_t)WS_END2); grid_blocks = -1; return; }
        int dev = 0, cus = 0, per_cu = 0;
        (void)hipGetDevice(&dev);
        (void)hipDeviceGetAttribute(&cus, hipDeviceAttributeMultiprocessorCount, dev);
        (void)hipFuncSetAttribute((const void*)mega, hipFuncAttributeMaxDynamicSharedMemorySize, LDS_BYTES);
        (void)hipOccupancyMaxActiveBlocksPerMultiprocessor(&per_cu, (const void*)mega, 512, LDS_BYTES);
        if (per_cu < 1) per_cu = 1;
        grid_blocks = cus * per_cu;
    }
    if (grid_blocks < 0) return;
    (void)hipMemsetAsync((unsigned char*)d_ws + OFF_BAR, 0, 16384, stream);
    Params p{};
    for (int i = 0; i < 22; ++i) p.in[i] = (const float*)d_in[i];
    p.out = (float*)d_out; p.ws = (unsigned char*)d_ws;
    void* args[] = {&p};
    hipError_t e = hipLaunchCooperativeKernel((const void*)mega, dim3(grid_blocks), dim3(512), args, LDS_BYTES, stream);
    if (e != hipSuccess) fprintf(stderr, "cooperative launch failed: %s (grid %d)\n", hipGetErrorString(e), grid_blocks);
}
```

```cpp
#include <hip/hip_runtime.h>
#include <hip/hip_cooperative_groups.h>
#include <cstdio>
#include <cstdint>
namespace cg = cooperative_groups;
namespace pg8 {
#define PG8_LAS __attribute__((address_space(3)))
typedef unsigned short bf16_t;
typedef short bf16x8 __attribute__((ext_vector_type(8)));
typedef float f32x4 __attribute__((ext_vector_type(4)));
typedef unsigned u32x4 __attribute__((ext_vector_type(4)));
constexpr int BM = 256, BK = 64, HALF = 128, HTB = HALF * BK * 2  , STAGE_BYTES = 8 * HTB, NXCD = 8, WGM = 8;

__host__ __device__ __forceinline__ int lds_byte(int r, int c) { const int st = (r >> 4) * 2 + (c >> 5), rr = r & 15, cc = c & 31, ob = rr * 64 + cc * 2; return st * 1024 + (ob ^ (((ob >> 9) & 1) << 5)); }
__host__ __device__ __forceinline__ void stage_rc(int b, int& R, int& C) { const int st = b / 1024, sb = b % 1024, swz = sb ^ (((sb >> 9) & 1) << 5); R = (st >> 1) * 16 + swz / 64; C = (st & 1) * 32 + (swz % 64) / 2; }
__host__ __device__ __forceinline__ int perm32(int rho) { const int n = rho >> 4, i = rho & 15; return 8 * (i >> 2) + 4 * n + (i & 3); }

struct Unit { int pm, pn; };
struct Gemm { const bf16_t* A; const bf16_t* Bt; int M, N, K, lda; };

struct StaticOrder {
    int nM, nN, nwg, G, c;
    __host__ __device__ void init(int M, int N, int G_, int c_) { nM = M / BM; nN = N / BM; nwg = nM * nN; G = G_; c = c_; }
    __host__ __device__ bool next(int i, Unit& u) const {
        const long L = (long)i * G + c; if (L >= nwg) return false;
        int wgid = (int)L; { const int q = nwg / NXCD, r = nwg % NXCD, xcd = wgid % NXCD, off = wgid / NXCD; wgid = (xcd < r ? xcd * (q + 1) : r * (q + 1) + (xcd - r) * q) + off; }
        const int nig = WGM * nN, gid = wgid / nig, fm = gid * WGM, gsz = (nM - fm) < WGM ? (nM - fm) : WGM;
        u.pm = fm + ((wgid % nig) % gsz); u.pn = (wgid % nig) / gsz; return true;
    }
    __device__ __forceinline__ void a_ready(const Unit&) const {}
    __device__ __forceinline__ void done(const Unit&) const {}
};

__device__ __forceinline__ unsigned cvt_pk_bf16(float lo, float hi) { unsigned r; asm volatile("v_cvt_pk_bf16_f32 %0, %1, %2" : "=v"(r) : "v"(lo), "v"(hi)); return r; }
typedef float f32x2 __attribute__((ext_vector_type(2)));
template <class Epi, class Sched, bool ALIGN_EPI = false, bool SP2 = false>
__device__ __forceinline__ void gemm_phase(PG8_LAS unsigned char* lds, const Gemm g, const Sched& S, const Epi& E) {
    int tid_ = threadIdx.x; asm volatile("" : "+v"(tid_)); const int tid = tid_, wid = __builtin_amdgcn_readfirstlane(tid >> 6), lane = tid & 63, wr = wid >> 2, wc = wid & 3, fr = lane & 15, fq = lane >> 4;
    const int K = g.K, nt = K / BK;
    unsigned voffA[2], voffB[2];
#pragma unroll
    for (int i = 0; i < 2; ++i) { int R, C; stage_rc(tid * 16 + i * 8192, R, C); const int Rb = Epi::PERM ? ((R & ~31) + perm32(R & 31)) : R;
        voffA[i] = (unsigned)(R * g.lda + C) * 2u; voffB[i] = (unsigned)(Rb * K + C) * 2u; }
    const size_t kstep = (size_t)(BK * 2);
    const size_t hstepB = (size_t)HALF * K * 2, hstepA = (size_t)HALF * g.lda * 2;
    const size_t tstepB = 2 * hstepB, tstepA = 2 * hstepA;
    const unsigned ldsw = (unsigned)wid * 1024u;
    const int aoff = lds_byte(wr * 64 + fr, fq * 8), boff = lds_byte(wc * 32 + fr, fq * 8);
#define PG8_SA(b, h) (((b) * 2 + (h)) * HTB)
#define PG8_SB(b, h) ((4 + (b) * 2 + (h)) * HTB)
#define PG8_STAGE(bufoff, gbase, voff) do { _Pragma("unroll") for (int _i = 0; _i < 2; ++_i) \
        __builtin_amdgcn_global_load_lds((const unsigned*)((const char*)(gbase) + (voff)[_i]), (PG8_LAS unsigned*)(lds + (bufoff) + ldsw + _i * 8192), 16, 0, 0); } while (0)
#define PG8_LDA(dst, b, h) do { _Pragma("unroll") for (int m = 0; m < 4; ++m) _Pragma("unroll") for (int k = 0; k < 2; ++k) dst[m][k] = *(const PG8_LAS bf16x8*)(lds + PG8_SA(b, h) + aoff + m * 2048 + k * 1024); } while (0)
#define PG8_LDB(dst, b, h) do { _Pragma("unroll") for (int n = 0; n < 2; ++n) _Pragma("unroll") for (int k = 0; k < 2; ++k) dst[n][k] = *(const PG8_LAS bf16x8*)(lds + PG8_SB(b, h) + boff + n * 2048 + k * 1024); } while (0)
#define PG8_MMA(ai, bj, At, Bt) do { __builtin_amdgcn_s_setprio(1); _Pragma("unroll") for (int m = 0; m < 4; ++m) _Pragma("unroll") for (int n = 0; n < 2; ++n) _Pragma("unroll") for (int k = 0; k < 2; ++k) \
        acc[ai][bj][m][n] = __builtin_amdgcn_mfma_f32_16x16x32_bf16(Bt[n][k], At[m][k], acc[ai][bj][m][n], 0, 0, 0); __builtin_amdgcn_s_setprio(0); } while (0)
#define PG8_WAIT_V(n) asm volatile("s_waitcnt vmcnt(" #n ")" ::: "memory")
#define PG8_WAIT_L(n) asm volatile("s_waitcnt lgkmcnt(" #n ")" ::: "memory")
#define PG8_BAR __builtin_amdgcn_s_barrier()
#define PG8_SCHED __builtin_amdgcn_sched_barrier(0)
    Unit cur, nxt; int ui = 0;
    if (!S.next(0, cur)) return;
    f32x4 acc[2][2][4][2];
#pragma unroll
    for (int a = 0; a < 2; ++a)
#pragma unroll
        for (int b = 0; b < 2; ++b)
#pragma unroll
            for (int m = 0; m < 4; ++m)
#pragma unroll
                for (int n = 0; n < 2; ++n) acc[a][b][m][n] = (f32x4){0.f, 0.f, 0.f, 0.f};
    bf16x8 At[4][2], B0[2][2], B1[2][2];
    const char* cA = (const char*)g.A + (size_t)cur.pm * tstepA; const char* cB = (const char*)g.Bt + (size_t)cur.pn * tstepB;
    S.a_ready(cur);
    if constexpr (SP2) {
        PG8_STAGE(PG8_SB(0, 0), cB, voffB); PG8_STAGE(PG8_SB(0, 1), cB + hstepB, voffB); PG8_STAGE(PG8_SA(0, 0), cA, voffA); PG8_STAGE(PG8_SA(0, 1), cA + hstepA, voffA);
        if (wr == 1) PG8_BAR;
        PG8_WAIT_V(2); PG8_BAR;
        PG8_STAGE(PG8_SB(1, 0), cB + kstep, voffB); PG8_STAGE(PG8_SA(1, 0), cA + kstep, voffA); PG8_STAGE(PG8_SB(1, 1), cB + hstepB + kstep, voffB);
        PG8_WAIT_V(6); PG8_BAR;
    } else {
        PG8_STAGE(PG8_SB(0, 0), cB, voffB); PG8_STAGE(PG8_SA(0, 0), cA, voffA); PG8_STAGE(PG8_SB(0, 1), cB + hstepB, voffB); PG8_STAGE(PG8_SA(0, 1), cA + hstepA, voffA);
        if (wr == 1) PG8_BAR;
        PG8_WAIT_V(4); PG8_BAR;
        PG8_STAGE(PG8_SB(1, 0), cB + kstep, voffB); PG8_STAGE(PG8_SA(1, 0), cA + kstep, voffA); PG8_STAGE(PG8_SB(1, 1), cB + hstepB + kstep, voffB);
        PG8_WAIT_V(6); PG8_BAR;
    }
    for (;;) {
        const bool has_next = S.next(ui + 1, nxt);
        const char* nA = has_next ? (const char*)g.A + (size_t)nxt.pm * tstepA : cA; const char* nB = has_next ? (const char*)g.Bt + (size_t)nxt.pn * tstepB : cB;
        for (int t = 0; t < nt; t += 2) {
            const bool last = (t == nt - 2);
            const char* a1 = cA + (size_t)(t + 1) * kstep;
            const char* a2 = last ? nA : cA + (size_t)(t + 2) * kstep; const char* b2 = last ? nB : cB + (size_t)(t + 2) * kstep;
            const char* a3 = a2 + kstep; const char* b3 = b2 + kstep;
            if (last && has_next) S.a_ready(nxt);
            if constexpr (SP2) {
            PG8_LDB(B0, 0, 0); PG8_LDB(B1, 0, 1); PG8_SCHED; PG8_LDA(At, 0, 0); PG8_STAGE(PG8_SA(1, 1), a1 + hstepA, voffA);
            PG8_WAIT_V(8); PG8_WAIT_L(0); PG8_BAR; PG8_MMA(0, 0, At, B0); PG8_MMA(0, 1, At, B1); PG8_BAR; PG8_SCHED;
            PG8_LDA(At, 0, 1); PG8_STAGE(PG8_SB(0, 0), b2, voffB); PG8_STAGE(PG8_SB(0, 1), b2 + hstepB, voffB); PG8_STAGE(PG8_SA(0, 0), a2, voffA);
            PG8_WAIT_V(8); PG8_WAIT_L(0); PG8_BAR; PG8_MMA(1, 0, At, B0); PG8_MMA(1, 1, At, B1); PG8_BAR; PG8_SCHED;
            PG8_LDB(B0, 1, 0); PG8_LDB(B1, 1, 1); PG8_SCHED; PG8_LDA(At, 1, 0); PG8_STAGE(PG8_SA(0, 1), a2 + hstepA, voffA);
            PG8_WAIT_V(8); PG8_WAIT_L(0); PG8_BAR; PG8_MMA(0, 0, At, B0); PG8_MMA(0, 1, At, B1); PG8_BAR; PG8_SCHED;
            PG8_LDA(At, 1, 1); PG8_STAGE(PG8_SB(1, 0), b3, voffB); PG8_STAGE(PG8_SB(1, 1), b3 + hstepB, voffB); PG8_STAGE(PG8_SA(1, 0), a3, voffA);
            PG8_WAIT_V(8); PG8_WAIT_L(0); PG8_BAR; PG8_MMA(1, 0, At, B0); PG8_MMA(1, 1, At, B1); PG8_BAR; PG8_SCHED;
            } else {
            PG8_LDB(B0, 0, 0); PG8_SCHED; PG8_LDA(At, 0, 0); PG8_STAGE(PG8_SA(1, 1), a1 + hstepA, voffA);
            PG8_WAIT_L(8); PG8_BAR; PG8_WAIT_L(0); PG8_MMA(0, 0, At, B0); PG8_BAR; PG8_SCHED;
            PG8_LDB(B1, 0, 1); PG8_STAGE(PG8_SB(0, 0), b2, voffB);
            PG8_BAR; PG8_WAIT_L(0); PG8_MMA(0, 1, At, B1); PG8_BAR;
            PG8_LDA(At, 0, 1); PG8_STAGE(PG8_SA(0, 0), a2, voffA);
            PG8_BAR; PG8_WAIT_L(0); PG8_MMA(1, 0, At, B0); PG8_BAR; PG8_SCHED;
            PG8_STAGE(PG8_SB(0, 1), b2 + hstepB, voffB);
            PG8_WAIT_V(6); PG8_BAR; PG8_MMA(1, 1, At, B1); PG8_BAR;
            PG8_LDB(B0, 1, 0); PG8_SCHED; PG8_LDA(At, 1, 0); PG8_STAGE(PG8_SA(0, 1), a2 + hstepA, voffA);
            PG8_WAIT_L(8); PG8_BAR; PG8_WAIT_L(0); PG8_MMA(0, 0, At, B0); PG8_BAR; PG8_SCHED;
            PG8_LDB(B1, 1, 1); PG8_STAGE(PG8_SB(1, 0), b3, voffB);
            PG8_BAR; PG8_WAIT_L(0); PG8_MMA(0, 1, At, B1); PG8_BAR;
            PG8_LDA(At, 1, 1); PG8_STAGE(PG8_SA(1, 0), a3, voffA);
            PG8_BAR; PG8_WAIT_L(0); PG8_MMA(1, 0, At, B0); PG8_BAR; PG8_SCHED;
            PG8_STAGE(PG8_SB(1, 1), b3 + hstepB, voffB);
            PG8_WAIT_V(6); PG8_BAR; PG8_MMA(1, 1, At, B1); PG8_BAR;
            }
        }
        if constexpr (ALIGN_EPI) { if (wr == 0) PG8_BAR; }
        if constexpr (!Epi::AFTER_DRAIN) { E(acc, cur, wr, wc, fr, fq); S.done(cur); }
        if (!has_next) break;
#pragma unroll
        for (int a = 0; a < 2; ++a)
#pragma unroll
            for (int b = 0; b < 2; ++b)
#pragma unroll
                for (int m = 0; m < 4; ++m)
#pragma unroll
                    for (int n = 0; n < 2; ++n) acc[a][b][m][n] = (f32x4){0.f, 0.f, 0.f, 0.f};
        cur = nxt; cA = nA; cB = nB; ++ui;
        if constexpr (ALIGN_EPI) { if (wr == 1) PG8_BAR; }
    }
    PG8_WAIT_V(0);
    if constexpr (!ALIGN_EPI) { if (wr == 0) PG8_BAR; }
    PG8_BAR;
    if constexpr (Epi::AFTER_DRAIN) { E.fused(acc, cur, wr, wc, fr, fq, lds, wid, lane); S.done(cur); }
#undef PG8_SA
#undef PG8_SB
#undef PG8_STAGE
#undef PG8_LDA
#undef PG8_LDB
#undef PG8_MMA
#undef PG8_WAIT_V
#undef PG8_WAIT_L
#undef PG8_BAR
#undef PG8_SCHED
}
}

typedef unsigned short bf16_t;
typedef short bf16x8 __attribute__((ext_vector_type(8)));
typedef short s16x4 __attribute__((ext_vector_type(4)));
typedef float f32x4 __attribute__((ext_vector_type(4)));
typedef float f32x16 __attribute__((ext_vector_type(16)));
typedef unsigned u32x4 __attribute__((ext_vector_type(4)));
typedef unsigned u32x2 __attribute__((ext_vector_type(2)));
typedef float f32x2_t __attribute__((ext_vector_type(2)));
typedef __bf16 bf16x2_t __attribute__((ext_vector_type(2)));
#define DI __device__ __forceinline__
template <class T> DI T* opq2(T* q) { asm volatile("" : "+s"(q)); return q; }
DI int ltid() { int t = threadIdx.x; asm volatile("" : "+v"(t)); return t; }

constexpr int NB = 8, SEQL = 4096, CTXL = 256, DM = 1024, NLAYER = 4;
constexpr int ML = NB * SEQL, MC = NB * CTXL, MT = ML + MC;
constexpr int POSN = SEQL + CTXL;
constexpr int INW = 2752, INWP = 2816, FFH = 2816;
constexpr float EPS = 1e-6f;
constexpr float LOG2E = 1.4426950408889634f;

constexpr size_t OFF_CTL = 0;
constexpr size_t OFF_MODS = 4096;
constexpr size_t OFF_ROPE = OFF_MODS + 884736;
constexpr size_t OFF_STQ = OFF_ROPE + 524288;
constexpr size_t OFF_STKV = OFF_STQ + 1114112;
constexpr size_t OFF_XCTX = OFF_STKV + 557056;
constexpr size_t OFF_W = OFF_XCTX + 8388608;
constexpr size_t W_IN = 0, W_OUT = 5767168, W_F1 = 7864320, W_F2 = 19398656, W_UQ = 25165824, W_UKV = 25427968, W_TOTAL = 25559040;
constexpr size_t OFF_HC = OFF_W + W_TOTAL;
constexpr size_t OFF_PA = OFF_HC + 71303168;
constexpr size_t OFF_Y = OFF_PA + 196083712;
constexpr size_t OFF_MLAQ = OFF_Y + 71303168;
constexpr size_t OFF_MLAK = OFF_MLAQ + 26738688;
constexpr size_t OFF_VT = OFF_MLAK + 17825792;
constexpr size_t VT_TYPE_ELEMS = (size_t)NB * 4 * 64 * POSN;
constexpr size_t WS_END = OFF_VT + 4 * VT_TYPE_ELEMS * 2;
constexpr size_t OFF_BAR = WS_END, WS_END2 = WS_END + 16384;
static_assert(WS_END2 <= 536870912, "workspace map");

#ifndef USE_CG_SYNC
#define USE_CG_SYNC 0
#endif
#ifndef REP_SYNC
#define REP_SYNC 0
#endif
#ifndef REP_C
#define REP_C 1
#endif
#ifndef REP_CONV
#define REP_CONV 1
#endif
#ifndef REP_RP0
#define REP_RP0 0
#endif
#ifndef REP_MIX_ONLY
#define REP_MIX_ONLY 0
#endif
#ifndef REP_MIX
#define REP_MIX 1
#endif
#ifndef REP_GEMM
#define REP_GEMM 1
#endif
#ifndef REP_G3
#define REP_G3 REP_GEMM
#endif
#ifndef REP_G7
#define REP_G7 REP_GEMM
#endif
#ifndef REP_G9
#define REP_G9 REP_GEMM
#endif
#ifndef REP_G10
#define REP_G10 REP_GEMM
#endif
#ifndef PHMASK
#define PHMASK 0xFFFF
#endif
#define PH(k) ((PHMASK >> (k)) & 1)
constexpr int LDS_BYTES = 147456;
constexpr int LDS_CTL_OFF = 131072;

struct Params { const float* in[22]; float* out; unsigned char* ws; };
enum { I_X = 0, I_C, I_CTX, I_CCTX, I_ADAW, I_ADAB, I_NORMG, I_WIN, I_DLAM, I_DNORM, I_MQN, I_MKVN, I_WUQ, I_WUKV, I_GWG, I_GBG, I_GNORM, I_RDEC, I_RNORM, I_WOUT, I_FIN, I_FOUT };

typedef const unsigned char __attribute__((address_space(4)))* kaptr_t;
DI kaptr_t kargs() { kaptr_t ka = (kaptr_t)__builtin_amdgcn_kernarg_segment_ptr(); asm volatile("" : "+s"(ka)); return ka; }
#define KIN(k) (*(const float* const __attribute__((address_space(4)))*)(kargs() + 8 * (k)))
#define KOUT (*(float* const __attribute__((address_space(4)))*)(kargs() + 8 * 22))
#define KWS (*(unsigned char* const __attribute__((address_space(4)))*)(kargs() + 8 * 23))
DI unsigned pk2(float lo, float hi) { f32x2_t v = {lo, hi}; bf16x2_t b = __builtin_convertvector(v, bf16x2_t); return __builtin_bit_cast(unsigned, b); }
DI unsigned f2bf(float f) { return pk2(f, f) & 0xffffu; }
DI float bflo(unsigned w) { return __uint_as_float(w << 16); }
DI float bfhi(unsigned w) { return __uint_as_float(w & 0xffff0000u); }
DI int crow(int i, int h) { return (i & 3) + 8 * (i >> 2) + 4 * h; }
DI float wave_sum(float v) {
#pragma unroll
    for (int o = 1; o < 64; o <<= 1) v += __shfl_xor(v, o);
    return v;
}
DI float silu_f(float x) { return x / (1.f + __expf(-x)); }
DI float logsig_f(float x) { return fminf(x, 0.f) - __logf(1.f + __expf(-fabsf(x))); }
#define LBAR() asm volatile("s_waitcnt lgkmcnt(0)\n\ts_barrier" ::: "memory")
#define MFMA32(a, b, c) __builtin_amdgcn_mfma_f32_32x32x16_bf16((a), (b), (c), 0, 0, 0)

DI void row_bpos(int row, int& b, int& pos) { if (row < ML) { b = row >> 12; pos = CTXL + (row & 4095); } else { const int r = row - ML; b = r >> 8; pos = r & 255; } }
DI int pos_row(int b, int pos) { return pos < CTXL ? ML + b * CTXL + pos : b * SEQL + pos - CTXL; }

namespace pg8 {
struct EpiY {
    static constexpr bool PERM = true, AFTER_DRAIN = false;
    bf16_t* O; int ldc;
    __device__ __forceinline__ void operator()(const f32x4 (&acc)[2][2][4][2], const Unit& u, int wr, int wc, int fr, int fq) const {
        const int row0 = u.pm * BM + wr * 64 + fr, col0 = u.pn * BM + wc * 32 + 8 * fq;
#pragma unroll
        for (int ai = 0; ai < 2; ++ai)
#pragma unroll
            for (int m = 0; m < 4; ++m) { bf16_t* rowp = O + (size_t)(row0 + ai * HALF + m * 16) * ldc + col0;
#pragma unroll
                for (int bj = 0; bj < 2; ++bj) { const f32x4 v0 = acc[ai][bj][m][0], v1 = acc[ai][bj][m][1];
                    u32x4 w; w.x = pk2(v0[0], v0[1]); w.y = pk2(v0[2], v0[3]); w.z = pk2(v1[0], v1[1]); w.w = pk2(v1[2], v1[3]);
                    *(u32x4*)(rowp + bj * HALF) = w; } }
    }
};
struct EpiSwiglu {
    static constexpr bool PERM = true, AFTER_DRAIN = false;
    bf16_t* O;
    __device__ __forceinline__ void operator()(const f32x4 (&acc)[2][2][4][2], const Unit& u, int wr, int wc, int fr, int fq) const {
        const int row0 = u.pm * BM + wr * 64 + fr, col0 = u.pn * HALF + wc * 32 + 8 * fq;
#pragma unroll
        for (int ai = 0; ai < 2; ++ai)
#pragma unroll
            for (int m = 0; m < 4; ++m) { bf16_t* rowp = O + (size_t)(row0 + ai * HALF + m * 16) * FFH + col0;
                float r[8];
#pragma unroll
                for (int n = 0; n < 2; ++n)
#pragma unroll
                    for (int i = 0; i < 4; ++i) { const float g = acc[ai][0][m][n][i], up = acc[ai][1][m][n][i]; r[4 * n + i] = g / (1.f + __expf(-g)) * up; }
                u32x4 w; w.x = pk2(r[0], r[1]); w.y = pk2(r[2], r[3]); w.z = pk2(r[4], r[5]); w.w = pk2(r[6], r[7]);
                *(u32x4*)rowp = w; }
    }
};
DI void rope_pair(f32x4& a, f32x4& b, const float* rc, const float* rs, int row, int fq) {
    if (row < ML) { const int t = row & 4095; const f32x4 c = *(const f32x4*)(rc + t * 16 + 4 * fq), s = *(const f32x4*)(rs + t * 16 + 4 * fq);
        const f32x4 x1 = a, x2 = b; a = x1 * c - x2 * s; b = x1 * s + x2 * c; }
}
DI void store4(bf16_t* p, const f32x4& v) { u32x2 w; w.x = pk2(v[0], v[1]); w.y = pk2(v[2], v[3]); *(u32x2*)p = w; }
DI void store_vt(bf16_t* VT, int type, int hd, int e0, int row, const f32x4& v) {
    int b, pos; row_bpos(row, b, pos);
    pos = (pos & ~12) | ((pos & 4) << 1) | ((pos & 8) >> 1);
    bf16_t* q = VT + ((size_t)((type * NB + b) * 4 + hd) * 64 + e0) * POSN + pos;
#pragma unroll
    for (int i = 0; i < 4; ++i) q[(size_t)i * POSN] = (bf16_t)f2bf(v[i]);
}
DI void store_vt_tile(bf16_t* VT, int type, int hd, int e0, int row0, const f32x4& v0, const f32x4& v1, bf16_t* scr, int fr, int c0, int c1, int lane) {
    const int pr = (fr & ~12) | ((fr & 4) << 1) | ((fr & 8) >> 1);
#pragma unroll
    for (int i = 0; i < 4; ++i) { scr[(c0 + i) * 24 + pr] = (bf16_t)f2bf(v0[i]); scr[(c1 + i) * 24 + pr] = (bf16_t)f2bf(v1[i]); }
    asm volatile("s_waitcnt lgkmcnt(0)" ::: "memory");
    const int col = lane >> 1, half = lane & 1;
    const u32x4 w = *(const u32x4*)(scr + col * 24 + 8 * half);
    int b, pos; row_bpos(row0, b, pos);
    *(u32x4*)(VT + ((size_t)((type * NB + b) * 4 + hd) * 64 + e0 + col) * POSN + pos + 8 * half) = w;
    asm volatile("s_waitcnt lgkmcnt(0)" ::: "memory");
}
struct EpiProj {
    static constexpr bool PERM = true, AFTER_DRAIN = false;
    bf16_t* PROJ; bf16_t* VT; float* stq; float* stkv; const float* rc; const float* rs; unsigned char* scr;
    __device__ __forceinline__ void operator()(const f32x4 (&acc)[2][2][4][2], const Unit& u, int wr, int wc, int fr, int fq) const {
#pragma unroll
        for (int bj = 0; bj < 2; ++bj) {
            const int g = u.pn * 8 + bj * 4 + wc;
            if (g >= 86) continue;
            const int colbase = g * 32;
            int kind = 0; float scale = 1.f; int vtype = 0, vc0 = 0, slot = 0;
            if (g < 8) { kind = 1; scale = 0.17677669529663687f * LOG2E; }
            else if (g < 16) { kind = 1; }
            else if (g < 24) { kind = 2; vtype = 0; vc0 = colbase - 512; }
            else if (g < 32) { kind = 3; slot = g - 24; }
            else if (g < 36) { kind = 4; slot = g - 32; }
            else if (g == 36) { kind = 1; }
            else if (g < 41) { kind = 0; scale = 0.17677669529663687f; }
            else if (g < 45) { kind = 0; }
            else if (g < 53) { kind = 2; vtype = 2; vc0 = colbase - 1440; }
            else if (g < 62) { kind = 0; }
            else if (g < 66) { kind = 1; scale = 0.17677669529663687f; }
            else if (g < 70) { kind = 1; }
            else if (g < 78) { kind = 2; vtype = 3; vc0 = colbase - 2240; }
            else { kind = 0; }
#pragma unroll
            for (int ai = 0; ai < 2; ++ai)
#pragma unroll
                for (int m = 0; m < 4; ++m) {
                    const int row = u.pm * BM + ai * HALF + wr * 64 + m * 16 + fr;
                    f32x4 v0 = acc[ai][bj][m][0], v1 = acc[ai][bj][m][1];
                    if (kind == 1) {
                        f32x4 w0, w1;
#pragma unroll
                        for (int i = 0; i < 4; ++i) { w0[i] = __shfl_xor(v0[i], 32); w1[i] = __shfl_xor(v1[i], 32); }
                        if (row < ML) { const int t = row & 4095; const float* cb = rc + t * 16 + 8 * (fq & 1); const float* sb = rs + t * 16 + 8 * (fq & 1);
                            const f32x4 c0 = *(const f32x4*)cb, c1 = *(const f32x4*)(cb + 4), s0 = *(const f32x4*)sb, s1 = *(const f32x4*)(sb + 4);
                            if (fq < 2) { v0 = v0 * c0 - w0 * s0; v1 = v1 * c1 - w1 * s1; } else { v0 = w0 * s0 + v0 * c0; v1 = w1 * s1 + v1 * c1; } }
                    }
                    v0 = v0 * scale; v1 = v1 * scale;
                    if (kind == 2) {
                        store_vt_tile(VT, vtype, vc0 >> 6, vc0 & 63, row - fr, v0, v1, (bf16_t*)(scr + (wr * 4 + wc) * 1536), fr, 8 * fq, 8 * fq + 4, fr + 16 * fq);
                    } else {
                        { u32x4 ww; ww.x = pk2(v0[0], v0[1]); ww.y = pk2(v0[2], v0[3]); ww.z = pk2(v1[0], v1[1]); ww.w = pk2(v1[2], v1[3]);
                          *(u32x4*)(PROJ + (size_t)row * INWP + colbase + 8 * fq) = ww; }
                        if (kind >= 3) {
                            float ss = (v0[0] * v0[0] + v0[1] * v0[1]) + (v0[2] * v0[2] + v0[3] * v0[3]) + (v1[0] * v1[0] + v1[1] * v1[1]) + (v1[2] * v1[2] + v1[3] * v1[3]);
                            ss += __shfl_xor(ss, 16); ss += __shfl_xor(ss, 32);
                            if (fq == 0) { if (kind == 3) stq[(size_t)row * 8 + slot] = ss; else stkv[(size_t)row * 4 + slot] = ss; }
                        }
                    }
                }
        }
    }
};
struct EpiUpQ {
    static constexpr bool PERM = false, AFTER_DRAIN = false;
    bf16_t* MQ; const float* stq; const float* rc; const float* rs;
    __device__ __forceinline__ void operator()(const f32x4 (&acc)[2][2][4][2], const Unit& u, int wr, int wc, int fr, int fq) const {
#pragma unroll
        for (int ai = 0; ai < 2; ++ai)
#pragma unroll
            for (int m = 0; m < 4; ++m) {
                const int row = u.pm * BM + ai * HALF + wr * 64 + m * 16 + fr;
                const f32x4 s0 = *(const f32x4*)(stq + (size_t)row * 8), s1 = *(const f32x4*)(stq + (size_t)row * 8 + 4);
                const float ss = ((s0[0] + s0[1]) + (s0[2] + s0[3])) + ((s1[0] + s1[1]) + (s1[2] + s1[3]));
                const float sc = rsqrtf(ss * (1.f / 256.f) + EPS) * (0.10206207261596575f * LOG2E);
#pragma unroll
                for (int bj = 0; bj < 2; ++bj) {
                    const int g = u.pn * 8 + bj * 4 + wc;
                    if (g >= 12) continue;
                    f32x4 v0 = acc[ai][bj][m][0], v1 = acc[ai][bj][m][1];
                    if ((g % 3) == 2) rope_pair(v0, v1, rc, rs, row, fq);
                    v0 = v0 * sc; v1 = v1 * sc;
                    bf16_t* pp = MQ + (size_t)row * 384 + g * 32 + 4 * fq;
                    store4(pp, v0); store4(pp + 16, v1);
                }
                asm volatile("" ::: "memory");
            }
    }
};
struct EpiUpKV {
    static constexpr bool PERM = false, AFTER_DRAIN = false;
    bf16_t* MK; bf16_t* VT; const float* stkv; unsigned char* scr;
    __device__ __forceinline__ void operator()(const f32x4 (&acc)[2][2][4][2], const Unit& u, int wr, int wc, int fr, int fq) const {
#pragma unroll
        for (int ai = 0; ai < 2; ++ai)
#pragma unroll
            for (int m = 0; m < 4; ++m) {
                const int row = u.pm * BM + ai * HALF + wr * 64 + m * 16 + fr;
                const f32x4 s0 = *(const f32x4*)(stkv + (size_t)row * 4);
                const float sc = rsqrtf(((s0[0] + s0[1]) + (s0[2] + s0[3])) * (1.f / 128.f) + EPS);
#pragma unroll
                for (int bj = 0; bj < 2; ++bj) {
                    const int g = u.pn * 8 + bj * 4 + wc, hd = g >> 2, part = g & 3;
                    const f32x4 v0 = acc[ai][bj][m][0] * sc, v1 = acc[ai][bj][m][1] * sc;
                    if (part < 2) { bf16_t* pp = MK + (size_t)row * 256 + hd * 64 + part * 32 + 4 * fq; store4(pp, v0); store4(pp + 16, v1); }
                    else { store_vt_tile(VT, 1, hd, (part - 2) * 32, row - fr, v0, v1, (bf16_t*)(scr + (wr * 4 + wc) * 1536), fr, 4 * fq, 16 + 4 * fq, fr + 16 * fq); }
                }
                asm volatile("" ::: "memory");
            }
    }
};
}

DI void phase0(const Params& p, unsigned char* lds) {
    const int tid = ltid(); const size_t gt = (size_t)blockIdx.x * 512 + tid, gn = (size_t)gridDim.x * 512;
    if (blockIdx.x == 0) for (int i = tid; i < 1024; i += 512) ((unsigned*)(KWS + OFF_CTL))[i] = 0u;
    float* rc = (float*)(KWS + OFF_ROPE); float* rs = rc + 4096 * 16;
    for (size_t i = gt; i < 65536; i += gn) { const int t = (int)(i >> 4), jj = (int)(i & 15), k = jj & 7;
        const float freq = powf(10000.f, -(float)k * 0.125f); const float pos = jj < 8 ? (float)(t >> 6) : (float)(t & 63); const float a = pos * freq;
        rc[i] = cosf(a); rs[i] = sinf(a); }
    float* S = (float*)lds;
    float* red = S + 9216;
    for (int i = tid; i < 9216; i += 512) { const int r = i >> 10, k = i & 1023; const float c = r < 8 ? KIN(I_C)[r * 1024 + k] : KIN(I_CCTX)[k]; S[i] = c / (1.f + expf(-c)); }
    __syncthreads();
    float* MODS = (float*)(KWS + OFF_MODS);
    for (int item = blockIdx.x; item < 384; item += gridDim.x) {
        const int l = item / 96, n0 = (item % 96) * 64, kg = tid >> 6, c = tid & 63;
        const float* W = KIN(I_ADAW) + (size_t)l * 1024 * 6144 + n0 + c;
        float acc[9];
#pragma unroll
        for (int r = 0; r < 9; ++r) acc[r] = 0.f;
#pragma unroll 8
        for (int kk = 0; kk < 128; ++kk) { const int k = kg * 128 + kk; const float w = __builtin_nontemporal_load(W + (size_t)k * 6144);
#pragma unroll
            for (int r = 0; r < 9; ++r) acc[r] += S[r * 1024 + k] * w; }
#pragma unroll
        for (int r = 0; r < 9; ++r) red[(kg * 9 + r) * 64 + c] = acc[r];
        __syncthreads();
        for (int o = tid; o < 576; o += 512) { const int r = o >> 6, cc = o & 63; float s = 0.f;
#pragma unroll
            for (int k2 = 0; k2 < 8; ++k2) s += red[(k2 * 9 + r) * 64 + cc];
            MODS[(size_t)(l * 9 + r) * 6144 + n0 + cc] = s + KIN(I_ADAB)[l * 6144 + n0 + cc]; }
        __syncthreads();
    }
}

DI void tr_item(const float* W, int K, int N, bf16_t* WT, int k0, int n0, int drow0, const float* kscale, float* scr, int lane) {
#pragma unroll 8
    for (int i = 0; i < 32; ++i) { const int kk = 2 * i + (lane >> 5); float v = __builtin_nontemporal_load(W + (size_t)(k0 + kk) * N + n0 + (lane & 31)); if (kscale) v *= kscale[k0 + kk]; scr[kk * 33 + (lane & 31)] = v; }
    asm volatile("s_waitcnt lgkmcnt(0)" ::: "memory");
    const int c = lane & 7;
#pragma unroll
    for (int j = 0; j < 4; ++j) { const int n = (lane >> 3) + 8 * j; const float* s = scr + (8 * c) * 33 + n;
        u32x4 o; o.x = pk2(s[0 * 33], s[1 * 33]); o.y = pk2(s[2 * 33], s[3 * 33]); o.z = pk2(s[4 * 33], s[5 * 33]); o.w = pk2(s[6 * 33], s[7 * 33]);
        *(u32x4*)(WT + (size_t)(drow0 + n) * K + k0 + 8 * c) = o; }
    asm volatile("s_waitcnt lgkmcnt(0)" ::: "memory");
}
DI void convert_weights(const Params& p, int l, unsigned char* lds) {
    asm volatile("" : "+s"(l));
    const int tid = ltid(), wave = tid >> 6, lane = tid & 63; const int gw = blockIdx.x * 8 + wave, NGW = gridDim.x * 8;
    float* scr = (float*)lds + wave * 2112;
    bf16_t* Wb = (bf16_t*)(KWS + OFF_W);
    bf16_t* WT_IN = Wb + W_IN / 2; bf16_t* WT_OUT = Wb + W_OUT / 2; bf16_t* WT_F1 = Wb + W_F1 / 2; bf16_t* WT_F2 = Wb + W_F2 / 2; bf16_t* WT_UQ = Wb + W_UQ / 2; bf16_t* WT_UKV = Wb + W_UKV / 2;
    for (int it = gw; it < 6192; it += NGW) {
        int r = it;
        if (r < 1376) { tr_item(KIN(I_WIN) + (size_t)l * 1024 * INW, 1024, INW, WT_IN, 64 * (r / 86), 32 * (r % 86), 32 * (r % 86), nullptr, scr, lane); continue; } r -= 1376;
        if (r < 512) { tr_item(KIN(I_WOUT) + (size_t)l * 1024 * 1024, 1024, 1024, WT_OUT, 64 * (r / 32), 32 * (r % 32), 32 * (r % 32), nullptr, scr, lane); continue; } r -= 512;
        if (r < 2816) { const int n0 = 32 * (r % 176); const int j = n0 < FFH ? n0 : n0 - FFH; const int drow = 256 * (j / 128) + (j % 128) + (n0 < FFH ? 0 : 128);
            tr_item(KIN(I_FIN) + (size_t)l * 1024 * 5632, 1024, 5632, WT_F1, 64 * (r / 176), n0, drow, nullptr, scr, lane); continue; } r -= 2816;
        if (r < 1408) { tr_item(KIN(I_FOUT) + (size_t)l * FFH * 1024, FFH, 1024, WT_F2, 64 * (r / 32), 32 * (r % 32), 32 * (r % 32), nullptr, scr, lane); continue; } r -= 1408;
        if (r < 48) { tr_item(KIN(I_WUQ) + (size_t)l * 256 * 384, 256, 384, WT_UQ, 64 * (r / 12), 32 * (r % 12), 32 * (r % 12), KIN(I_MQN) + l * 256, scr, lane); continue; } r -= 48;
        tr_item(KIN(I_WUKV) + (size_t)l * 128 * 512, 128, 512, WT_UKV, 64 * (r / 16), 32 * (r % 16), 32 * (r % 16), KIN(I_MKVN) + l * 128, scr, lane);
    }
    const size_t gt = (size_t)blockIdx.x * 512 + tid, gn = (size_t)gridDim.x * 512; unsigned zz = 0u; asm volatile("" : "+v"(zz)); const u32x4 z = {zz, zz, zz, zz};
    for (size_t i = gt; i < 8192; i += gn) ((u32x4*)(WT_IN + (size_t)INW * 1024))[i] = z;
    for (size_t i = gt; i < 4096; i += gn) ((u32x4*)(WT_UQ + (size_t)384 * 256))[i] = z;
}

DI void rowpass(int row_begin, int row_end, int vblock, int vgrid, const float* xinL, const float* xinC, float* xoutL, float* xoutC, const bf16_t* Y, const float* mgate, const float* gpost,
                bf16_t* H, const float* gpre, const float* mshift, const float* mscale) {
    const int tid = ltid(), wave = tid >> 6, lane = tid & 63; const int gw = vblock * 8 + wave, NGW = vgrid * 8;
    f32x4 vn[4]; u32x2 yn[4];
    auto fetch = [&](int row) {
        const float* xr = row < ML ? xinL + (size_t)row * DM : xinC + (size_t)(row - ML) * DM;
#pragma unroll
        for (int j = 0; j < 4; ++j) vn[j] = __builtin_nontemporal_load((const f32x4*)(xr + 4 * lane + 256 * j));
        if (Y) {
#pragma unroll
            for (int j = 0; j < 4; ++j) yn[j] = __builtin_nontemporal_load((const u32x2*)(Y + (size_t)row * DM + 4 * lane + 256 * j)); }
    };
    int row = row_begin + gw;
    if (row < row_end) fetch(row);
    for (; row < row_end; row += NGW) {
        const int mb = row < ML ? (row >> 12) : 8;
        f32x4 v[4]; u32x2 yw[4];
#pragma unroll
        for (int j = 0; j < 4; ++j) { v[j] = vn[j]; yw[j] = yn[j]; }
        if (row + NGW < row_end) fetch(row + NGW);
        if (Y) {
            f32x4 y[4]; float ss = 0.f;
#pragma unroll
            for (int j = 0; j < 4; ++j) { const u32x2 w = yw[j]; y[j] = (f32x4){bflo(w.x), bfhi(w.x), bflo(w.y), bfhi(w.y)};
                ss += (y[j][0] * y[j][0] + y[j][1] * y[j][1]) + (y[j][2] * y[j][2] + y[j][3] * y[j][3]); }
            const float ry = rsqrtf(wave_sum(ss) * (1.f / DM) + EPS);
            float* xo = row < ML ? xoutL + (size_t)row * DM : xoutC + (size_t)(row - ML) * DM;
#pragma unroll
            for (int j = 0; j < 4; ++j) { const f32x4 gt = *(const f32x4*)(mgate + (size_t)mb * 6144 + 4 * lane + 256 * j), gp = *(const f32x4*)(gpost + 4 * lane + 256 * j);
                v[j] = v[j] + gt * (y[j] * ry * gp); __builtin_nontemporal_store(v[j], (f32x4*)(xo + 4 * lane + 256 * j)); }
        }
        if (H) {
            float ss = 0.f;
#pragma unroll
            for (int j = 0; j < 4; ++j) ss += (v[j][0] * v[j][0] + v[j][1] * v[j][1]) + (v[j][2] * v[j][2] + v[j][3] * v[j][3]);
            const float rx = rsqrtf(wave_sum(ss) * (1.f / DM) + EPS);
#pragma unroll
            for (int j = 0; j < 4; ++j) { const int c = 4 * lane + 256 * j; const f32x4 g = *(const f32x4*)(gpre + c), sh = *(const f32x4*)(mshift + (size_t)mb * 6144 + c), sc = *(const f32x4*)(mscale + (size_t)mb * 6144 + c);
                const f32x4 hv = v[j] * rx * g * (sc + 1.f) + sh; u32x2 w; w.x = pk2(hv[0], hv[1]); w.y = pk2(hv[2], hv[3]); *(u32x2*)(H + (size_t)row * DM + c) = w; }
        }
    }
}

template <int TYPE>
DI void attn_unit(const Params& p, unsigned char* lds, int l, int b, int hd, int qrow0, int NT) {
    asm volatile("" : "+s"(l), "+s"(b), "+s"(hd), "+s"(qrow0), "+s"(NT));
    constexpr int NMAP = TYPE == 0 ? 2 : 1, KS = TYPE == 0 ? 2 : 6, DQ = NMAP * KS * 16, KP = DQ + 8, CPR = DQ / 8;
    constexpr int TK = TYPE == 0 ? 64 : 128, VP = TK + 8, KCH = TK * CPR / 512, VCPR = TK / 8, VCH = 64 * VCPR / 512;
    const int tid = ltid(), lane = tid & 63, w = tid >> 6, r32 = lane & 31, h = lane >> 5;
    bf16_t* Kl = (bf16_t*)lds;
    bf16_t* Vl = (bf16_t*)(lds + 2 * TK * KP * 2);
    const bf16_t* PROJ = (const bf16_t*)(KWS + OFF_PA);
    const bf16_t* MQ = (const bf16_t*)(KWS + OFF_MLAQ);
    const bf16_t* MK = (const bf16_t*)(KWS + OFF_MLAK);
    const bf16_t* VTb = (const bf16_t*)(KWS + OFF_VT) + ((size_t)((TYPE * NB + b) * 4 + hd) * 64) * POSN;
    bf16_t* CC = (bf16_t*)(KWS + OFF_HC);
    bf16x8 qf[NMAP][KS];
    const int qrow = qrow0 + 32 * w + r32;
#pragma unroll
    for (int mp = 0; mp < NMAP; ++mp)
#pragma unroll
        for (int s = 0; s < KS; ++s)
            qf[mp][s] = TYPE == 0 ? *(const bf16x8*)(PROJ + (size_t)qrow * INWP + 64 * hd + mp * 32 + 16 * s + 8 * h)
                                  : *(const bf16x8*)(MQ + (size_t)qrow * 384 + 96 * hd + 16 * s + 8 * h);
    float mrun[NMAP], lsum[NMAP]; f32x16 o[NMAP][2];
#pragma unroll
    for (int mp = 0; mp < NMAP; ++mp) { mrun[mp] = 0.f; lsum[mp] = 0.f;
#pragma unroll
        for (int i = 0; i < 16; ++i) { o[mp][0][i] = 0.f; o[mp][1][i] = 0.f; } }
    u32x4 kreg[KCH], vreg[VCH];
    auto gload = [&](int t) {
#pragma unroll
        for (int i = 0; i < KCH; ++i) { const int c = tid + 512 * i, kr = c / CPR, cc = c % CPR; const int grow = pos_row(b, TK * t + kr);
            if (TYPE == 0) kreg[i] = *(const u32x4*)(PROJ + (size_t)grow * INWP + 256 + 64 * hd + 8 * cc);
            else kreg[i] = cc < 8 ? *(const u32x4*)(MK + (size_t)grow * 256 + 64 * hd + 8 * cc) : *(const u32x4*)(PROJ + (size_t)grow * INWP + 1152 + 8 * (cc - 8)); }
#pragma unroll
        for (int i = 0; i < VCH; ++i) { const int c = tid + 512 * i, e = c / VCPR, jc = c % VCPR; vreg[i] = *(const u32x4*)(VTb + (size_t)e * POSN + TK * t + 8 * jc); }
    };
    auto lstore = [&](int buf) {
#pragma unroll
        for (int i = 0; i < KCH; ++i) { const int c = tid + 512 * i, kr = c / CPR, cc = c % CPR; *(u32x4*)(Kl + (size_t)buf * TK * KP + kr * KP + 8 * cc) = kreg[i]; }
#pragma unroll
        for (int i = 0; i < VCH; ++i) { const int c = tid + 512 * i, e = c / VCPR, jc = c % VCPR; *(u32x4*)(Vl + (size_t)buf * 64 * VP + e * VP + 8 * jc) = vreg[i]; }
    };
    const int NTI = NT * 64 / TK;
    gload(0); lstore(0); __syncthreads();
    bool shifted = false;
    for (int t = 0; t < NTI; ++t) {
        const int buf = t & 1;
        if (t + 1 < NTI) gload(t + 1);
        const bf16_t* Kb = Kl + (size_t)buf * TK * KP; const bf16_t* Vb = Vl + (size_t)buf * 64 * VP;
        bf16x8 pbd[2][4];
        f32x16 a0, a1, b0, b1;
        auto kfrag = [&](int st, int half, int s) { return TYPE == 0 ? *(const bf16x8*)(Kb + (32 * half + r32) * KP + st * 32 + 16 * s + 8 * h)
                                                                       : *(const bf16x8*)(Kb + (64 * st + 32 * half + r32) * KP + 16 * s + 8 * h); };
        auto vfrag = [&](int st, int eb, int s) { return *(const bf16x8*)(Vb + (32 * eb + r32) * VP + (TYPE == 0 ? 0 : 64 * st) + 16 * s + 8 * h); };
        auto sub_ref = [&](f32x16& x0, f32x16& x1, int mi) {
            if (__builtin_expect(shifted, 0)) { asm volatile("" ::: "memory");
#pragma unroll
                for (int i = 0; i < 16; ++i) { x0[i] -= mrun[mi]; x1[i] -= mrun[mi]; } } };
        auto pack8 = [&](const f32x16& x, int base) { u32x4 tt; tt.x = pk2(x[base], x[base + 1]); tt.y = pk2(x[base + 2], x[base + 3]); tt.z = pk2(x[base + 4], x[base + 5]); tt.w = pk2(x[base + 6], x[base + 7]); return __builtin_bit_cast(bf16x8, tt); };
        auto slow = [&](int st, f32x16& x0, f32x16& x1, float& ps) {
            const int mi = TYPE == 0 ? st : 0;
#pragma unroll
            for (int i = 0; i < 16; ++i) { x0[i] = 0.f; x1[i] = 0.f; }
#pragma unroll
            for (int s2 = 0; s2 < KS; ++s2) { x0 = MFMA32(kfrag(st, 0, s2), qf[mi][s2], x0); x1 = MFMA32(kfrag(st, 1, s2), qf[mi][s2], x1); }
            sub_ref(x0, x1, mi);
            float tm = fmaxf(x0[0], x1[0]);
#pragma unroll
            for (int i = 1; i < 16; ++i) tm = fmaxf(tm, fmaxf(x0[i], x1[i]));
            tm = fmaxf(tm, __shfl_xor(tm, 32));
            const bool first = (t == 0) && (TYPE == 0 || st == 0);
            const float dl = first ? tm : fmaxf(tm, 0.f);
            mrun[mi] += dl;
            if (!first) { const float alpha = __builtin_amdgcn_exp2f(-dl); lsum[mi] *= alpha;
#pragma unroll
                for (int i = 0; i < 16; ++i) { o[mi][0][i] *= alpha; o[mi][1][i] *= alpha; } }
            ps = 0.f;
#pragma unroll
            for (int i = 0; i < 16; ++i) { x0[i] = __builtin_amdgcn_exp2f(x0[i] - dl); x1[i] = __builtin_amdgcn_exp2f(x1[i] - dl); ps += x0[i] + x1[i]; }
            shifted = true;
        };
        constexpr int M0 = 0, M1 = TYPE == 0 ? 1 : 0;
#pragma unroll
        for (int i = 0; i < 16; ++i) { a0[i] = 0.f; a1[i] = 0.f; b0[i] = 0.f; b1[i] = 0.f; }
#pragma unroll
        for (int s2 = 0; s2 < KS; ++s2) { a0 = MFMA32(kfrag(0, 0, s2), qf[M0][s2], a0); a1 = MFMA32(kfrag(0, 1, s2), qf[M0][s2], a1); }
        sub_ref(a0, a1, M0);
        float psa = 0.f;
#pragma unroll
        for (int n = 0; n < 2 * KS; ++n) {
            if (n & 1) b1 = MFMA32(kfrag(1, 1, n >> 1), qf[M1][n >> 1], b1); else b0 = MFMA32(kfrag(1, 0, n >> 1), qf[M1][n >> 1], b0);
#pragma unroll
            for (int r = (32 * n) / (2 * KS); r < (32 * (n + 1)) / (2 * KS); ++r) {
                if (r < 16) { a0[r] = __builtin_amdgcn_exp2f(a0[r]); psa += a0[r]; } else { a1[r - 16] = __builtin_amdgcn_exp2f(a1[r - 16]); psa += a1[r - 16]; } }
        }
        {   const bool firstA = (t == 0);
            if (__builtin_expect(__any(!(psa <= 1e13f) || (firstA && psa < 1e-13f)), 0)) slow(0, a0, a1, psa); }
        lsum[M0] += psa;
        pbd[0][0] = pack8(a0, 0); pbd[0][1] = pack8(a0, 8); pbd[0][2] = pack8(a1, 0); pbd[0][3] = pack8(a1, 8);
        sub_ref(b0, b1, M1);
        float psb = 0.f;
#pragma unroll
        for (int eb = 0; eb < 2; ++eb)
#pragma unroll
            for (int s2 = 0; s2 < 4; ++s2) {
                o[M0][eb] = MFMA32(vfrag(0, eb, s2), pbd[0][s2], o[M0][eb]);
                const int q4 = (eb * 4 + s2) * 4;
#pragma unroll
                for (int i = 0; i < 4; ++i) { const int r = q4 + i; if (r < 16) { b0[r] = __builtin_amdgcn_exp2f(b0[r]); psb += b0[r]; } else { b1[r - 16] = __builtin_amdgcn_exp2f(b1[r - 16]); psb += b1[r - 16]; } }
            }
        {   const bool firstB = (t == 0) && TYPE == 0;
            if (__builtin_expect(__any(!(psb <= 1e13f) || (firstB && psb < 1e-13f)), 0)) slow(1, b0, b1, psb); }
        lsum[M1] += psb;
        pbd[1][0] = pack8(b0, 0); pbd[1][1] = pack8(b0, 8); pbd[1][2] = pack8(b1, 0); pbd[1][3] = pack8(b1, 8);
#pragma unroll
        for (int eb = 0; eb < 2; ++eb)
#pragma unroll
            for (int s2 = 0; s2 < 4; ++s2) o[M1][eb] = MFMA32(vfrag(1, eb, s2), pbd[1][s2], o[M1][eb]);
        if (t + 1 < NTI) lstore(buf ^ 1);
        __syncthreads();
    }
    float inv[NMAP];
#pragma unroll
    for (int mp = 0; mp < NMAP; ++mp) { const float lt = lsum[mp] + __shfl_xor(lsum[mp], 32); inv[mp] = 1.f / lt; }
    if (TYPE == 1) {
        bf16_t* op = CC + (size_t)qrow * DM + 256 + 64 * hd;
#pragma unroll
        for (int eb = 0; eb < 2; ++eb)
#pragma unroll
            for (int g = 0; g < 4; ++g) { const f32x4 v = {o[0][eb][4 * g] * inv[0], o[0][eb][4 * g + 1] * inv[0], o[0][eb][4 * g + 2] * inv[0], o[0][eb][4 * g + 3] * inv[0]};
                pg8::store4(op + 32 * eb + 8 * g + 4 * h, v); }
    } else {
        int l2 = l; asm volatile("" : "+s"(l2));
        const float* dl = opq2(KIN(I_DLAM)) + l2 * 128; float d1 = 0.f, d2 = 0.f;
        for (int i = 0; i < 32; ++i) { d1 += dl[i] * dl[32 + i]; d2 += dl[64 + i] * dl[96 + i]; }
        float c08 = 0.8f, c06 = 0.6f; asm volatile("" : "+v"(c08), "+v"(c06));
        const float lam_init = c08 - c06 * __expf(-0.3f * (float)l2);
        const float lam = __expf(d1) - __expf(d2) + lam_init;
        const float* sg = opq2(KIN(I_DNORM)) + l2 * 64;
        float ss = 0.f; const float li1 = lam * inv[NMAP - 1];
#pragma unroll
        for (int eb = 0; eb < 2; ++eb)
#pragma unroll
            for (int i = 0; i < 16; ++i) { const float v = o[0][eb][i] * inv[0] - li1 * o[NMAP - 1][eb][i]; o[0][eb][i] = v; ss += v * v; }
        ss += __shfl_xor(ss, 32);
        const float rn = rsqrtf(ss * (1.f / 64.f) + EPS) * (1.f - lam_init);
        bf16_t* op = CC + (size_t)qrow * DM + 64 * hd;
#pragma unroll
        for (int eb = 0; eb < 2; ++eb)
#pragma unroll
            for (int g = 0; g < 4; ++g) { const int e0 = 32 * eb + 8 * g + 4 * h; const f32x4 gg = *(const f32x4*)(sg + e0);
                const f32x4 v = {o[0][eb][4 * g] * rn * gg[0], o[0][eb][4 * g + 1] * rn * gg[1], o[0][eb][4 * g + 2] * rn * gg[2], o[0][eb][4 * g + 3] * rn * gg[3]};
                pg8::store4(op + e0, v); }
    }
}

DI void scan_unit(const Params& p, unsigned char* lds, int l, int mixer, int b, int hd, int item) {
    asm volatile("" : "+s"(l), "+s"(mixer), "+s"(b), "+s"(hd), "+s"(item));
    const int tid = ltid(), dir = tid >> 8, td = tid & 255, lane = tid & 63, wd = (tid >> 6) & 3, r32 = lane & 31, h = lane >> 5;
    unsigned char* L = lds + dir * 55296;
    bf16_t* QT = (bf16_t*)(L);
    bf16_t* KT = (bf16_t*)(L + 5120);
    bf16_t* KH = (bf16_t*)(L + 10240);
    bf16_t* ST = (bf16_t*)(L + 14848);
    bf16_t* VTt = (bf16_t*)(L + 19968);
    bf16_t* SC = (bf16_t*)(L + 29184);
    float* OL = (float*)(L + 19968);
    float* BB = (float*)(L + 38400);
    float* SEG = (float*)(L + 46592);
    float* BEND = (float*)(L + 47616);
    float* WG = (float*)(L + 47744);
    float* GT = (float*)(L + 49920);
    const bf16_t* PROJ = (const bf16_t*)(KWS + OFF_PA);
    bf16_t* CC = (bf16_t*)(KWS + OFF_HC);
    float* OTMP = (float*)(KWS + OFF_Y) + (size_t)item * 68 * 4096;
    const int qcol = (mixer == 0 ? 1184 : 1984) + 32 * hd, kcol = (mixer == 0 ? 1312 : 2112) + 32 * hd, ogcol = (mixer == 0 ? 1696 : 2496) + 64 * hd;
    const int ccol = 512 + 256 * mixer + 64 * hd;
    const bf16_t* VTb = (const bf16_t*)(KWS + OFF_VT) + ((size_t)(((mixer == 0 ? 2 : 3) * NB + b) * 4 + hd) * 64) * POSN;
    const float* og = (mixer == 0 ? KIN(I_GNORM) : KIN(I_RNORM)) + l * 64;
    float lg = 0.f;
    float ogr[16];
#pragma unroll
    for (int i = 0; i < 16; ++i) ogr[i] = og[16 * (td & 3) + i];
    float wg[16], wb = 0.f;
#pragma unroll
    for (int r = 0; r < 16; ++r) wg[r] = 0.f;
    if (mixer == 0) {
        const float* gw = KIN(I_GWG) + (size_t)((l * 2 + dir) * 16) * 128 + 32 * hd + (td & 31);
#pragma unroll
        for (int r = 0; r < 16; ++r) wg[r] = gw[r * 128];
        wb = KIN(I_GBG)[(l * 2 + dir) * 128 + 32 * hd + (td & 31)];
    } else lg = logsig_f(KIN(I_RDEC)[(l * 2 + dir) * 4 + hd]);
    for (int idx = td; idx < 64 * 40; idx += 256) ST[idx] = 0;
    f32x16 Sacc;
#pragma unroll
    for (int i = 0; i < 16; ++i) Sacc[i] = 0.f;
    u32x4 qreg, kreg, vreg0, vreg1, greg;
    auto chunk_of = [&](int s) { return dir == 0 ? s : (s < 4 ? 3 - s : 71 - s); };
    auto chunk_row0 = [&](int g) { return g < 4 ? ML + b * CTXL + 64 * g : b * SEQL + 64 * (g - 4); };
    auto gload = [&](int s) {
        const int g = chunk_of(s), row0 = chunk_row0(g);
        qreg = *(const u32x4*)(PROJ + (size_t)(row0 + (td >> 2)) * INWP + qcol + 8 * (td & 3));
        kreg = *(const u32x4*)(PROJ + (size_t)(row0 + (td >> 2)) * INWP + kcol + 8 * (td & 3));
        vreg0 = *(const u32x4*)(VTb + (size_t)(td >> 3) * POSN + 64 * g + 8 * (td & 7));
        vreg1 = *(const u32x4*)(VTb + (size_t)(32 + (td >> 3)) * POSN + 64 * g + 8 * (td & 7));
        if (mixer == 0 && td < 128) greg = *(const u32x4*)(PROJ + (size_t)(row0 + (td >> 1)) * INWP + 1952 + 16 * dir + 8 * (td & 1));
    };
    gload(0);
    __syncthreads();
    for (int s = 0; s < 68; ++s) {
        const int g = chunk_of(s), row0 = chunk_row0(g);
        *(u32x4*)(VTt + (td >> 3) * 72 + 8 * (td & 7)) = vreg0;
        *(u32x4*)(VTt + (32 + (td >> 3)) * 72 + 8 * (td & 7)) = vreg1;
        if (mixer == 0 && td < 128) { float* gp = GT + (td >> 1) * 16 + 8 * (td & 1);
            gp[0] = bflo(greg.x); gp[1] = bfhi(greg.x); gp[2] = bflo(greg.y); gp[3] = bfhi(greg.y); gp[4] = bflo(greg.z); gp[5] = bfhi(greg.z); gp[6] = bflo(greg.w); gp[7] = bfhi(greg.w); }
        const u32x4 qc = qreg, kc = kreg;
        if (s + 1 < 68) gload(s + 1);
        const int s_other = dir == 0 ? (g < 4 ? 3 - g : 71 - g) : g;
        const bool fin = s_other < s;
        float* ot = OTMP + (size_t)g * 4096 + (td >> 2) * 64 + 16 * (td & 3);
        f32x4 pf0, pf1, pf2, pf3; u32x4 g0, g1;
        LBAR();
        { const int d = td & 31, seg = td >> 5; float a[8];
          if (mixer == 0) {
#pragma unroll
              for (int i = 0; i < 8; ++i) { const float* gr = GT + (8 * seg + i) * 16;
                  const f32x4 x0 = *(const f32x4*)gr, x1 = *(const f32x4*)(gr + 4), x2 = *(const f32x4*)(gr + 8), x3 = *(const f32x4*)(gr + 12);
                  float acc = wb;
                  acc += x0[0] * wg[0]; acc += x0[1] * wg[1]; acc += x0[2] * wg[2]; acc += x0[3] * wg[3];
                  acc += x1[0] * wg[4]; acc += x1[1] * wg[5]; acc += x1[2] * wg[6]; acc += x1[3] * wg[7];
                  acc += x2[0] * wg[8]; acc += x2[1] * wg[9]; acc += x2[2] * wg[10]; acc += x2[3] * wg[11];
                  acc += x3[0] * wg[12]; acc += x3[1] * wg[13]; acc += x3[2] * wg[14]; acc += x3[3] * wg[15];
                  a[i] = logsig_f(acc) * (1.f / 16.f); }
          } else {
#pragma unroll
              for (int i = 0; i < 8; ++i) a[i] = lg;
          }
          float run = 0.f;
          if (dir == 0) {
#pragma unroll
              for (int i = 0; i < 8; ++i) { run += a[i]; a[i] = run; }
          } else {
#pragma unroll
              for (int i = 7; i >= 0; --i) { run += a[i]; a[i] = run; }
          }
          SEG[seg * 32 + d] = run;
          LBAR();
          float off = 0.f, tot = 0.f;
#pragma unroll
          for (int s2 = 0; s2 < 8; ++s2) { const float sv = SEG[s2 * 32 + d]; tot += sv; if (dir == 0 ? (s2 < seg) : (s2 > seg)) off += sv; }
#pragma unroll
          for (int i = 0; i < 8; ++i) BB[(8 * seg + i) * 32 + d] = a[i] + off;
          if (seg == 0) { BEND[d] = tot; BEND[32 + d] = __expf(tot); } }
        LBAR();
        { const int j = td >> 2, cc = td & 3;
          float qv[8] = {bflo(qc.x), bfhi(qc.x), bflo(qc.y), bfhi(qc.y), bflo(qc.z), bfhi(qc.z), bflo(qc.w), bfhi(qc.w)};
          float kv[8] = {bflo(kc.x), bfhi(kc.x), bflo(kc.y), bfhi(kc.y), bflo(kc.z), bfhi(kc.z), bflo(kc.w), bfhi(kc.w)};
          float k1[8];
#pragma unroll
          for (int i = 0; i < 8; ++i) { const int d = 8 * cc + i; const float bv = BB[j * 32 + d], ee = BEND[32 + d];
              const float eb = __expf(bv), en = __builtin_amdgcn_rcpf(eb); qv[i] *= eb; k1[i] = kv[i] * en; KH[d * 72 + ((j & ~12) | ((j & 4) << 1) | ((j & 8) >> 1))] = (bf16_t)f2bf(kv[i] * (ee * en)); }
          u32x4 wq, wk; wq.x = pk2(qv[0], qv[1]); wq.y = pk2(qv[2], qv[3]); wq.z = pk2(qv[4], qv[5]); wq.w = pk2(qv[6], qv[7]);
          wk.x = pk2(k1[0], k1[1]); wk.y = pk2(k1[2], k1[3]); wk.z = pk2(k1[4], k1[5]); wk.w = pk2(k1[6], k1[7]);
          *(u32x4*)(QT + j * 40 + 8 * cc) = wq; *(u32x4*)(KT + j * 40 + 8 * cc) = wk; }
        __syncthreads();
        if (fin) { pf0 = *(const f32x4*)(ot); pf1 = *(const f32x4*)(ot + 4); pf2 = *(const f32x4*)(ot + 8); pf3 = *(const f32x4*)(ot + 12);
            const bf16_t* gp = PROJ + (size_t)(row0 + (td >> 2)) * INWP + ogcol + 16 * (td & 3); g0 = *(const u32x4*)gp; g1 = *(const u32x4*)(gp + 8); }
        { const int jb = wd >> 1, ib = wd & 1; const bool skip = dir == 0 ? (jb > ib) : (jb < ib);
          f32x16 pa;
#pragma unroll
          for (int i = 0; i < 16; ++i) pa[i] = 0.f;
          if (!skip) {
#pragma unroll
              for (int s2 = 0; s2 < 2; ++s2) { const bf16x8 a = *(const bf16x8*)(KT + (32 * jb + r32) * 40 + 16 * s2 + 8 * h), bq = *(const bf16x8*)(QT + (32 * ib + r32) * 40 + 16 * s2 + 8 * h);
                  pa = MFMA32(a, bq, pa); }
          }
          const int itok = 32 * ib + r32;
#pragma unroll
          for (int gq = 0; gq < 4; ++gq) { f32x4 v;
#pragma unroll
              for (int i = 0; i < 4; ++i) { const int j = 32 * jb + 8 * gq + 4 * h + i; const bool keep = dir == 0 ? (j <= itok) : (j >= itok); v[i] = keep ? pa[4 * gq + i] : 0.f; }
              pg8::store4(SC + itok * 72 + 32 * jb + 16 * (gq >> 1) + 8 * h + 4 * (gq & 1), v); } }
        LBAR();
        f32x16 oacc;
        { const int eb = wd >> 1, ib = wd & 1;
#pragma unroll
          for (int i = 0; i < 16; ++i) oacc[i] = 0.f;
#pragma unroll
          for (int s2 = 0; s2 < 4; ++s2) { const bf16x8 a = *(const bf16x8*)(VTt + (32 * eb + r32) * 72 + 16 * s2 + 8 * h), bb = *(const bf16x8*)(SC + (32 * ib + r32) * 72 + 16 * s2 + 8 * h);
              oacc = MFMA32(a, bb, oacc); }
#pragma unroll
          for (int s2 = 0; s2 < 2; ++s2) { const bf16x8 a = *(const bf16x8*)(ST + (32 * eb + r32) * 40 + 16 * s2 + 8 * h), bb = *(const bf16x8*)(QT + (32 * ib + r32) * 40 + 16 * s2 + 8 * h);
              oacc = MFMA32(a, bb, oacc); }
          if (wd < 2) { const float dec = BEND[32 + r32];
#pragma unroll
              for (int i = 0; i < 16; ++i) Sacc[i] *= dec;
#pragma unroll
              for (int s2 = 0; s2 < 4; ++s2) { const bf16x8 a = *(const bf16x8*)(VTt + (32 * wd + r32) * 72 + 16 * s2 + 8 * h), bb = *(const bf16x8*)(KH + r32 * 72 + 16 * s2 + 8 * h);
                  Sacc = MFMA32(a, bb, Sacc); } } }
        LBAR();
        { const int eb = wd >> 1, ib = wd & 1;
#pragma unroll
          for (int gq = 0; gq < 4; ++gq) *(f32x4*)(OL + (32 * ib + r32) * 68 + 32 * eb + 8 * gq + 4 * h) = (f32x4){oacc[4 * gq], oacc[4 * gq + 1], oacc[4 * gq + 2], oacc[4 * gq + 3]};
          if (wd < 2) {
#pragma unroll
              for (int i = 0; i < 16; ++i) ST[(32 * wd + crow(i, h)) * 40 + r32] = (bf16_t)f2bf(Sacc[i]); } }
        LBAR();
        { const int j = td >> 2, e0 = 16 * (td & 3); float ov[16];
#pragma unroll
          for (int q4 = 0; q4 < 4; ++q4) { const f32x4 v = *(const f32x4*)(OL + j * 68 + e0 + 4 * q4); ov[4 * q4] = v[0]; ov[4 * q4 + 1] = v[1]; ov[4 * q4 + 2] = v[2]; ov[4 * q4 + 3] = v[3]; }
          if (fin) {
              float ss = 0.f;
              const float pv[16] = {pf0[0], pf0[1], pf0[2], pf0[3], pf1[0], pf1[1], pf1[2], pf1[3], pf2[0], pf2[1], pf2[2], pf2[3], pf3[0], pf3[1], pf3[2], pf3[3]};
#pragma unroll
              for (int i = 0; i < 16; ++i) { ov[i] += pv[i]; ss += ov[i] * ov[i]; }
              ss += __shfl_xor(ss, 1); ss += __shfl_xor(ss, 2);
              const float rn = rsqrtf(ss * (1.f / 64.f) + EPS);
              const int row = row0 + j;
              const float gv[16] = {bflo(g0.x), bfhi(g0.x), bflo(g0.y), bfhi(g0.y), bflo(g0.z), bfhi(g0.z), bflo(g0.w), bfhi(g0.w),
                                    bflo(g1.x), bfhi(g1.x), bflo(g1.y), bfhi(g1.y), bflo(g1.z), bfhi(g1.z), bflo(g1.w), bfhi(g1.w)};
              float r[16];
#pragma unroll
              for (int i = 0; i < 16; ++i) r[i] = ov[i] * rn * ogr[i] * silu_f(gv[i]);
              u32x4 w0, w1; w0.x = pk2(r[0], r[1]); w0.y = pk2(r[2], r[3]); w0.z = pk2(r[4], r[5]); w0.w = pk2(r[6], r[7]);
              w1.x = pk2(r[8], r[9]); w1.y = pk2(r[10], r[11]); w1.z = pk2(r[12], r[13]); w1.w = pk2(r[14], r[15]);
              *(u32x4*)(CC + (size_t)row * DM + ccol + e0) = w0; *(u32x4*)(CC + (size_t)row * DM + ccol + e0 + 8) = w1;
          } else {
#pragma unroll
              for (int q4 = 0; q4 < 4; ++q4) *(f32x4*)(ot + 4 * q4) = (f32x4){ov[4 * q4], ov[4 * q4 + 1], ov[4 * q4 + 2], ov[4 * q4 + 3]};
          } }
        LBAR();
    }
    __syncthreads();
}

DI void mixer_phase(const Params& p, unsigned char* lds, int l, int rep) {
    asm volatile("" : "+s"(l));
    const int tid = ltid();
    unsigned* ctr = (unsigned*)(KWS + OFF_CTL) + 64 * (l + 1 + 4 * rep);
    volatile int* s_item = (volatile int*)(lds + LDS_CTL_OFF);
    const bool with_ctx = l < NLAYER - 1;
    const int nitems = 64 + 1024 + (with_ctx ? 64 : 0);
    for (;;) {
        if (tid == 0) *s_item = (int)atomicAdd(ctr, 1u);
        __syncthreads();
        const int it = __builtin_amdgcn_readfirstlane(*s_item);
        __syncthreads();
        if (it >= nitems) break;
        if (rep > 0 && ((REP_MIX_ONLY == 1 && it >= 64) || (REP_MIX_ONLY == 2 && it < 64))) continue;
        if (it < 64) { if (PH(11)) scan_unit(p, lds, l, it >> 5, (it >> 2) & 7, it & 3, it); }
        else { int type, b, hd, qrow0, NT;
            if (it < 64 + 1024) { const int u = it - 64, rem = u & 511, qb = rem & 15; type = u >> 9; b = rem >> 6; hd = (rem >> 4) & 3; qrow0 = b * SEQL + 256 * qb; NT = POSN / 64; }
            else { const int u = it - 1088; type = u >> 5; b = (u >> 2) & 7; hd = u & 3; qrow0 = ML + b * CTXL; NT = CTXL / 64; }
            if (type == 0) { if (PH(12)) attn_unit<0>(p, lds, l, b, hd, qrow0, NT); } else { if (PH(13)) attn_unit<1>(p, lds, l, b, hd, qrow0, NT); } }
    }
}

#define LAS __attribute__((address_space(3)))
#define XB_TMO      128
#define XB_XCNT(j)  (256  + 64 * (j))
#define XB_XSUB(j)  (1280 + 64 * (j))
#define XB_XGEN(j)  (2304 + 64 * (j))
#define XB_TOP      3328
#define XB_TOPGEN   3392
#define XCD_BAR_WORDS 3456
#define XB_SPIN_CAP (1u << 18)

__device__ __forceinline__ unsigned xb_ld(unsigned* p)              { return __hip_atomic_load(p, __ATOMIC_RELAXED, __HIP_MEMORY_SCOPE_AGENT); }
__device__ __forceinline__ unsigned xb_add(unsigned* p, unsigned v) { return __hip_atomic_fetch_add(p, v, __ATOMIC_RELAXED, __HIP_MEMORY_SCOPE_AGENT); }
__device__ __forceinline__ unsigned xb_xcc_id() { return (unsigned)__builtin_amdgcn_s_getreg((3 << 11) | 20) & 0xFu; }
#define XB_SPIN(cond, bar) do { unsigned _sp = 0; while (cond) { __builtin_amdgcn_s_sleep(1); \
    if ((++_sp & 255u) == 0u) { if (xb_ld(&(bar)[XB_TMO])) break; if (_sp > XB_SPIN_CAP) { atomicAdd(&(bar)[XB_TMO], 1u); break; } } } } while (0)

struct XcdBarrier {
    unsigned* bar; unsigned x;
    volatile LAS unsigned* st;
};

__device__ __forceinline__ XcdBarrier xcd_barrier_post(unsigned* bar, volatile LAS unsigned* st) {
    XcdBarrier b; b.bar = bar; b.x = xb_xcc_id(); b.st = st;
    if (threadIdx.x == 0) (void)xb_add(&bar[XB_XCNT(b.x)], 1u);
    return b;
}
__device__ __forceinline__ void xcd_barrier_complete(unsigned* bar, unsigned x, unsigned& nloc, unsigned& nx) {
    const unsigned G = gridDim.x * gridDim.y * gridDim.z;
    unsigned sum, cnt, mine, sp = 0u;
    for (;;) {
        sum = 0u; cnt = 0u; mine = 0u;
#pragma unroll
        for (unsigned j = 0; j < 16; ++j) { const unsigned c = xb_ld(&bar[XB_XCNT(j)]); sum += c; cnt += (c > 0u) ? 1u : 0u; mine = (j == x) ? c : mine; }
        if (sum == G) break;
        __builtin_amdgcn_s_sleep(1);
        if ((++sp & 255u) == 0u) { if (xb_ld(&bar[XB_TMO])) break; if (sp > XB_SPIN_CAP) { atomicAdd(&bar[XB_TMO], 1u); break; } }
    }
    nloc = mine > 0u ? mine : 1u; nx = cnt > 0u ? cnt : 1u;
}

__device__ __forceinline__ void xcd_barrier(const XcdBarrier& b) {
    asm volatile("s_waitcnt vmcnt(0)" ::: "memory");
    __syncthreads();
    if (threadIdx.x == 0) {
        unsigned* bar = b.bar;
        __builtin_amdgcn_s_waitcnt(0);
        unsigned nloc = b.st[0], nx = b.st[1];
        if (nloc == 0u) { xcd_barrier_complete(bar, b.x, nloc, nx); b.st[0] = nloc; b.st[1] = nx; }
        const unsigned old = xb_add(&bar[XB_XSUB(b.x)], 1u);
        const unsigned gen = old / nloc;
        if (old + 1u == (gen + 1u) * nloc) {
            __builtin_amdgcn_fence(__ATOMIC_RELEASE, "agent");
            asm volatile("s_waitcnt vmcnt(0)" ::: "memory");
            const unsigned og = xb_add(&bar[XB_TOP], 1u);
            const unsigned tg = og / nx;
            if (og + 1u == (tg + 1u) * nx) xb_add(&bar[XB_TOPGEN], 1u);
            else XB_SPIN(xb_ld(&bar[XB_TOPGEN]) == tg, bar);
            __builtin_amdgcn_fence(__ATOMIC_ACQUIRE, "agent");
            xb_add(&bar[XB_XGEN(b.x)], 1u);
            asm volatile("s_waitcnt vmcnt(0)" ::: "memory");
        } else {
            XB_SPIN(xb_ld(&bar[XB_XGEN(b.x)]) == gen, bar);
            __builtin_amdgcn_fence(__ATOMIC_ACQUIRE, "agent");
            asm volatile("s_waitcnt vmcnt(0)" ::: "memory");
        }
    }
    __syncthreads();
}

template <class T> DI T* opq(T* q) { asm volatile("" : "+s"(q)); return q; }
__global__ void __launch_bounds__(512, 2) mega(Params p) {
    extern __shared__ __attribute__((aligned(16))) unsigned char lds[];
    cg::grid_group grid = cg::this_grid();
    { volatile LAS unsigned* z = (volatile LAS unsigned*)((LAS unsigned char*)lds + LDS_CTL_OFF); if (threadIdx.x < 16) z[threadIdx.x] = 0u; }
    __syncthreads();
    const XcdBarrier xbar = xcd_barrier_post((unsigned*)(KWS + OFF_BAR), (volatile LAS unsigned*)((LAS unsigned char*)lds + LDS_CTL_OFF + 32));
#if USE_CG_SYNC
#define GSYNC() grid.sync()
#else
#define GSYNC() xcd_barrier(xbar)
#endif
    PG8_LAS unsigned char* lds3 = (PG8_LAS unsigned char*)lds;
    const int G = gridDim.x, c = blockIdx.x;
#define WSB(off) (opq(KWS) + (off))
#define WGT(off) ((bf16_t*)(opq(KWS) + OFF_W + (off)))

    if (PH(0)) phase0(p, lds);
    grid.sync();
#pragma unroll 1
    for (int l = 0; l < NLAYER; ++l) {
        const bool with_ctx = l < NLAYER - 1;
        const int Mrows = with_ctx ? MT : ML;
        if (PH(1)) {
            const float* ng = opq(KIN(I_NORMG)) + (size_t)l * 4 * DM; const float* MODS = (const float*)WSB(OFF_MODS); const float* ml = MODS + (size_t)l * 9 * 6144;
            bf16_t* HC = (bf16_t*)WSB(OFF_HC); float* XC = (float*)WSB(OFF_XCTX); float* outp = opq(KOUT);
            if (l == 0) rowpass(0, MT, c, G, KIN(I_X), KIN(I_CTX), nullptr, nullptr, nullptr, nullptr, nullptr, HC, ng, ml, ml + 1024);
            else {
                if (c < 32) { pg8::Gemm g{(const bf16_t*)WSB(OFF_PA) + (size_t)ML * FFH, WGT(W_F2), MC, DM, FFH, FFH}; pg8::StaticOrder S; S.init(MC, DM, G, c);
                    pg8::EpiY E{(bf16_t*)WSB(OFF_Y) + (size_t)ML * DM, DM};
                    pg8::gemm_phase<pg8::EpiY, pg8::StaticOrder, true, true>(lds3, g, S, E); }
                else rowpass(0, ML, c - 32, G - 32, outp, XC, outp, XC, (const bf16_t*)WSB(OFF_Y), MODS + (size_t)(l - 1) * 9 * 6144 + 5 * 1024, ng - DM, HC, ng, ml, ml + 1024);
                GSYNC();
                rowpass(ML, MT, c, G, outp, XC, outp, XC, (const bf16_t*)WSB(OFF_Y), MODS + (size_t)(l - 1) * 9 * 6144 + 5 * 1024, ng - DM, HC, ng, ml, ml + 1024);
            }
        }
        for (int rep = 0; rep < REP_CONV; ++rep) { if (PH(2)) convert_weights(p, l, lds); }
        for (int rep = 0; rep < REP_RP0; ++rep) { const float* ng = opq(KIN(I_NORMG)); const float* ml = (const float*)WSB(OFF_MODS); rowpass(0, MT, c, G, KIN(I_X), KIN(I_CTX), nullptr, nullptr, nullptr, nullptr, nullptr, (bf16_t*)WSB(OFF_Y), ng, ml, ml + 1024); }
        GSYNC();
        for (int rep = 0; rep < REP_SYNC; ++rep) GSYNC();
        for (int rep = 0; rep < REP_G3; ++rep) { if (rep) GSYNC();
        if (PH(3)) { pg8::Gemm g{(const bf16_t*)WSB(OFF_HC), WGT(W_IN), MT, INWP, DM, DM}; pg8::StaticOrder S; S.init(MT, INWP, G, c);
          const float* rc = (const float*)WSB(OFF_ROPE);
          pg8::EpiProj E{(bf16_t*)WSB(OFF_PA), (bf16_t*)WSB(OFF_VT), (float*)WSB(OFF_STQ), (float*)WSB(OFF_STKV), rc, rc + 4096 * 16, lds + LDS_CTL_OFF + 256};
          pg8::gemm_phase<pg8::EpiProj, pg8::StaticOrder, true, true>(lds3, g, S, E); } }
        GSYNC();
        for (int rep = 0; rep < REP_C; ++rep) {
        if (PH(4)) { int Kq = 256; asm volatile("" : "+s"(Kq)); pg8::Gemm g{(const bf16_t*)WSB(OFF_PA) + 768, WGT(W_UQ), MT, 512, Kq, INWP}; pg8::StaticOrder S; S.init(MT, 512, G, c);
          const float* rc = (const float*)WSB(OFF_ROPE);
          pg8::EpiUpQ E{(bf16_t*)WSB(OFF_MLAQ), (const float*)WSB(OFF_STQ), rc, rc + 4096 * 16};
          pg8::gemm_phase<pg8::EpiUpQ, pg8::StaticOrder, true, true>(lds3, g, S, E); }
        if (PH(5)) { int Kq = 128; asm volatile("" : "+s"(Kq)); pg8::Gemm g{(const bf16_t*)WSB(OFF_PA) + 1024, WGT(W_UKV), MT, 512, Kq, INWP}; pg8::StaticOrder S; S.init(MT, 512, G, (c + G / 2) % G);
          pg8::EpiUpKV E{(bf16_t*)WSB(OFF_MLAK), (bf16_t*)WSB(OFF_VT), (const float*)WSB(OFF_STKV), lds + LDS_CTL_OFF + 256};
          pg8::gemm_phase<pg8::EpiUpKV, pg8::StaticOrder, true, true>(lds3, g, S, E); }
        GSYNC(); }
        for (int rep = 0; rep < REP_MIX; ++rep) { if (PH(6)) mixer_phase(p, lds, l, rep); GSYNC(); }
        for (int rep = 0; rep < REP_G7; ++rep) { if (rep) GSYNC();
        if (PH(7)) { pg8::Gemm g{(const bf16_t*)WSB(OFF_HC), WGT(W_OUT), Mrows, DM, DM, DM}; pg8::StaticOrder S; S.init(Mrows, DM, G, c);
          pg8::EpiY E{(bf16_t*)WSB(OFF_Y), DM};
          pg8::gemm_phase<pg8::EpiY, pg8::StaticOrder, true, true>(lds3, g, S, E); } }
        GSYNC();
        if (PH(8)) {
            const float* ng = opq(KIN(I_NORMG)) + (size_t)l * 4 * DM; const float* ml = (const float*)WSB(OFF_MODS) + (size_t)l * 9 * 6144;
            float* XC = (float*)WSB(OFF_XCTX); float* outp = opq(KOUT);
            rowpass(0, Mrows, c, G, l == 0 ? KIN(I_X) : outp, l == 0 ? KIN(I_CTX) : XC, outp, XC, (const bf16_t*)WSB(OFF_Y), ml + 2 * 1024, ng + DM, (bf16_t*)WSB(OFF_HC), ng + 2 * DM, ml + 3 * 1024, ml + 4 * 1024);
        }
        GSYNC();
        for (int rep = 0; rep < REP_G9; ++rep) { if (rep) GSYNC();
        if (PH(9)) { pg8::Gemm g{(const bf16_t*)WSB(OFF_HC), WGT(W_F1), Mrows, 2 * FFH, DM, DM}; pg8::StaticOrder S; S.init(Mrows, 2 * FFH, G, c);
          pg8::EpiSwiglu E{(bf16_t*)WSB(OFF_PA)};
          pg8::gemm_phase<pg8::EpiSwiglu, pg8::StaticOrder, true, true>(lds3, g, S, E); } }
        GSYNC();
        for (int rep = 0; rep < REP_G10; ++rep) { if (rep) GSYNC();
        if (PH(10)) { pg8::Gemm g{(const bf16_t*)WSB(OFF_PA), WGT(W_F2), ML, DM, FFH, FFH}; pg8::StaticOrder S; S.init(ML, DM, G, c);
          pg8::EpiY E{(bf16_t*)WSB(OFF_Y), DM};
          pg8::gemm_phase<pg8::EpiY, pg8::StaticOrder, true, true>(lds3, g, S, E); } }
        GSYNC();
    }
    { float* XC = (float*)WSB(OFF_XCTX); float* outp = opq(KOUT);
      rowpass(0, ML, c, G, outp, XC, outp, XC, (const bf16_t*)WSB(OFF_Y), (const float*)WSB(OFF_MODS) + (size_t)3 * 9 * 6144 + 5 * 1024, KIN(I_NORMG) + (size_t)3 * 4 * DM + 3 * DM, nullptr, nullptr, nullptr, nullptr); }
}

extern "C" void kernel_launch(void* const* d_in, const int* in_sizes, int n_in, void* d_out, int out_size, void* d_ws, size_t ws_size, hipStream_t stream) {
    static int grid_blocks = 0;
    if (!grid_blocks) {
        if (n_in != 22 || ws_size < WS_END2) { fprintf(stderr, "kernel_launch: unexpected n_in %d or ws_size %zu (need %zu)\n", n_in, ws_size, (size_t)WS_END2); grid_blocks = -1; return; }
        int dev = 0, cus = 0, per_cu = 0;
        (void)hipGetDevice(&dev);
        (void)hipDeviceGetAttribute(&cus, hipDeviceAttributeMultiprocessorCount, dev);
        (void)hipFuncSetAttribute((const void*)mega, hipFuncAttributeMaxDynamicSharedMemorySize, LDS_BYTES);
        (void)hipOccupancyMaxActiveBlocksPerMultiprocessor(&per_cu, (const void*)mega, 512, LDS_BYTES);
        if (per_cu < 1) per_cu = 1;
        grid_blocks = cus * per_cu;
    }
    if (grid_blocks < 0) return;
    (void)hipMemsetAsync((unsigned char*)d_ws + OFF_BAR, 0, 16384, stream);
    Params p{};
    for (int i = 0; i < 22; ++i) p.in[i] = (const float*)d_in[i];
    p.out = (float*)d_out; p.ws = (unsigned char*)d_ws;
    void* args[] = {&p};
    hipError_t e = hipLaunchCooperativeKernel((const void*)mega, dim3(grid_blocks), dim3(512), args, LDS_BYTES, stream);
    if (e != hipSuccess) fprintf(stderr, "cooperative launch failed: %s (grid %d)\n", hipGetErrorString(e), grid_blocks);
}
```

```cpp
#include <hip/hip_runtime.h>
#include <hip/hip_cooperative_groups.h>
#include <cstdio>
#include <cstdint>
namespace cg = cooperative_groups;
namespace pg8 {
#define PG8_LAS __attribute__((address_space(3)))
typedef unsigned short bf16_t;
typedef short bf16x8 __attribute__((ext_vector_type(8)));
typedef float f32x4 __attribute__((ext_vector_type(4)));
typedef unsigned u32x4 __attribute__((ext_vector_type(4)));
constexpr int BM = 256, BK = 64, HALF = 128, HTB = HALF * BK * 2  , STAGE_BYTES = 8 * HTB, NXCD = 8, WGM = 8;

__host__ __device__ __forceinline__ int lds_byte(int r, int c) { const int st = (r >> 4) * 2 + (c >> 5), rr = r & 15, cc = c & 31, ob = rr * 64 + cc * 2; return st * 1024 + (ob ^ (((ob >> 9) & 1) << 5)); }
__host__ __device__ __forceinline__ void stage_rc(int b, int& R, int& C) { const int st = b / 1024, sb = b % 1024, swz = sb ^ (((sb >> 9) & 1) << 5); R = (st >> 1) * 16 + swz / 64; C = (st & 1) * 32 + (swz % 64) / 2; }
__host__ __device__ __forceinline__ int perm32(int rho) { const int n = rho >> 4, i = rho & 15; return 8 * (i >> 2) + 4 * n + (i & 3); }

struct Unit { int pm, pn; };
struct Gemm { const bf16_t* A; const bf16_t* Bt; int M, N, K, lda; };

struct StaticOrder {
    int nM, nN, nwg, G, c;
    __host__ __device__ void init(int M, int N, int G_, int c_) { nM = M / BM; nN = N / BM; nwg = nM * nN; G = G_; c = c_; }
    __host__ __device__ bool next(int i, Unit& u) const {
        const long L = (long)i * G + c; if (L >= nwg) return false;
        int wgid = (int)L; { const int q = nwg / NXCD, r = nwg % NXCD, xcd = wgid % NXCD, off = wgid / NXCD; wgid = (xcd < r ? xcd * (q + 1) : r * (q + 1) + (xcd - r) * q) + off; }
        const int nig = WGM * nN, gid = wgid / nig, fm = gid * WGM, gsz = (nM - fm) < WGM ? (nM - fm) : WGM;
        u.pm = fm + ((wgid % nig) % gsz); u.pn = (wgid % nig) / gsz; return true;
    }
    __device__ __forceinline__ void a_ready(const Unit&) const {}
    __device__ __forceinline__ void done(const Unit&) const {}
};

__device__ __forceinline__ unsigned cvt_pk_bf16(float lo, float hi) { unsigned r; asm volatile("v_cvt_pk_bf16_f32 %0, %1, %2" : "=v"(r) : "v"(lo), "v"(hi)); return r; }
typedef float f32x2 __attribute__((ext_vector_type(2)));
template <class Epi, class Sched, bool ALIGN_EPI = false, bool SP2 = false>
__device__ __forceinline__ void gemm_phase(PG8_LAS unsigned char* lds, const Gemm g, const Sched& S, const Epi& E) {
    int tid_ = threadIdx.x; asm volatile("" : "+v"(tid_)); const int tid = tid_, wid = __builtin_amdgcn_readfirstlane(tid >> 6), lane = tid & 63, wr = wid >> 2, wc = wid & 3, fr = lane & 15, fq = lane >> 4;
    const int K = g.K, nt = K / BK;
    unsigned voffA[2], voffB[2];
#pragma unroll
    for (int i = 0; i < 2; ++i) { int R, C; stage_rc(tid * 16 + i * 8192, R, C); const int Rb = Epi::PERM ? ((R & ~31) + perm32(R & 31)) : R;
        voffA[i] = (unsigned)(R * g.lda + C) * 2u; voffB[i] = (unsigned)(Rb * K + C) * 2u; }
    const size_t kstep = (size_t)(BK * 2);
    const size_t hstepB = (size_t)HALF * K * 2, hstepA = (size_t)HALF * g.lda * 2;
    const size_t tstepB = 2 * hstepB, tstepA = 2 * hstepA;
    const unsigned ldsw = (unsigned)wid * 1024u;
    const int aoff = lds_byte(wr * 64 + fr, fq * 8), boff = lds_byte(wc * 32 + fr, fq * 8);
#define PG8_SA(b, h) (((b) * 2 + (h)) * HTB)
#define PG8_SB(b, h) ((4 + (b) * 2 + (h)) * HTB)
#define PG8_STAGE(bufoff, gbase, voff) do { _Pragma("unroll") for (int _i = 0; _i < 2; ++_i) \
        __builtin_amdgcn_global_load_lds((const unsigned*)((const char*)(gbase) + (voff)[_i]), (PG8_LAS unsigned*)(lds + (bufoff) + ldsw + _i * 8192), 16, 0, 0); } while (0)
#define PG8_LDA(dst, b, h) do { _Pragma("unroll") for (int m = 0; m < 4; ++m) _Pragma("unroll") for (int k = 0; k < 2; ++k) dst[m][k] = *(const PG8_LAS bf16x8*)(lds + PG8_SA(b, h) + aoff + m * 2048 + k * 1024); } while (0)
#define PG8_LDB(dst, b, h) do { _Pragma("unroll") for (int n = 0; n < 2; ++n) _Pragma("unroll") for (int k = 0; k < 2; ++k) dst[n][k] = *(const PG8_LAS bf16x8*)(lds + PG8_SB(b, h) + boff + n * 2048 + k * 1024); } while (0)
#define PG8_MMA(ai, bj, At, Bt) do { __builtin_amdgcn_s_setprio(1); _Pragma("unroll") for (int m = 0; m < 4; ++m) _Pragma("unroll") for (int n = 0; n < 2; ++n) _Pragma("unroll") for (int k = 0; k < 2; ++k) \
        acc[ai][bj][m][n] = __builtin_amdgcn_mfma_f32_16x16x32_bf16(Bt[n][k], At[m][k], acc[ai][bj][m][n], 0, 0, 0); __builtin_amdgcn_s_setprio(0); } while (0)
#define PG8_WAIT_V(n) asm volatile("s_waitcnt vmcnt(" #n ")" ::: "memory")
#define PG8_WAIT_L(n) asm volatile("s_waitcnt lgkmcnt(" #n ")" ::: "memory")
#define PG8_BAR __builtin_amdgcn_s_barrier()
#define PG8_SCHED __builtin_amdgcn_sched_barrier(0)
    Unit cur, nxt; int ui = 0;
    if (!S.next(0, cur)) return;
    f32x4 acc[2][2][4][2];
#pragma unroll
    for (int a = 0; a < 2; ++a)
#pragma unroll
        for (int b = 0; b < 2; ++b)
#pragma unroll
            for (int m = 0; m < 4; ++m)
#pragma unroll
                for (int n = 0; n < 2; ++n) acc[a][b][m][n] = (f32x4){0.f, 0.f, 0.f, 0.f};
    bf16x8 At[4][2], B0[2][2], B1[2][2];
    const char* cA = (const char*)g.A + (size_t)cur.pm * tstepA; const char* cB = (const char*)g.Bt + (size_t)cur.pn * tstepB;
    S.a_ready(cur);
    if constexpr (SP2) {
        PG8_STAGE(PG8_SB(0, 0), cB, voffB); PG8_STAGE(PG8_SB(0, 1), cB + hstepB, voffB); PG8_STAGE(PG8_SA(0, 0), cA, voffA); PG8_STAGE(PG8_SA(0, 1), cA + hstepA, voffA);
        if (wr == 1) PG8_BAR;
        PG8_WAIT_V(2); PG8_BAR;
        PG8_STAGE(PG8_SB(1, 0), cB + kstep, voffB); PG8_STAGE(PG8_SA(1, 0), cA + kstep, voffA); PG8_STAGE(PG8_SB(1, 1), cB + hstepB + kstep, voffB);
        PG8_WAIT_V(6); PG8_BAR;
    } else {
        PG8_STAGE(PG8_SB(0, 0), cB, voffB); PG8_STAGE(PG8_SA(0, 0), cA, voffA); PG8_STAGE(PG8_SB(0, 1), cB + hstepB, voffB); PG8_STAGE(PG8_SA(0, 1), cA + hstepA, voffA);
        if (wr == 1) PG8_BAR;
        PG8_WAIT_V(4); PG8_BAR;
        PG8_STAGE(PG8_SB(1, 0), cB + kstep, voffB); PG8_STAGE(PG8_SA(1, 0), cA + kstep, voffA); PG8_STAGE(PG8_SB(1, 1), cB + hstepB + kstep, voffB);
        PG8_WAIT_V(6); PG8_BAR;
    }
    for (;;) {
        const bool has_next = S.next(ui + 1, nxt);
        const char* nA = has_next ? (const char*)g.A + (size_t)nxt.pm * tstepA : cA; const char* nB = has_next ? (const char*)g.Bt + (size_t)nxt.pn * tstepB : cB;
        for (int t = 0; t < nt; t += 2) {
            const bool last = (t == nt - 2);
            const char* a1 = cA + (size_t)(t + 1) * kstep;
            const char* a2 = last ? nA : cA + (size_t)(t + 2) * kstep; const char* b2 = last ? nB : cB + (size_t)(t + 2) * kstep;
            const char* a3 = a2 + kstep; const char* b3 = b2 + kstep;
            if (last && has_next) S.a_ready(nxt);
            if constexpr (SP2) {
            PG8_LDB(B0, 0, 0); PG8_LDB(B1, 0, 1); PG8_SCHED; PG8_LDA(At, 0, 0); PG8_STAGE(PG8_SA(1, 1), a1 + hstepA, voffA);
            PG8_WAIT_V(8); PG8_WAIT_L(0); PG8_BAR; PG8_MMA(0, 0, At, B0); PG8_MMA(0, 1, At, B1); PG8_BAR; PG8_SCHED;
            PG8_LDA(At, 0, 1); PG8_STAGE(PG8_SB(0, 0), b2, voffB); PG8_STAGE(PG8_SB(0, 1), b2 + hstepB, voffB); PG8_STAGE(PG8_SA(0, 0), a2, voffA);
            PG8_WAIT_V(8); PG8_WAIT_L(0); PG8_BAR; PG8_MMA(1, 0, At, B0); PG8_MMA(1, 1, At, B1); PG8_BAR; PG8_SCHED;
            PG8_LDB(B0, 1, 0); PG8_LDB(B1, 1, 1); PG8_SCHED; PG8_LDA(At, 1, 0); PG8_STAGE(PG8_SA(0, 1), a2 + hstepA, voffA);
            PG8_WAIT_V(8); PG8_WAIT_L(0); PG8_BAR; PG8_MMA(0, 0, At, B0); PG8_MMA(0, 1, At, B1); PG8_BAR; PG8_SCHED;
            PG8_LDA(At, 1, 1); PG8_STAGE(PG8_SB(1, 0), b3, voffB); PG8_STAGE(PG8_SB(1, 1), b3 + hstepB, voffB); PG8_STAGE(PG8_SA(1, 0), a3, voffA);
            PG8_WAIT_V(8); PG8_WAIT_L(0); PG8_BAR; PG8_MMA(1, 0, At, B0); PG8_MMA(1, 1, At, B1); PG8_BAR; PG8_SCHED;
            } else {
            PG8_LDB(B0, 0, 0); PG8_SCHED; PG8_LDA(At, 0, 0); PG8_STAGE(PG8_SA(1, 1), a1 + hstepA, voffA);
            PG8_WAIT_L(8); PG8_BAR; PG8_WAIT_L(0); PG8_MMA(0, 0, At, B0); PG8_BAR; PG8_SCHED;
            PG8_LDB(B1, 0, 1); PG8_STAGE(PG8_SB(0, 0), b2, voffB);
            PG8_BAR; PG8_WAIT_L(0); PG8_MMA(0, 1, At, B1); PG8_BAR;
            PG8_LDA(At, 0, 1); PG8_STAGE(PG8_SA(0, 0), a2, voffA);
            PG8_BAR; PG8_WAIT_L(0); PG8_MMA(1, 0, At, B0); PG8_BAR; PG8_SCHED;
            PG8_STAGE(PG8_SB(0, 1), b2 + hstepB, voffB);
            PG8_WAIT_V(6); PG8_BAR; PG8_MMA(1, 1, At, B1); PG8_BAR;
            PG8_LDB(B0, 1, 0); PG8_SCHED; PG8_LDA(At, 1, 0); PG8_STAGE(PG8_SA(0, 1), a2 + hstepA, voffA);
            PG8_WAIT_L(8); PG8_BAR; PG8_WAIT_L(0); PG8_MMA(0, 0, At, B0); PG8_BAR; PG8_SCHED;
            PG8_LDB(B1, 1, 1); PG8_STAGE(PG8_SB(1, 0), b3, voffB);
            PG8_BAR; PG8_WAIT_L(0); PG8_MMA(0, 1, At, B1); PG8_BAR;
            PG8_LDA(At, 1, 1); PG8_STAGE(PG8_SA(1, 0), a3, voffA);
            PG8_BAR; PG8_WAIT_L(0); PG8_MMA(1, 0, At, B0); PG8_BAR; PG8_SCHED;
            PG8_STAGE(PG8_SB(1, 1), b3 + hstepB, voffB);
            PG8_WAIT_V(6); PG8_BAR; PG8_MMA(1, 1, At, B1); PG8_BAR;
            }
        }
        if constexpr (ALIGN_EPI) { if (wr == 0) PG8_BAR; }
        if constexpr (!Epi::AFTER_DRAIN) { E(acc, cur, wr, wc, fr, fq); S.done(cur); }
        if (!has_next) break;
#pragma unroll
        for (int a = 0; a < 2; ++a)
#pragma unroll
            for (int b = 0; b < 2; ++b)
#pragma unroll
                for (int m = 0; m < 4; ++m)
#pragma unroll
                    for (int n = 0; n < 2; ++n) acc[a][b][m][n] = (f32x4){0.f, 0.f, 0.f, 0.f};
        cur = nxt; cA = nA; cB = nB; ++ui;
        if constexpr (ALIGN_EPI) { if (wr == 1) PG8_BAR; }
    }
    PG8_WAIT_V(0);
    if constexpr (!ALIGN_EPI) { if (wr == 0) PG8_BAR; }
    PG8_BAR;
    if constexpr (Epi::AFTER_DRAIN) { E.fused(acc, cur, wr, wc, fr, fq, lds, wid, lane); S.done(cur); }
#undef PG8_SA
#undef PG8_SB
#undef PG8_STAGE
#undef PG8_LDA
#undef PG8_LDB
#undef PG8_MMA
#undef PG8_WAIT_V
#undef PG8_WAIT_L
#undef PG8_BAR
#undef PG8_SCHED
}
}

typedef unsigned short bf16_t;
typedef short bf16x8 __attribute__((ext_vector_type(8)));
typedef short s16x4 __attribute__((ext_vector_type(4)));
typedef float f32x4 __attribute__((ext_vector_type(4)));
typedef float f32x16 __attribute__((ext_vector_type(16)));
typedef unsigned u32x4 __attribute__((ext_vector_type(4)));
typedef unsigned u32x2 __attribute__((ext_vector_type(2)));
typedef float f32x2_t __attribute__((ext_vector_type(2)));
typedef __bf16 bf16x2_t __attribute__((ext_vector_type(2)));
#define DI __device__ __forceinline__
template <class T> DI T* opq2(T* q) { asm volatile("" : "+s"(q)); return q; }
DI int ltid() { int t = threadIdx.x; asm volatile("" : "+v"(t)); return t; }

constexpr int NB = 8, SEQL = 4096, CTXL = 256, DM = 1024, NLAYER = 4;
constexpr int ML = NB * SEQL, MC = NB * CTXL, MT = ML + MC;
constexpr int POSN = SEQL + CTXL;
constexpr int INW = 2752, INWP = 2816, FFH = 2816;
constexpr float EPS = 1e-6f;
constexpr float LOG2E = 1.4426950408889634f;

constexpr size_t OFF_CTL = 0;
constexpr size_t OFF_MODS = 4096;
constexpr size_t OFF_ROPE = OFF_MODS + 884736;
constexpr size_t OFF_STQ = OFF_ROPE + 524288;
constexpr size_t OFF_STKV = OFF_STQ + 1114112;
constexpr size_t OFF_XCTX = OFF_STKV + 557056;
constexpr size_t OFF_W = OFF_XCTX + 8388608;
constexpr size_t W_IN = 0, W_OUT = 5767168, W_F1 = 7864320, W_F2 = 19398656, W_UQ = 25165824, W_UKV = 25427968, W_TOTAL = 25559040;
constexpr size_t OFF_HC = OFF_W + W_TOTAL;
constexpr size_t OFF_PA = OFF_HC + 71303168;
constexpr size_t OFF_Y = OFF_PA + 196083712;
constexpr size_t OFF_MLAQ = OFF_Y + 71303168;
constexpr size_t OFF_MLAK = OFF_MLAQ + 26738688;
constexpr size_t OFF_VT = OFF_MLAK + 17825792;
constexpr size_t VT_TYPE_ELEMS = (size_t)NB * 4 * 64 * POSN;
constexpr size_t WS_END = OFF_VT + 4 * VT_TYPE_ELEMS * 2;
constexpr size_t OFF_BAR = WS_END, WS_END2 = WS_END + 16384;
static_assert(WS_END2 <= 536870912, "workspace map");

#ifndef USE_CG_SYNC
#define USE_CG_SYNC 0
#endif
#ifndef REP_SYNC
#define REP_SYNC 0
#endif
#ifndef REP_C
#define REP_C 1
#endif
#ifndef REP_CONV
#define REP_CONV 1
#endif
#ifndef REP_RP0
#define REP_RP0 0
#endif
#ifndef REP_MIX_ONLY
#define REP_MIX_ONLY 0
#endif
#ifndef REP_MIX
#define REP_MIX 1
#endif
#ifndef REP_GEMM
#define REP_GEMM 1
#endif
#ifndef REP_G3
#define REP_G3 REP_GEMM
#endif
#ifndef REP_G7
#define REP_G7 REP_GEMM
#endif
#ifndef REP_G9
#define REP_G9 REP_GEMM
#endif
#ifndef REP_G10
#define REP_G10 REP_GEMM
#endif
#ifndef PHMASK
#define PHMASK 0xFFFF
#endif
#define PH(k) ((PHMASK >> (k)) & 1)
constexpr int LDS_BYTES = 147456;
constexpr int LDS_CTL_OFF = 131072;

struct Params { const float* in[22]; float* out; unsigned char* ws; };
enum { I_X = 0, I_C, I_CTX, I_CCTX, I_ADAW, I_ADAB, I_NORMG, I_WIN, I_DLAM, I_DNORM, I_MQN, I_MKVN, I_WUQ, I_WUKV, I_GWG, I_GBG, I_GNORM, I_RDEC, I_RNORM, I_WOUT, I_FIN, I_FOUT };

typedef const unsigned char __attribute__((address_space(4)))* kaptr_t;
DI kaptr_t kargs() { kaptr_t ka = (kaptr_t)__builtin_amdgcn_kernarg_segment_ptr(); asm volatile("" : "+s"(ka)); return ka; }
#define KIN(k) (*(const float* const __attribute__((address_space(4)))*)(kargs() + 8 * (k)))
#define KOUT (*(float* const __attribute__((address_space(4)))*)(kargs() + 8 * 22))
#define KWS (*(unsigned char* const __attribute__((address_space(4)))*)(kargs() + 8 * 23))
DI unsigned pk2(float lo, float hi) { f32x2_t v = {lo, hi}; bf16x2_t b = __builtin_convertvector(v, bf16x2_t); return __builtin_bit_cast(unsigned, b); }
DI unsigned f2bf(float f) { return pk2(f, f) & 0xffffu; }
DI float bflo(unsigned w) { return __uint_as_float(w << 16); }
DI float bfhi(unsigned w) { return __uint_as_float(w & 0xffff0000u); }
DI int crow(int i, int h) { return (i & 3) + 8 * (i >> 2) + 4 * h; }
DI float wave_sum(float v) {
#pragma unroll
    for (int o = 1; o < 64; o <<= 1) v += __shfl_xor(v, o);
    return v;
}
DI float silu_f(float x) { return x / (1.f + __expf(-x)); }
DI float logsig_f(float x) { return fminf(x, 0.f) - __logf(1.f + __expf(-fabsf(x))); }
#define LBAR() asm volatile("s_waitcnt lgkmcnt(0)\n\ts_barrier" ::: "memory")
#define MFMA32(a, b, c) __builtin_amdgcn_mfma_f32_32x32x16_bf16((a), (b), (c), 0, 0, 0)

DI void row_bpos(int row, int& b, int& pos) { if (row < ML) { b = row >> 12; pos = CTXL + (row & 4095); } else { const int r = row - ML; b = r >> 8; pos = r & 255; } }
DI int pos_row(int b, int pos) { return pos < CTXL ? ML + b * CTXL + pos : b * SEQL + pos - CTXL; }

namespace pg8 {
struct EpiY {
    static constexpr bool PERM = true, AFTER_DRAIN = false;
    bf16_t* O; int ldc;
    __device__ __forceinline__ void operator()(const f32x4 (&acc)[2][2][4][2], const Unit& u, int wr, int wc, int fr, int fq) const {
        const int row0 = u.pm * BM + wr * 64 + fr, col0 = u.pn * BM + wc * 32 + 8 * fq;
#pragma unroll
        for (int ai = 0; ai < 2; ++ai)
#pragma unroll
            for (int m = 0; m < 4; ++m) { bf16_t* rowp = O + (size_t)(row0 + ai * HALF + m * 16) * ldc + col0;
#pragma unroll
                for (int bj = 0; bj < 2; ++bj) { const f32x4 v0 = acc[ai][bj][m][0], v1 = acc[ai][bj][m][1];
                    u32x4 w; w.x = pk2(v0[0], v0[1]); w.y = pk2(v0[2], v0[3]); w.z = pk2(v1[0], v1[1]); w.w = pk2(v1[2], v1[3]);
                    *(u32x4*)(rowp + bj * HALF) = w; } }
    }
};
struct EpiSwiglu {
    static constexpr bool PERM = true, AFTER_DRAIN = false;
    bf16_t* O;
    __device__ __forceinline__ void operator()(const f32x4 (&acc)[2][2][4][2], const Unit& u, int wr, int wc, int fr, int fq) const {
        const int row0 = u.pm * BM + wr * 64 + fr, col0 = u.pn * HALF + wc * 32 + 8 * fq;
#pragma unroll
        for (int ai = 0; ai < 2; ++ai)
#pragma unroll
            for (int m = 0; m < 4; ++m) { bf16_t* rowp = O + (size_t)(row0 + ai * HALF + m * 16) * FFH + col0;
                float r[8];
#pragma unroll
                for (int n = 0; n < 2; ++n)
#pragma unroll
                    for (int i = 0; i < 4; ++i) { const float g = acc[ai][0][m][n][i], up = acc[ai][1][m][n][i]; r[4 * n + i] = g / (1.f + __expf(-g)) * up; }
                u32x4 w; w.x = pk2(r[0], r[1]); w.y = pk2(r[2], r[3]); w.z = pk2(r[4], r[5]); w.w = pk2(r[6], r[7]);
                *(u32x4*)rowp = w; }
    }
};
DI void rope_pair(f32x4& a, f32x4& b, const float* rc, const float* rs, int row, int fq) {
    if (row < ML) { const int t = row & 4095; const f32x4 c = *(const f32x4*)(rc + t * 16 + 4 * fq), s = *(const f32x4*)(rs + t * 16 + 4 * fq);
        const f32x4 x1 = a, x2 = b; a = x1 * c - x2 * s; b = x1 * s + x2 * c; }
}
DI void store4(bf16_t* p, const f32x4& v) { u32x2 w; w.x = pk2(v[0], v[1]); w.y = pk2(v[2], v[3]); *(u32x2*)p = w; }
DI void store_vt(bf16_t* VT, int type, int hd, int e0, int row, const f32x4& v) {
    int b, pos; row_bpos(row, b, pos);
    pos = (pos & ~12) | ((pos & 4) << 1) | ((pos & 8) >> 1);
    bf16_t* q = VT + ((size_t)((type * NB + b) * 4 + hd) * 64 + e0) * POSN + pos;
#pragma unroll
    for (int i = 0; i < 4; ++i) q[(size_t)i * POSN] = (bf16_t)f2bf(v[i]);
}
DI void store_vt_tile(bf16_t* VT, int type, int hd, int e0, int row0, const f32x4& v0, const f32x4& v1, bf16_t* scr, int fr, int c0, int c1, int lane) {
    const int pr = (fr & ~12) | ((fr & 4) << 1) | ((fr & 8) >> 1);
#pragma unroll
    for (int i = 0; i < 4; ++i) { scr[(c0 + i) * 24 + pr] = (bf16_t)f2bf(v0[i]); scr[(c1 + i) * 24 + pr] = (bf16_t)f2bf(v1[i]); }
    asm volatile("s_waitcnt lgkmcnt(0)" ::: "memory");
    const int col = lane >> 1, half = lane & 1;
    const u32x4 w = *(const u32x4*)(scr + col * 24 + 8 * half);
    int b, pos; row_bpos(row0, b, pos);
    *(u32x4*)(VT + ((size_t)((type * NB + b) * 4 + hd) * 64 + e0 + col) * POSN + pos + 8 * half) = w;
    asm volatile("s_waitcnt lgkmcnt(0)" ::: "memory");
}
struct EpiProj {
    static constexpr bool PERM = true, AFTER_DRAIN = false;
    bf16_t* PROJ; bf16_t* VT; float* stq; float* stkv; const float* rc; const float* rs; unsigned char* scr;
    __device__ __forceinline__ void operator()(const f32x4 (&acc)[2][2][4][2], const Unit& u, int wr, int wc, int fr, int fq) const {
#pragma unroll
        for (int bj = 0; bj < 2; ++bj) {
            const int g = u.pn * 8 + bj * 4 + wc;
            if (g >= 86) continue;
            const int colbase = g * 32;
            int kind = 0; float scale = 1.f; int vtype = 0, vc0 = 0, slot = 0;
            if (g < 8) { kind = 1; scale = 0.17677669529663687f * LOG2E; }
            else if (g < 16) { kind = 1; }
            else if (g < 24) { kind = 2; vtype = 0; vc0 = colbase - 512; }
            else if (g < 32) { kind = 3; slot = g - 24; }
            else if (g < 36) { kind = 4; slot = g - 32; }
            else if (g == 36) { kind = 1; }
            else if (g < 41) { kind = 0; scale = 0.17677669529663687f; }
            else if (g < 45) { kind = 0; }
            else if (g < 53) { kind = 2; vtype = 2; vc0 = colbase - 1440; }
            else if (g < 62) { kind = 0; }
            else if (g < 66) { kind = 1; scale = 0.17677669529663687f; }
            else if (g < 70) { kind = 1; }
            else if (g < 78) { kind = 2; vtype = 3; vc0 = colbase - 2240; }
            else { kind = 0; }
#pragma unroll
            for (int ai = 0; ai < 2; ++ai)
#pragma unroll
                for (int m = 0; m < 4; ++m) {
                    const int row = u.pm * BM + ai * HALF + wr * 64 + m * 16 + fr;
                    f32x4 v0 = acc[ai][bj][m][0], v1 = acc[ai][bj][m][1];
                    if (kind == 1) {
                        f32x4 w0, w1;
#pragma unroll
                        for (int i = 0; i < 4; ++i) { w0[i] = __shfl_xor(v0[i], 32); w1[i] = __shfl_xor(v1[i], 32); }
                        if (row < ML) { const int t = row & 4095; const float* cb = rc + t * 16 + 8 * (fq & 1); const float* sb = rs + t * 16 + 8 * (fq & 1);
                            const f32x4 c0 = *(const f32x4*)cb, c1 = *(const f32x4*)(cb + 4), s0 = *(const f32x4*)sb, s1 = *(const f32x4*)(sb + 4);
                            if (fq < 2) { v0 = v0 * c0 - w0 * s0; v1 = v1 * c1 - w1 * s1; } else { v0 = w0 * s0 + v0 * c0; v1 = w1 * s1 + v1 * c1; } }
                    }
                    v0 = v0 * scale; v1 = v1 * scale;
                    if (kind == 2) {
                        store_vt_tile(VT, vtype, vc0 >> 6, vc0 & 63, row - fr, v0, v1, (bf16_t*)(scr + (wr * 4 + wc) * 1536), fr, 8 * fq, 8 * fq + 4, fr + 16 * fq);
                    } else {
                        { u32x4 ww; ww.x = pk2(v0[0], v0[1]); ww.y = pk2(v0[2], v0[3]); ww.z = pk2(v1[0], v1[1]); ww.w = pk2(v1[2], v1[3]);
                          *(u32x4*)(PROJ + (size_t)row * INWP + colbase + 8 * fq) = ww; }
                        if (kind >= 3) {
                            float ss = (v0[0] * v0[0] + v0[1] * v0[1]) + (v0[2] * v0[2] + v0[3] * v0[3]) + (v1[0] * v1[0] + v1[1] * v1[1]) + (v1[2] * v1[2] + v1[3] * v1[3]);
                            ss += __shfl_xor(ss, 16); ss += __shfl_xor(ss, 32);
                            if (fq == 0) { if (kind == 3) stq[(size_t)row * 8 + slot] = ss; else stkv[(size_t)row * 4 + slot] = ss; }
                        }
                    }
                }
        }
    }
};
struct EpiUpQ {
    static constexpr bool PERM = false, AFTER_DRAIN = false;
    bf16_t* MQ; const float* stq; const float* rc; const float* rs;
    __device__ __forceinline__ void operator()(const f32x4 (&acc)[2][2][4][2], const Unit& u, int wr, int wc, int fr, int fq) const {
#pragma unroll
        for (int ai = 0; ai < 2; ++ai)
#pragma unroll
            for (int m = 0; m < 4; ++m) {
                const int row = u.pm * BM + ai * HALF + wr * 64 + m * 16 + fr;
                const f32x4 s0 = *(const f32x4*)(stq + (size_t)row * 8), s1 = *(const f32x4*)(stq + (size_t)row * 8 + 4);
                const float ss = ((s0[0] + s0[1]) + (s0[2] + s0[3])) + ((s1[0] + s1[1]) + (s1[2] + s1[3]));
                const float sc = rsqrtf(ss * (1.f / 256.f) + EPS) * (0.10206207261596575f * LOG2E);
#pragma unroll
                for (int bj = 0; bj < 2; ++bj) {
                    const int g = u.pn * 8 + bj * 4 + wc;
                    if (g >= 12) continue;
                    f32x4 v0 = acc[ai][bj][m][0], v1 = acc[ai][bj][m][1];
                    if ((g % 3) == 2) rope_pair(v0, v1, rc, rs, row, fq);
                    v0 = v0 * sc; v1 = v1 * sc;
                    bf16_t* pp = MQ + (size_t)row * 384 + g * 32 + 4 * fq;
                    store4(pp, v0); store4(pp + 16, v1);
                }
                asm volatile("" ::: "memory");
            }
    }
};
struct EpiUpKV {
    static constexpr bool PERM = false, AFTER_DRAIN = false;
    bf16_t* MK; bf16_t* VT; const float* stkv; unsigned char* scr;
    __device__ __forceinline__ void operator()(const f32x4 (&acc)[2][2][4][2], const Unit& u, int wr, int wc, int fr, int fq) const {
#pragma unroll
        for (int ai = 0; ai < 2; ++ai)
#pragma unroll
            for (int m = 0; m < 4; ++m) {
                const int row = u.pm * BM + ai * HALF + wr * 64 + m * 16 + fr;
                const f32x4 s0 = *(const f32x4*)(stkv + (size_t)row * 4);
                const float sc = rsqrtf(((s0[0] + s0[1]) + (s0[2] + s0[3])) * (1.f / 128.f) + EPS);
#pragma unroll
                for (int bj = 0; bj < 2; ++bj) {
                    const int g = u.pn * 8 + bj * 4 + wc, hd = g >> 2, part = g & 3;
                    const f32x4 v0 = acc[ai][bj][m][0] * sc, v1 = acc[ai][bj][m][1] * sc;
                    if (part < 2) { bf16_t* pp = MK + (size_t)row * 256 + hd * 64 + part * 32 + 4 * fq; store4(pp, v0); store4(pp + 16, v1); }
                    else { store_vt_tile(VT, 1, hd, (part - 2) * 32, row - fr, v0, v1, (bf16_t*)(scr + (wr * 4 + wc) * 1536), fr, 4 * fq, 16 + 4 * fq, fr + 16 * fq); }
                }
                asm volatile("" ::: "memory");
            }
    }
};
}

DI void phase0(const Params& p, unsigned char* lds) {
    const int tid = ltid(); const size_t gt = (size_t)blockIdx.x * 512 + tid, gn = (size_t)gridDim.x * 512;
    if (blockIdx.x == 0) for (int i = tid; i < 1024; i += 512) ((unsigned*)(KWS + OFF_CTL))[i] = 0u;
    float* rc = (float*)(KWS + OFF_ROPE); float* rs = rc + 4096 * 16;
    for (size_t i = gt; i < 65536; i += gn) { const int t = (int)(i >> 4), jj = (int)(i & 15), k = jj & 7;
        const float freq = powf(10000.f, -(float)k * 0.125f); const float pos = jj < 8 ? (float)(t >> 6) : (float)(t & 63); const float a = pos * freq;
        rc[i] = cosf(a); rs[i] = sinf(a); }
    float* S = (float*)lds;
    float* red = S + 9216;
    for (int i = tid; i < 9216; i += 512) { const int r = i >> 10, k = i & 1023; const float c = r < 8 ? KIN(I_C)[r * 1024 + k] : KIN(I_CCTX)[k]; S[i] = c / (1.f + expf(-c)); }
    __syncthreads();
    float* MODS = (float*)(KWS + OFF_MODS);
    for (int item = blockIdx.x; item < 384; item += gridDim.x) {
        const int l = item / 96, n0 = (item % 96) * 64, kg = tid >> 6, c = tid & 63;
        const float* W = KIN(I_ADAW) + (size_t)l * 1024 * 6144 + n0 + c;
        float acc[9];
#pragma unroll
        for (int r = 0; r < 9; ++r) acc[r] = 0.f;
#pragma unroll 8
        for (int kk = 0; kk < 128; ++kk) { const int k = kg * 128 + kk; const float w = __builtin_nontemporal_load(W + (size_t)k * 6144);
#pragma unroll
            for (int r = 0; r < 9; ++r) acc[r] += S[r * 1024 + k] * w; }
#pragma unroll
        for (int r = 0; r < 9; ++r) red[(kg * 9 + r) * 64 + c] = acc[r];
        __syncthreads();
        for (int o = tid; o < 576; o += 512) { const int r = o >> 6, cc = o & 63; float s = 0.f;
#pragma unroll
            for (int k2 = 0; k2 < 8; ++k2) s += red[(k2 * 9 + r) * 64 + cc];
            MODS[(size_t)(l * 9 + r) * 6144 + n0 + cc] = s + KIN(I_ADAB)[l * 6144 + n0 + cc]; }
        __syncthreads();
    }
}

DI void tr_item(const float* W, int K, int N, bf16_t* WT, int k0, int n0, int drow0, const float* kscale, float* scr, int lane) {
#pragma unroll 8
    for (int i = 0; i < 32; ++i) { const int kk = 2 * i + (lane >> 5); float v = __builtin_nontemporal_load(W + (size_t)(k0 + kk) * N + n0 + (lane & 31)); if (kscale) v *= kscale[k0 + kk]; scr[kk * 33 + (lane & 31)] = v; }
    asm volatile("s_waitcnt lgkmcnt(0)" ::: "memory");
    const int c = lane & 7;
#pragma unroll
    for (int j = 0; j < 4; ++j) { const int n = (lane >> 3) + 8 * j; const float* s = scr + (8 * c) * 33 + n;
        u32x4 o; o.x = pk2(s[0 * 33], s[1 * 33]); o.y = pk2(s[2 * 33], s[3 * 33]); o.z = pk2(s[4 * 33], s[5 * 33]); o.w = pk2(s[6 * 33], s[7 * 33]);
        *(u32x4*)(WT + (size_t)(drow0 + n) * K + k0 + 8 * c) = o; }
    asm volatile("s_waitcnt lgkmcnt(0)" ::: "memory");
}
DI void convert_weights(const Params& p, int l, unsigned char* lds) {
    asm volatile("" : "+s"(l));
    const int tid = ltid(), wave = tid >> 6, lane = tid & 63; const int gw = blockIdx.x * 8 + wave, NGW = gridDim.x * 8;
    float* scr = (float*)lds + wave * 2112;
    bf16_t* Wb = (bf16_t*)(KWS + OFF_W);
    bf16_t* WT_IN = Wb + W_IN / 2; bf16_t* WT_OUT = Wb + W_OUT / 2; bf16_t* WT_F1 = Wb + W_F1 / 2; bf16_t* WT_F2 = Wb + W_F2 / 2; bf16_t* WT_UQ = Wb + W_UQ / 2; bf16_t* WT_UKV = Wb + W_UKV / 2;
    for (int it = gw; it < 6192; it += NGW) {
        int r = it;
        if (r < 1376) { tr_item(KIN(I_WIN) + (size_t)l * 1024 * INW, 1024, INW, WT_IN, 64 * (r / 86), 32 * (r % 86), 32 * (r % 86), nullptr, scr, lane); continue; } r -= 1376;
        if (r < 512) { tr_item(KIN(I_WOUT) + (size_t)l * 1024 * 1024, 1024, 1024, WT_OUT, 64 * (r / 32), 32 * (r % 32), 32 * (r % 32), nullptr, scr, lane); continue; } r -= 512;
        if (r < 2816) { const int n0 = 32 * (r % 176); const int j = n0 < FFH ? n0 : n0 - FFH; const int drow = 256 * (j / 128) + (j % 128) + (n0 < FFH ? 0 : 128);
            tr_item(KIN(I_FIN) + (size_t)l * 1024 * 5632, 1024, 5632, WT_F1, 64 * (r / 176), n0, drow, nullptr, scr, lane); continue; } r -= 2816;
        if (r < 1408) { tr_item(KIN(I_FOUT) + (size_t)l * FFH * 1024, FFH, 1024, WT_F2, 64 * (r / 32), 32 * (r % 32), 32 * (r % 32), nullptr, scr, lane); continue; } r -= 1408;
        if (r < 48) { tr_item(KIN(I_WUQ) + (size_t)l * 256 * 384, 256, 384, WT_UQ, 64 * (r / 12), 32 * (r % 12), 32 * (r % 12), KIN(I_MQN) + l * 256, scr, lane); continue; } r -= 48;
        tr_item(KIN(I_WUKV) + (size_t)l * 128 * 512, 128, 512, WT_UKV, 64 * (r / 16), 32 * (r % 16), 32 * (r % 16), KIN(I_MKVN) + l * 128, scr, lane);
    }
    const size_t gt = (size_t)blockIdx.x * 512 + tid, gn = (size_t)gridDim.x * 512; unsigned zz = 0u; asm volatile("" : "+v"(zz)); const u32x4 z = {zz, zz, zz, zz};
    for (size_t i = gt; i < 8192; i += gn) ((u32x4*)(WT_IN + (size_t)INW * 1024))[i] = z;
    for (size_t i = gt; i < 4096; i += gn) ((u32x4*)(WT_UQ + (size_t)384 * 256))[i] = z;
}

DI void rowpass(int row_begin, int row_end, int vblock, int vgrid, const float* xinL, const float* xinC, float* xoutL, float* xoutC, const bf16_t* Y, const float* mgate, const float* gpost,
                bf16_t* H, const float* gpre, const float* mshift, const float* mscale) {
    const int tid = ltid(), wave = tid >> 6, lane = tid & 63; const int gw = vblock * 8 + wave, NGW = vgrid * 8;
    f32x4 vn[4]; u32x2 yn[4];
    auto fetch = [&](int row) {
        const float* xr = row < ML ? xinL + (size_t)row * DM : xinC + (size_t)(row - ML) * DM;
#pragma unroll
        for (int j = 0; j < 4; ++j) vn[j] = __builtin_nontemporal_load((const f32x4*)(xr + 4 * lane + 256 * j));
        if (Y) {
#pragma unroll
            for (int j = 0; j < 4; ++j) yn[j] = __builtin_nontemporal_load((const u32x2*)(Y + (size_t)row * DM + 4 * lane + 256 * j)); }
    };
    f32x4 gpo[4], gpr[4], gat[4], shf[4], scl[4];
#pragma unroll
    for (int j = 0; j < 4; ++j) { gpo[j] = Y ? *(const f32x4*)(gpost + 4 * lane + 256 * j) : (f32x4){0.f, 0.f, 0.f, 0.f}; gpr[j] = H ? *(const f32x4*)(gpre + 4 * lane + 256 * j) : (f32x4){0.f, 0.f, 0.f, 0.f};
        gat[j] = gpo[j]; shf[j] = gpo[j]; scl[j] = gpo[j]; }
    int mb_cur = -1;
    int row = row_begin + gw;
    if (row < row_end) fetch(row);
    for (; row < row_end; row += NGW) {
        const int mb = row < ML ? (row >> 12) : 8;
        f32x4 v[4]; u32x2 yw[4];
#pragma unroll
        for (int j = 0; j < 4; ++j) { v[j] = vn[j]; yw[j] = yn[j]; }
        if (row + NGW < row_end) fetch(row + NGW);
        if (mb != mb_cur) {
            mb_cur = mb;
#pragma unroll
            for (int j = 0; j < 4; ++j) { const int c = 4 * lane + 256 * j;
                if (Y) gat[j] = *(const f32x4*)(mgate + (size_t)mb * 6144 + c);
                if (H) { shf[j] = *(const f32x4*)(mshift + (size_t)mb * 6144 + c); scl[j] = *(const f32x4*)(mscale + (size_t)mb * 6144 + c) + 1.f; } }
        }
        if (Y) {
            f32x4 y[4]; float ss = 0.f;
#pragma unroll
            for (int j = 0; j < 4; ++j) { const u32x2 w = yw[j]; y[j] = (f32x4){bflo(w.x), bfhi(w.x), bflo(w.y), bfhi(w.y)};
                ss += (y[j][0] * y[j][0] + y[j][1] * y[j][1]) + (y[j][2] * y[j][2] + y[j][3] * y[j][3]); }
            const float ry = rsqrtf(wave_sum(ss) * (1.f / DM) + EPS);
            float* xo = row < ML ? xoutL + (size_t)row * DM : xoutC + (size_t)(row - ML) * DM;
#pragma unroll
            for (int j = 0; j < 4; ++j) { v[j] = v[j] + gat[j] * (y[j] * ry * gpo[j]); __builtin_nontemporal_store(v[j], (f32x4*)(xo + 4 * lane + 256 * j)); }
        }
        if (H) {
            float ss = 0.f;
#pragma unroll
            for (int j = 0; j < 4; ++j) ss += (v[j][0] * v[j][0] + v[j][1] * v[j][1]) + (v[j][2] * v[j][2] + v[j][3] * v[j][3]);
            const float rx = rsqrtf(wave_sum(ss) * (1.f / DM) + EPS);
#pragma unroll
            for (int j = 0; j < 4; ++j) { const int c = 4 * lane + 256 * j;
                const f32x4 hv = v[j] * rx * gpr[j] * scl[j] + shf[j]; u32x2 w; w.x = pk2(hv[0], hv[1]); w.y = pk2(hv[2], hv[3]); *(u32x2*)(H + (size_t)row * DM + c) = w; }
        }
    }
}

template <int TYPE>
DI void attn_unit(const Params& p, unsigned char* lds, int l, int b, int hd, int qrow0, int NT) {
    asm volatile("" : "+s"(l), "+s"(b), "+s"(hd), "+s"(qrow0), "+s"(NT));
    constexpr int NMAP = TYPE == 0 ? 2 : 1, KS = TYPE == 0 ? 2 : 6, DQ = NMAP * KS * 16, KP = DQ + 8, CPR = DQ / 8;
    constexpr int TK = TYPE == 0 ? 64 : 128, VP = TK + 8, KCH = TK * CPR / 512, VCPR = TK / 8, VCH = 64 * VCPR / 512;
    const int tid = ltid(), lane = tid & 63, w = tid >> 6, r32 = lane & 31, h = lane >> 5;
    bf16_t* Kl = (bf16_t*)lds;
    bf16_t* Vl = (bf16_t*)(lds + 2 * TK * KP * 2);
    const bf16_t* PROJ = (const bf16_t*)(KWS + OFF_PA);
    const bf16_t* MQ = (const bf16_t*)(KWS + OFF_MLAQ);
    const bf16_t* MK = (const bf16_t*)(KWS + OFF_MLAK);
    const bf16_t* VTb = (const bf16_t*)(KWS + OFF_VT) + ((size_t)((TYPE * NB + b) * 4 + hd) * 64) * POSN;
    bf16_t* CC = (bf16_t*)(KWS + OFF_HC);
    bf16x8 qf[NMAP][KS];
    const int qrow = qrow0 + 32 * w + r32;
#pragma unroll
    for (int mp = 0; mp < NMAP; ++mp)
#pragma unroll
        for (int s = 0; s < KS; ++s)
            qf[mp][s] = TYPE == 0 ? *(const bf16x8*)(PROJ + (size_t)qrow * INWP + 64 * hd + mp * 32 + 16 * s + 8 * h)
                                  : *(const bf16x8*)(MQ + (size_t)qrow * 384 + 96 * hd + 16 * s + 8 * h);
    float mrun[NMAP], lsum[NMAP]; f32x16 o[NMAP][2];
#pragma unroll
    for (int mp = 0; mp < NMAP; ++mp) { mrun[mp] = 0.f; lsum[mp] = 0.f;
#pragma unroll
        for (int i = 0; i < 16; ++i) { o[mp][0][i] = 0.f; o[mp][1][i] = 0.f; } }
    u32x4 kreg[KCH], vreg[VCH];
    auto gload = [&](int t) {
#pragma unroll
        for (int i = 0; i < KCH; ++i) { const int c = tid + 512 * i, kr = c / CPR, cc = c % CPR; const int grow = pos_row(b, TK * t + kr);
            if (TYPE == 0) kreg[i] = *(const u32x4*)(PROJ + (size_t)grow * INWP + 256 + 64 * hd + 8 * cc);
            else kreg[i] = cc < 8 ? *(const u32x4*)(MK + (size_t)grow * 256 + 64 * hd + 8 * cc) : *(const u32x4*)(PROJ + (size_t)grow * INWP + 1152 + 8 * (cc - 8)); }
#pragma unroll
        for (int i = 0; i < VCH; ++i) { const int c = tid + 512 * i, e = c / VCPR, jc = c % VCPR; vreg[i] = *(const u32x4*)(VTb + (size_t)e * POSN + TK * t + 8 * jc); }
    };
    auto lstore = [&](int buf) {
#pragma unroll
        for (int i = 0; i < KCH; ++i) { const int c = tid + 512 * i, kr = c / CPR, cc = c % CPR; *(u32x4*)(Kl + (size_t)buf * TK * KP + kr * KP + 8 * cc) = kreg[i]; }
#pragma unroll
        for (int i = 0; i < VCH; ++i) { const int c = tid + 512 * i, e = c / VCPR, jc = c % VCPR; *(u32x4*)(Vl + (size_t)buf * 64 * VP + e * VP + 8 * jc) = vreg[i]; }
    };
    const int NTI = NT * 64 / TK;
    gload(0); lstore(0); __syncthreads();
    bool shifted = false;
    for (int t = 0; t < NTI; ++t) {
        const int buf = t & 1;
        if (t + 1 < NTI) gload(t + 1);
        const bf16_t* Kb = Kl + (size_t)buf * TK * KP; const bf16_t* Vb = Vl + (size_t)buf * 64 * VP;
        bf16x8 pbd[2][4];
        f32x16 a0, a1, b0, b1;
        auto kfrag = [&](int st, int half, int s) { return TYPE == 0 ? *(const bf16x8*)(Kb + (32 * half + r32) * KP + st * 32 + 16 * s + 8 * h)
                                                                       : *(const bf16x8*)(Kb + (64 * st + 32 * half + r32) * KP + 16 * s + 8 * h); };
        auto vfrag = [&](int st, int eb, int s) { return *(const bf16x8*)(Vb + (32 * eb + r32) * VP + (TYPE == 0 ? 0 : 64 * st) + 16 * s + 8 * h); };
        auto sub_ref = [&](f32x16& x0, f32x16& x1, int mi) {
            if (__builtin_expect(shifted, 0)) { asm volatile("" ::: "memory");
#pragma unroll
                for (int i = 0; i < 16; ++i) { x0[i] -= mrun[mi]; x1[i] -= mrun[mi]; } } };
        auto pack8 = [&](const f32x16& x, int base) { u32x4 tt; tt.x = pk2(x[base], x[base + 1]); tt.y = pk2(x[base + 2], x[base + 3]); tt.z = pk2(x[base + 4], x[base + 5]); tt.w = pk2(x[base + 6], x[base + 7]); return __builtin_bit_cast(bf16x8, tt); };
        auto slow = [&](int st, f32x16& x0, f32x16& x1, float& ps) {
            const int mi = TYPE == 0 ? st : 0;
#pragma unroll
            for (int i = 0; i < 16; ++i) { x0[i] = 0.f; x1[i] = 0.f; }
#pragma unroll
            for (int s2 = 0; s2 < KS; ++s2) { x0 = MFMA32(kfrag(st, 0, s2), qf[mi][s2], x0); x1 = MFMA32(kfrag(st, 1, s2), qf[mi][s2], x1); }
            sub_ref(x0, x1, mi);
            float tm = fmaxf(x0[0], x1[0]);
#pragma unroll
            for (int i = 1; i < 16; ++i) tm = fmaxf(tm, fmaxf(x0[i], x1[i]));
            tm = fmaxf(tm, __shfl_xor(tm, 32));
            const bool first = (t == 0) && (TYPE == 0 || st == 0);
            const float dl = first ? tm : fmaxf(tm, 0.f);
            mrun[mi] += dl;
            if (!first) { const float alpha = __builtin_amdgcn_exp2f(-dl); lsum[mi] *= alpha;
#pragma unroll
                for (int i = 0; i < 16; ++i) { o[mi][0][i] *= alpha; o[mi][1][i] *= alpha; } }
            ps = 0.f;
#pragma unroll
            for (int i = 0; i < 16; ++i) { x0[i] = __builtin_amdgcn_exp2f(x0[i] - dl); x1[i] = __builtin_amdgcn_exp2f(x1[i] - dl); ps += x0[i] + x1[i]; }
            shifted = true;
        };
        constexpr int M0 = 0, M1 = TYPE == 0 ? 1 : 0;
#pragma unroll
        for (int i = 0; i < 16; ++i) { a0[i] = 0.f; a1[i] = 0.f; b0[i] = 0.f; b1[i] = 0.f; }
#pragma unroll
        for (int s2 = 0; s2 < KS; ++s2) { a0 = MFMA32(kfrag(0, 0, s2), qf[M0][s2], a0); a1 = MFMA32(kfrag(0, 1, s2), qf[M0][s2], a1); }
        sub_ref(a0, a1, M0);
        float psa = 0.f;
#pragma unroll
        for (int n = 0; n < 2 * KS; ++n) {
            if (n & 1) b1 = MFMA32(kfrag(1, 1, n >> 1), qf[M1][n >> 1], b1); else b0 = MFMA32(kfrag(1, 0, n >> 1), qf[M1][n >> 1], b0);
#pragma unroll
            for (int r = (32 * n) / (2 * KS); r < (32 * (n + 1)) / (2 * KS); ++r) {
                if (r < 16) { a0[r] = __builtin_amdgcn_exp2f(a0[r]); psa += a0[r]; } else { a1[r - 16] = __builtin_amdgcn_exp2f(a1[r - 16]); psa += a1[r - 16]; } }
        }
        {   const bool firstA = (t == 0);
            if (__builtin_expect(__any(!(psa <= 1e13f) || (firstA && psa < 1e-13f)), 0)) slow(0, a0, a1, psa); }
        lsum[M0] += psa;
        pbd[0][0] = pack8(a0, 0); pbd[0][1] = pack8(a0, 8); pbd[0][2] = pack8(a1, 0); pbd[0][3] = pack8(a1, 8);
        sub_ref(b0, b1, M1);
        float psb = 0.f;
#pragma unroll
        for (int eb = 0; eb < 2; ++eb)
#pragma unroll
            for (int s2 = 0; s2 < 4; ++s2) {
                o[M0][eb] = MFMA32(vfrag(0, eb, s2), pbd[0][s2], o[M0][eb]);
                const int q4 = (eb * 4 + s2) * 4;
#pragma unroll
                for (int i = 0; i < 4; ++i) { const int r = q4 + i; if (r < 16) { b0[r] = __builtin_amdgcn_exp2f(b0[r]); psb += b0[r]; } else { b1[r - 16] = __builtin_amdgcn_exp2f(b1[r - 16]); psb += b1[r - 16]; } }
            }
        {   const bool firstB = (t == 0) && TYPE == 0;
            if (__builtin_expect(__any(!(psb <= 1e13f) || (firstB && psb < 1e-13f)), 0)) slow(1, b0, b1, psb); }
        lsum[M1] += psb;
        pbd[1][0] = pack8(b0, 0); pbd[1][1] = pack8(b0, 8); pbd[1][2] = pack8(b1, 0); pbd[1][3] = pack8(b1, 8);
#pragma unroll
        for (int eb = 0; eb < 2; ++eb)
#pragma unroll
            for (int s2 = 0; s2 < 4; ++s2) o[M1][eb] = MFMA32(vfrag(1, eb, s2), pbd[1][s2], o[M1][eb]);
        if (t + 1 < NTI) lstore(buf ^ 1);
        __syncthreads();
    }
    float inv[NMAP];
#pragma unroll
    for (int mp = 0; mp < NMAP; ++mp) { const float lt = lsum[mp] + __shfl_xor(lsum[mp], 32); inv[mp] = 1.f / lt; }
    if (TYPE == 1) {
        bf16_t* op = CC + (size_t)qrow * DM + 256 + 64 * hd;
#pragma unroll
        for (int eb = 0; eb < 2; ++eb)
#pragma unroll
            for (int g = 0; g < 4; ++g) { const f32x4 v = {o[0][eb][4 * g] * inv[0], o[0][eb][4 * g + 1] * inv[0], o[0][eb][4 * g + 2] * inv[0], o[0][eb][4 * g + 3] * inv[0]};
                pg8::store4(op + 32 * eb + 8 * g + 4 * h, v); }
    } else {
        int l2 = l; asm volatile("" : "+s"(l2));
        const float* dl = opq2(KIN(I_DLAM)) + l2 * 128; float d1 = 0.f, d2 = 0.f;
        for (int i = 0; i < 32; ++i) { d1 += dl[i] * dl[32 + i]; d2 += dl[64 + i] * dl[96 + i]; }
        float c08 = 0.8f, c06 = 0.6f; asm volatile("" : "+v"(c08), "+v"(c06));
        const float lam_init = c08 - c06 * __expf(-0.3f * (float)l2);
        const float lam = __expf(d1) - __expf(d2) + lam_init;
        const float* sg = opq2(KIN(I_DNORM)) + l2 * 64;
        float ss = 0.f; const float li1 = lam * inv[NMAP - 1];
#pragma unroll
        for (int eb = 0; eb < 2; ++eb)
#pragma unroll
            for (int i = 0; i < 16; ++i) { const float v = o[0][eb][i] * inv[0] - li1 * o[NMAP - 1][eb][i]; o[0][eb][i] = v; ss += v * v; }
        ss += __shfl_xor(ss, 32);
        const float rn = rsqrtf(ss * (1.f / 64.f) + EPS) * (1.f - lam_init);
        bf16_t* op = CC + (size_t)qrow * DM + 64 * hd;
#pragma unroll
        for (int eb = 0; eb < 2; ++eb)
#pragma unroll
            for (int g = 0; g < 4; ++g) { const int e0 = 32 * eb + 8 * g + 4 * h; const f32x4 gg = *(const f32x4*)(sg + e0);
                const f32x4 v = {o[0][eb][4 * g] * rn * gg[0], o[0][eb][4 * g + 1] * rn * gg[1], o[0][eb][4 * g + 2] * rn * gg[2], o[0][eb][4 * g + 3] * rn * gg[3]};
                pg8::store4(op + e0, v); }
    }
}

DI void scan_unit(const Params& p, unsigned char* lds, int l, int mixer, int b, int hd, int item) {
    asm volatile("" : "+s"(l), "+s"(mixer), "+s"(b), "+s"(hd), "+s"(item));
    const int tid = ltid(), dir = tid >> 8, td = tid & 255, lane = tid & 63, wd = (tid >> 6) & 3, r32 = lane & 31, h = lane >> 5;
    unsigned char* L = lds + dir * 55296;
    bf16_t* QT = (bf16_t*)(L);
    bf16_t* KT = (bf16_t*)(L + 5120);
    bf16_t* KH = (bf16_t*)(L + 10240);
    bf16_t* ST = (bf16_t*)(L + 14848);
    bf16_t* VTt = (bf16_t*)(L + 19968);
    bf16_t* SC = (bf16_t*)(L + 29184);
    float* OL = (float*)(L + 19968);
    float* BB = (float*)(L + 38400);
    float* SEG = (float*)(L + 46592);
    float* BEND = (float*)(L + 47616);
    float* WG = (float*)(L + 47744);
    float* GT = (float*)(L + 49920);
    const bf16_t* PROJ = (const bf16_t*)(KWS + OFF_PA);
    bf16_t* CC = (bf16_t*)(KWS + OFF_HC);
    float* OTMP = (float*)(KWS + OFF_Y) + (size_t)item * 68 * 4096;
    const int qcol = (mixer == 0 ? 1184 : 1984) + 32 * hd, kcol = (mixer == 0 ? 1312 : 2112) + 32 * hd, ogcol = (mixer == 0 ? 1696 : 2496) + 64 * hd;
    const int ccol = 512 + 256 * mixer + 64 * hd;
    const bf16_t* VTb = (const bf16_t*)(KWS + OFF_VT) + ((size_t)(((mixer == 0 ? 2 : 3) * NB + b) * 4 + hd) * 64) * POSN;
    const float* og = (mixer == 0 ? KIN(I_GNORM) : KIN(I_RNORM)) + l * 64;
    float lg = 0.f;
    float ogr[16];
#pragma unroll
    for (int i = 0; i < 16; ++i) ogr[i] = og[16 * (td & 3) + i];
    float wg[16], wb = 0.f;
#pragma unroll
    for (int r = 0; r < 16; ++r) wg[r] = 0.f;
    if (mixer == 0) {
        const float* gw = KIN(I_GWG) + (size_t)((l * 2 + dir) * 16) * 128 + 32 * hd + (td & 31);
#pragma unroll
        for (int r = 0; r < 16; ++r) wg[r] = gw[r * 128];
        wb = KIN(I_GBG)[(l * 2 + dir) * 128 + 32 * hd + (td & 31)];
    } else lg = logsig_f(KIN(I_RDEC)[(l * 2 + dir) * 4 + hd]);
    for (int idx = td; idx < 64 * 40; idx += 256) ST[idx] = 0;
    f32x16 Sacc;
#pragma unroll
    for (int i = 0; i < 16; ++i) Sacc[i] = 0.f;
    u32x4 qreg, kreg, vreg0, vreg1, greg;
    auto chunk_of = [&](int s) { return dir == 0 ? s : (s < 4 ? 3 - s : 71 - s); };
    auto chunk_row0 = [&](int g) { return g < 4 ? ML + b * CTXL + 64 * g : b * SEQL + 64 * (g - 4); };
    auto gload = [&](int s) {
        const int g = chunk_of(s), row0 = chunk_row0(g);
        qreg = *(const u32x4*)(PROJ + (size_t)(row0 + (td >> 2)) * INWP + qcol + 8 * (td & 3));
        kreg = *(const u32x4*)(PROJ + (size_t)(row0 + (td >> 2)) * INWP + kcol + 8 * (td & 3));
        vreg0 = *(const u32x4*)(VTb + (size_t)(td >> 3) * POSN + 64 * g + 8 * (td & 7));
        vreg1 = *(const u32x4*)(VTb + (size_t)(32 + (td >> 3)) * POSN + 64 * g + 8 * (td & 7));
        if (mixer == 0 && td < 128) greg = *(const u32x4*)(PROJ + (size_t)(row0 + (td >> 1)) * INWP + 1952 + 16 * dir + 8 * (td & 1));
    };
    gload(0);
    __syncthreads();
    for (int s = 0; s < 68; ++s) {
        const int g = chunk_of(s), row0 = chunk_row0(g);
        *(u32x4*)(VTt + (td >> 3) * 72 + 8 * (td & 7)) = vreg0;
        *(u32x4*)(VTt + (32 + (td >> 3)) * 72 + 8 * (td & 7)) = vreg1;
        if (mixer == 0 && td < 128) { float* gp = GT + (td >> 1) * 16 + 8 * (td & 1);
            gp[0] = bflo(greg.x); gp[1] = bfhi(greg.x); gp[2] = bflo(greg.y); gp[3] = bfhi(greg.y); gp[4] = bflo(greg.z); gp[5] = bfhi(greg.z); gp[6] = bflo(greg.w); gp[7] = bfhi(greg.w); }
        const u32x4 qc = qreg, kc = kreg;
        if (s + 1 < 68) gload(s + 1);
        const int s_other = dir == 0 ? (g < 4 ? 3 - g : 71 - g) : g;
        const bool fin = s_other < s;
        float* ot = OTMP + (size_t)g * 4096 + (td >> 2) * 64 + 16 * (td & 3);
        f32x4 pf0, pf1, pf2, pf3; u32x4 g0, g1;
        LBAR();
        { const int d = td & 31, seg = td >> 5; float a[8];
          if (mixer == 0) {
#pragma unroll
              for (int i = 0; i < 8; ++i) { const float* gr = GT + (8 * seg + i) * 16;
                  const f32x4 x0 = *(const f32x4*)gr, x1 = *(const f32x4*)(gr + 4), x2 = *(const f32x4*)(gr + 8), x3 = *(const f32x4*)(gr + 12);
                  float acc = wb;
                  acc += x0[0] * wg[0]; acc += x0[1] * wg[1]; acc += x0[2] * wg[2]; acc += x0[3] * wg[3];
                  acc += x1[0] * wg[4]; acc += x1[1] * wg[5]; acc += x1[2] * wg[6]; acc += x1[3] * wg[7];
                  acc += x2[0] * wg[8]; acc += x2[1] * wg[9]; acc += x2[2] * wg[10]; acc += x2[3] * wg[11];
                  acc += x3[0] * wg[12]; acc += x3[1] * wg[13]; acc += x3[2] * wg[14]; acc += x3[3] * wg[15];
                  a[i] = logsig_f(acc) * (1.f / 16.f); }
          } else {
#pragma unroll
              for (int i = 0; i < 8; ++i) a[i] = lg;
          }
          float run = 0.f;
          if (dir == 0) {
#pragma unroll
              for (int i = 0; i < 8; ++i) { run += a[i]; a[i] = run; }
          } else {
#pragma unroll
              for (int i = 7; i >= 0; --i) { run += a[i]; a[i] = run; }
          }
          SEG[seg * 32 + d] = run;
          LBAR();
          float off = 0.f, tot = 0.f;
#pragma unroll
          for (int s2 = 0; s2 < 8; ++s2) { const float sv = SEG[s2 * 32 + d]; tot += sv; if (dir == 0 ? (s2 < seg) : (s2 > seg)) off += sv; }
#pragma unroll
          for (int i = 0; i < 8; ++i) BB[(8 * seg + i) * 32 + d] = a[i] + off;
          if (seg == 0) { BEND[d] = tot; BEND[32 + d] = __expf(tot); } }
        LBAR();
        { const int j = td >> 2, cc = td & 3;
          float qv[8] = {bflo(qc.x), bfhi(qc.x), bflo(qc.y), bfhi(qc.y), bflo(qc.z), bfhi(qc.z), bflo(qc.w), bfhi(qc.w)};
          float kv[8] = {bflo(kc.x), bfhi(kc.x), bflo(kc.y), bfhi(kc.y), bflo(kc.z), bfhi(kc.z), bflo(kc.w), bfhi(kc.w)};
          float k1[8];
#pragma unroll
          for (int i = 0; i < 8; ++i) { const int d = 8 * cc + i; const float bv = BB[j * 32 + d], ee = BEND[32 + d];
              const float eb = __expf(bv), en = __builtin_amdgcn_rcpf(eb); qv[i] *= eb; k1[i] = kv[i] * en; KH[d * 72 + ((j & ~12) | ((j & 4) << 1) | ((j & 8) >> 1))] = (bf16_t)f2bf(kv[i] * (ee * en)); }
          u32x4 wq, wk; wq.x = pk2(qv[0], qv[1]); wq.y = pk2(qv[2], qv[3]); wq.z = pk2(qv[4], qv[5]); wq.w = pk2(qv[6], qv[7]);
          wk.x = pk2(k1[0], k1[1]); wk.y = pk2(k1[2], k1[3]); wk.z = pk2(k1[4], k1[5]); wk.w = pk2(k1[6], k1[7]);
          *(u32x4*)(QT + j * 40 + 8 * cc) = wq; *(u32x4*)(KT + j * 40 + 8 * cc) = wk; }
        __syncthreads();
        if (fin) { pf0 = *(const f32x4*)(ot); pf1 = *(const f32x4*)(ot + 4); pf2 = *(const f32x4*)(ot + 8); pf3 = *(const f32x4*)(ot + 12);
            const bf16_t* gp = PROJ + (size_t)(row0 + (td >> 2)) * INWP + ogcol + 16 * (td & 3); g0 = *(const u32x4*)gp; g1 = *(const u32x4*)(gp + 8); }
        { const int jb = wd >> 1, ib = wd & 1; const bool skip = dir == 0 ? (jb > ib) : (jb < ib);
          f32x16 pa;
#pragma unroll
          for (int i = 0; i < 16; ++i) pa[i] = 0.f;
          if (!skip) {
#pragma unroll
              for (int s2 = 0; s2 < 2; ++s2) { const bf16x8 a = *(const bf16x8*)(KT + (32 * jb + r32) * 40 + 16 * s2 + 8 * h), bq = *(const bf16x8*)(QT + (32 * ib + r32) * 40 + 16 * s2 + 8 * h);
                  pa = MFMA32(a, bq, pa); }
          }
          const int itok = 32 * ib + r32;
#pragma unroll
          for (int gq = 0; gq < 4; ++gq) { f32x4 v;
#pragma unroll
              for (int i = 0; i < 4; ++i) { const int j = 32 * jb + 8 * gq + 4 * h + i; const bool keep = dir == 0 ? (j <= itok) : (j >= itok); v[i] = keep ? pa[4 * gq + i] : 0.f; }
              pg8::store4(SC + itok * 72 + 32 * jb + 16 * (gq >> 1) + 8 * h + 4 * (gq & 1), v); } }
        LBAR();
        f32x16 oacc;
        { const int eb = wd >> 1, ib = wd & 1;
#pragma unroll
          for (int i = 0; i < 16; ++i) oacc[i] = 0.f;
#pragma unroll
          for (int s2 = 0; s2 < 4; ++s2) { const bf16x8 a = *(const bf16x8*)(VTt + (32 * eb + r32) * 72 + 16 * s2 + 8 * h), bb = *(const bf16x8*)(SC + (32 * ib + r32) * 72 + 16 * s2 + 8 * h);
              oacc = MFMA32(a, bb, oacc); }
#pragma unroll
          for (int s2 = 0; s2 < 2; ++s2) { const bf16x8 a = *(const bf16x8*)(ST + (32 * eb + r32) * 40 + 16 * s2 + 8 * h), bb = *(const bf16x8*)(QT + (32 * ib + r32) * 40 + 16 * s2 + 8 * h);
              oacc = MFMA32(a, bb, oacc); }
          if (wd < 2) { const float dec = BEND[32 + r32];
#pragma unroll
              for (int i = 0; i < 16; ++i) Sacc[i] *= dec;
#pragma unroll
              for (int s2 = 0; s2 < 4; ++s2) { const bf16x8 a = *(const bf16x8*)(VTt + (32 * wd + r32) * 72 + 16 * s2 + 8 * h), bb = *(const bf16x8*)(KH + r32 * 72 + 16 * s2 + 8 * h);
                  Sacc = MFMA32(a, bb, Sacc); } } }
        LBAR();
        { const int eb = wd >> 1, ib = wd & 1;
#pragma unroll
          for (int gq = 0; gq < 4; ++gq) *(f32x4*)(OL + (32 * ib + r32) * 68 + 32 * eb + 8 * gq + 4 * h) = (f32x4){oacc[4 * gq], oacc[4 * gq + 1], oacc[4 * gq + 2], oacc[4 * gq + 3]};
          if (wd < 2) {
#pragma unroll
              for (int i = 0; i < 16; ++i) ST[(32 * wd + crow(i, h)) * 40 + r32] = (bf16_t)f2bf(Sacc[i]); } }
        LBAR();
        { const int j = td >> 2, e0 = 16 * (td & 3); float ov[16];
#pragma unroll
          for (int q4 = 0; q4 < 4; ++q4) { const f32x4 v = *(const f32x4*)(OL + j * 68 + e0 + 4 * q4); ov[4 * q4] = v[0]; ov[4 * q4 + 1] = v[1]; ov[4 * q4 + 2] = v[2]; ov[4 * q4 + 3] = v[3]; }
          if (fin) {
              float ss = 0.f;
              const float pv[16] = {pf0[0], pf0[1], pf0[2], pf0[3], pf1[0], pf1[1], pf1[2], pf1[3], pf2[0], pf2[1], pf2[2], pf2[3], pf3[0], pf3[1], pf3[2], pf3[3]};
#pragma unroll
              for (int i = 0; i < 16; ++i) { ov[i] += pv[i]; ss += ov[i] * ov[i]; }
              ss += __shfl_xor(ss, 1); ss += __shfl_xor(ss, 2);
              const float rn = rsqrtf(ss * (1.f / 64.f) + EPS);
              const int row = row0 + j;
              const float gv[16] = {bflo(g0.x), bfhi(g0.x), bflo(g0.y), bfhi(g0.y), bflo(g0.z), bfhi(g0.z), bflo(g0.w), bfhi(g0.w),
                                    bflo(g1.x), bfhi(g1.x), bflo(g1.y), bfhi(g1.y), bflo(g1.z), bfhi(g1.z), bflo(g1.w), bfhi(g1.w)};
              float r[16];
#pragma unroll
              for (int i = 0; i < 16; ++i) r[i] = ov[i] * rn * ogr[i] * silu_f(gv[i]);
              u32x4 w0, w1; w0.x = pk2(r[0], r[1]); w0.y = pk2(r[2], r[3]); w0.z = pk2(r[4], r[5]); w0.w = pk2(r[6], r[7]);
              w1.x = pk2(r[8], r[9]); w1.y = pk2(r[10], r[11]); w1.z = pk2(r[12], r[13]); w1.w = pk2(r[14], r[15]);
              *(u32x4*)(CC + (size_t)row * DM + ccol + e0) = w0; *(u32x4*)(CC + (size_t)row * DM + ccol + e0 + 8) = w1;
          } else {
#pragma unroll
              for (int q4 = 0; q4 < 4; ++q4) *(f32x4*)(ot + 4 * q4) = (f32x4){ov[4 * q4], ov[4 * q4 + 1], ov[4 * q4 + 2], ov[4 * q4 + 3]};
          } }
        LBAR();
    }
    __syncthreads();
}

DI void mixer_phase(const Params& p, unsigned char* lds, int l, int rep) {
    asm volatile("" : "+s"(l));
    const int tid = ltid();
    unsigned* ctr = (unsigned*)(KWS + OFF_CTL) + 64 * (l + 1 + 4 * rep);
    volatile int* s_item = (volatile int*)(lds + LDS_CTL_OFF);
    const bool with_ctx = l < NLAYER - 1;
    const int nitems = 64 + 1024 + (with_ctx ? 64 : 0);
    for (;;) {
        if (tid == 0) *s_item = (int)atomicAdd(ctr, 1u);
        __syncthreads();
        const int it = __builtin_amdgcn_readfirstlane(*s_item);
        __syncthreads();
        if (it >= nitems) break;
        if (rep > 0 && ((REP_MIX_ONLY == 1 && it >= 64) || (REP_MIX_ONLY == 2 && it < 64))) continue;
        if (it < 64) { if (PH(11)) scan_unit(p, lds, l, it >> 5, (it >> 2) & 7, it & 3, it); }
        else { int type, b, hd, qrow0, NT;
            if (it < 64 + 1024) { const int u = it - 64, rem = u & 511, qb = rem & 15; type = u >> 9; b = rem >> 6; hd = (rem >> 4) & 3; qrow0 = b * SEQL + 256 * qb; NT = POSN / 64; }
            else { const int u = it - 1088; type = u >> 5; b = (u >> 2) & 7; hd = u & 3; qrow0 = ML + b * CTXL; NT = CTXL / 64; }
            if (type == 0) { if (PH(12)) attn_unit<0>(p, lds, l, b, hd, qrow0, NT); } else { if (PH(13)) attn_unit<1>(p, lds, l, b, hd, qrow0, NT); } }
    }
}

#define LAS __attribute__((address_space(3)))
#define XB_TMO      128
#define XB_XCNT(j)  (256  + 64 * (j))
#define XB_XSUB(j)  (1280 + 64 * (j))
#define XB_XGEN(j)  (2304 + 64 * (j))
#define XB_TOP      3328
#define XB_TOPGEN   3392
#define XCD_BAR_WORDS 3456
#define XB_SPIN_CAP (1u << 18)

__device__ __forceinline__ unsigned xb_ld(unsigned* p)              { return __hip_atomic_load(p, __ATOMIC_RELAXED, __HIP_MEMORY_SCOPE_AGENT); }
__device__ __forceinline__ unsigned xb_add(unsigned* p, unsigned v) { return __hip_atomic_fetch_add(p, v, __ATOMIC_RELAXED, __HIP_MEMORY_SCOPE_AGENT); }
__device__ __forceinline__ unsigned xb_xcc_id() { return (unsigned)__builtin_amdgcn_s_getreg((3 << 11) | 20) & 0xFu; }
#define XB_SPIN(cond, bar) do { unsigned _sp = 0; while (cond) { __builtin_amdgcn_s_sleep(1); \
    if ((++_sp & 255u) == 0u) { if (xb_ld(&(bar)[XB_TMO])) break; if (_sp > XB_SPIN_CAP) { atomicAdd(&(bar)[XB_TMO], 1u); break; } } } } while (0)

struct XcdBarrier {
    unsigned* bar; unsigned x;
    volatile LAS unsigned* st;
};

__device__ __forceinline__ XcdBarrier xcd_barrier_post(unsigned* bar, volatile LAS unsigned* st) {
    XcdBarrier b; b.bar = bar; b.x = xb_xcc_id(); b.st = st;
    if (threadIdx.x == 0) (void)xb_add(&bar[XB_XCNT(b.x)], 1u);
    return b;
}
__device__ __forceinline__ void xcd_barrier_complete(unsigned* bar, unsigned x, unsigned& nloc, unsigned& nx) {
    const unsigned G = gridDim.x * gridDim.y * gridDim.z;
    unsigned sum, cnt, mine, sp = 0u;
    for (;;) {
        sum = 0u; cnt = 0u; mine = 0u;
#pragma unroll
        for (unsigned j = 0; j < 16; ++j) { const unsigned c = xb_ld(&bar[XB_XCNT(j)]); sum += c; cnt += (c > 0u) ? 1u : 0u; mine = (j == x) ? c : mine; }
        if (sum == G) break;
        __builtin_amdgcn_s_sleep(1);
        if ((++sp & 255u) == 0u) { if (xb_ld(&bar[XB_TMO])) break; if (sp > XB_SPIN_CAP) { atomicAdd(&bar[XB_TMO], 1u); break; } }
    }
    nloc = mine > 0u ? mine : 1u; nx = cnt > 0u ? cnt : 1u;
}

__device__ __forceinline__ void xcd_barrier(const XcdBarrier& b) {
    asm volatile("s_waitcnt vmcnt(0)" ::: "memory");
    __syncthreads();
    if (threadIdx.x == 0) {
        unsigned* bar = b.bar;
        __builtin_amdgcn_s_waitcnt(0);
        unsigned nloc = b.st[0], nx = b.st[1];
        if (nloc == 0u) { xcd_barrier_complete(bar, b.x, nloc, nx); b.st[0] = nloc; b.st[1] = nx; }
        const unsigned old = xb_add(&bar[XB_XSUB(b.x)], 1u);
        const unsigned gen = old / nloc;
        if (old + 1u == (gen + 1u) * nloc) {
            __builtin_amdgcn_fence(__ATOMIC_RELEASE, "agent");
            asm volatile("s_waitcnt vmcnt(0)" ::: "memory");
            const unsigned og = xb_add(&bar[XB_TOP], 1u);
            const unsigned tg = og / nx;
            if (og + 1u == (tg + 1u) * nx) xb_add(&bar[XB_TOPGEN], 1u);
            else XB_SPIN(xb_ld(&bar[XB_TOPGEN]) == tg, bar);
            __builtin_amdgcn_fence(__ATOMIC_ACQUIRE, "agent");
            xb_add(&bar[XB_XGEN(b.x)], 1u);
            asm volatile("s_waitcnt vmcnt(0)" ::: "memory");
        } else {
            XB_SPIN(xb_ld(&bar[XB_XGEN(b.x)]) == gen, bar);
            __builtin_amdgcn_fence(__ATOMIC_ACQUIRE, "agent");
            asm volatile("s_waitcnt vmcnt(0)" ::: "memory");
        }
    }
    __syncthreads();
}

template <class T> DI T* opq(T* q) { asm volatile("" : "+s"(q)); return q; }
__global__ void __launch_bounds__(512, 2) mega(Params p) {
    extern __shared__ __attribute__((aligned(16))) unsigned char lds[];
    cg::grid_group grid = cg::this_grid();
    { volatile LAS unsigned* z = (volatile LAS unsigned*)((LAS unsigned char*)lds + LDS_CTL_OFF); if (threadIdx.x < 16) z[threadIdx.x] = 0u; }
    __syncthreads();
    const XcdBarrier xbar = xcd_barrier_post((unsigned*)(KWS + OFF_BAR), (volatile LAS unsigned*)((LAS unsigned char*)lds + LDS_CTL_OFF + 32));
#if USE_CG_SYNC
#define GSYNC() grid.sync()
#else
#define GSYNC() xcd_barrier(xbar)
#endif
    PG8_LAS unsigned char* lds3 = (PG8_LAS unsigned char*)lds;
    const int G = gridDim.x, c = blockIdx.x;
#define WSB(off) (opq(KWS) + (off))
#define WGT(off) ((bf16_t*)(opq(KWS) + OFF_W + (off)))

    if (PH(0)) phase0(p, lds);
    grid.sync();
#pragma unroll 1
    for (int l = 0; l < NLAYER; ++l) {
        const bool with_ctx = l < NLAYER - 1;
        const int Mrows = with_ctx ? MT : ML;
        if (PH(1)) {
            const float* ng = opq(KIN(I_NORMG)) + (size_t)l * 4 * DM; const float* MODS = (const float*)WSB(OFF_MODS); const float* ml = MODS + (size_t)l * 9 * 6144;
            bf16_t* HC = (bf16_t*)WSB(OFF_HC); float* XC = (float*)WSB(OFF_XCTX); float* outp = opq(KOUT);
            if (l == 0) rowpass(0, MT, c, G, KIN(I_X), KIN(I_CTX), nullptr, nullptr, nullptr, nullptr, nullptr, HC, ng, ml, ml + 1024);
            else {
                if (c < 32) { pg8::Gemm g{(const bf16_t*)WSB(OFF_PA) + (size_t)ML * FFH, WGT(W_F2), MC, DM, FFH, FFH}; pg8::StaticOrder S; S.init(MC, DM, G, c);
                    pg8::EpiY E{(bf16_t*)WSB(OFF_Y) + (size_t)ML * DM, DM};
                    pg8::gemm_phase<pg8::EpiY, pg8::StaticOrder, true, true>(lds3, g, S, E); }
                else rowpass(0, ML, c - 32, G - 32, outp, XC, outp, XC, (const bf16_t*)WSB(OFF_Y), MODS + (size_t)(l - 1) * 9 * 6144 + 5 * 1024, ng - DM, HC, ng, ml, ml + 1024);
                GSYNC();
                rowpass(ML, MT, c, G, outp, XC, outp, XC, (const bf16_t*)WSB(OFF_Y), MODS + (size_t)(l - 1) * 9 * 6144 + 5 * 1024, ng - DM, HC, ng, ml, ml + 1024);
            }
        }
        for (int rep = 0; rep < REP_CONV; ++rep) { if (PH(2)) convert_weights(p, l, lds); }
        for (int rep = 0; rep < REP_RP0; ++rep) { const float* ng = opq(KIN(I_NORMG)); const float* ml = (const float*)WSB(OFF_MODS); rowpass(0, MT, c, G, KIN(I_X), KIN(I_CTX), nullptr, nullptr, nullptr, nullptr, nullptr, (bf16_t*)WSB(OFF_Y), ng, ml, ml + 1024); }
        GSYNC();
        for (int rep = 0; rep < REP_SYNC; ++rep) GSYNC();
        for (int rep = 0; rep < REP_G3; ++rep) { if (rep) GSYNC();
        if (PH(3)) { pg8::Gemm g{(const bf16_t*)WSB(OFF_HC), WGT(W_IN), MT, INWP, DM, DM}; pg8::StaticOrder S; S.init(MT, INWP, G, c);
          const float* rc = (const float*)WSB(OFF_ROPE);
          pg8::EpiProj E{(bf16_t*)WSB(OFF_PA), (bf16_t*)WSB(OFF_VT), (float*)WSB(OFF_STQ), (float*)WSB(OFF_STKV), rc, rc + 4096 * 16, lds + LDS_CTL_OFF + 256};
          pg8::gemm_phase<pg8::EpiProj, pg8::StaticOrder, true, true>(lds3, g, S, E); } }
        GSYNC();
        for (int rep = 0; rep < REP_C; ++rep) {
        if (PH(4)) { int Kq = 256; asm volatile("" : "+s"(Kq)); pg8::Gemm g{(const bf16_t*)WSB(OFF_PA) + 768, WGT(W_UQ), MT, 512, Kq, INWP}; pg8::StaticOrder S; S.init(MT, 512, G, c);
          const float* rc = (const float*)WSB(OFF_ROPE);
          pg8::EpiUpQ E{(bf16_t*)WSB(OFF_MLAQ), (const float*)WSB(OFF_STQ), rc, rc + 4096 * 16};
          pg8::gemm_phase<pg8::EpiUpQ, pg8::StaticOrder, true, true>(lds3, g, S, E); }
        if (PH(5)) { int Kq = 128; asm volatile("" : "+s"(Kq)); pg8::Gemm g{(const bf16_t*)WSB(OFF_PA) + 1024, WGT(W_UKV), MT, 512, Kq, INWP}; pg8::StaticOrder S; S.init(MT, 512, G, (c + G / 2) % G);
          pg8::EpiUpKV E{(bf16_t*)WSB(OFF_MLAK), (bf16_t*)WSB(OFF_VT), (const float*)WSB(OFF_STKV), lds + LDS_CTL_OFF + 256};
          pg8::gemm_phase<pg8::EpiUpKV, pg8::StaticOrder, true, true>(lds3, g, S, E); }
        GSYNC(); }
        for (int rep = 0; rep < REP_MIX; ++rep) { if (PH(6)) mixer_phase(p, lds, l, rep); GSYNC(); }
        for (int rep = 0; rep < REP_G7; ++rep) { if (rep) GSYNC();
        if (PH(7)) { pg8::Gemm g{(const bf16_t*)WSB(OFF_HC), WGT(W_OUT), Mrows, DM, DM, DM}; pg8::StaticOrder S; S.init(Mrows, DM, G, c);
          pg8::EpiY E{(bf16_t*)WSB(OFF_Y), DM};
          pg8::gemm_phase<pg8::EpiY, pg8::StaticOrder, true, true>(lds3, g, S, E); } }
        GSYNC();
        if (PH(8)) {
            const float* ng = opq(KIN(I_NORMG)) + (size_t)l * 4 * DM; const float* ml = (const float*)WSB(OFF_MODS) + (size_t)l * 9 * 6144;
            float* XC = (float*)WSB(OFF_XCTX); float* outp = opq(KOUT);
            rowpass(0, Mrows, c, G, l == 0 ? KIN(I_X) : outp, l == 0 ? KIN(I_CTX) : XC, outp, XC, (const bf16_t*)WSB(OFF_Y), ml + 2 * 1024, ng + DM, (bf16_t*)WSB(OFF_HC), ng + 2 * DM, ml + 3 * 1024, ml + 4 * 1024);
        }
        GSYNC();
        for (int rep = 0; rep < REP_G9; ++rep) { if (rep) GSYNC();
        if (PH(9)) { pg8::Gemm g{(const bf16_t*)WSB(OFF_HC), WGT(W_F1), Mrows, 2 * FFH, DM, DM}; pg8::StaticOrder S; S.init(Mrows, 2 * FFH, G, c);
          pg8::EpiSwiglu E{(bf16_t*)WSB(OFF_PA)};
          pg8::gemm_phase<pg8::EpiSwiglu, pg8::StaticOrder, true, true>(lds3, g, S, E); } }
        GSYNC();
        for (int rep = 0; rep < REP_G10; ++rep) { if (rep) GSYNC();
        if (PH(10)) { pg8::Gemm g{(const bf16_t*)WSB(OFF_PA), WGT(W_F2), ML, DM, FFH, FFH}; pg8::StaticOrder S; S.init(ML, DM, G, c);
          pg8::EpiY E{(bf16_t*)WSB(OFF_Y), DM};
          pg8::gemm_phase<pg8::EpiY, pg8::StaticOrder, true, true>(lds3, g, S, E); } }
        GSYNC();
    }
    { float* XC = (float*)WSB(OFF_XCTX); float* outp = opq(KOUT);
      rowpass(0, ML, c, G, outp, XC, outp, XC, (const bf16_t*)WSB(OFF_Y), (const float*)WSB(OFF_MODS) + (size_t)3 * 9 * 6144 + 5 * 1024, KIN(I_NORMG) + (size_t)3 * 4 * DM + 3 * DM, nullptr, nullptr, nullptr, nullptr); }
}

extern "C" void kernel_launch(void* const* d_in, const int* in_sizes, int n_in, void* d_out, int out_size, void* d_ws, size_t ws_size, hipStream_t stream) {
    static int grid_blocks = 0;
    if (!grid_blocks) {
        if (n_in != 22 || ws_size < WS_END2) { fprintf(stderr, "kernel_launch: unexpected n_in %d or ws_size %zu (need %zu)\n", n_in, ws_size, (size_t)WS_END2); grid_blocks = -1; return; }
        int dev = 0, cus = 0, per_cu = 0;
        (void)hipGetDevice(&dev);
        (void)hipDeviceGetAttribute(&cus, hipDeviceAttributeMultiprocessorCount, dev);
        (void)hipFuncSetAttribute((const void*)mega, hipFuncAttributeMaxDynamicSharedMemorySize, LDS_BYTES);
        (void)hipOccupancyMaxActiveBlocksPerMultiprocessor(&per_cu, (const void*)mega, 512, LDS_BYTES);
        if (per_cu < 1) per_cu = 1;
        grid_blocks = cus * per_cu;
    }
    if (grid_blocks < 0) return;
    (void)hipMemsetAsync((unsigned char*)d_ws + OFF_BAR, 0, 16384, stream);
    Params p{};
    for (int i = 0; i < 22; ++i) p.in[i] = (const float*)d_in[i];
    p.out = (float*)d_out; p.ws = (unsigned char*)d_ws;
    void* args[] = {&p};
    hipError_t e = hipLaunchCooperativeKernel((const void*)mega, dim3(grid_blocks), dim3(512), args, LDS_BYTES, stream);
    if (e != hipSuccess) fprintf(stderr, "cooperative launch failed: %s (grid %d)\n", hipGetErrorString(e), grid_blocks);
}
```

```cpp
#include <hip/hip_runtime.h>
#include <hip/hip_cooperative_groups.h>
#include <cstdio>
#include <cstdint>
namespace cg = cooperative_groups;
namespace pg8 {
#define PG8_LAS __attribute__((address_space(3)))
typedef unsigned short bf16_t;
typedef short bf16x8 __attribute__((ext_vector_type(8)));
typedef float f32x4 __attribute__((ext_vector_type(4)));
typedef unsigned u32x4 __attribute__((ext_vector_type(4)));
constexpr int BM = 256, BK = 64, HALF = 128, HTB = HALF * BK * 2  , STAGE_BYTES = 8 * HTB, NXCD = 8, WGM = 8;

__host__ __device__ __forceinline__ int lds_byte(int r, int c) { const int st = (r >> 4) * 2 + (c >> 5), rr = r & 15, cc = c & 31, ob = rr * 64 + cc * 2; return st * 1024 + (ob ^ (((ob >> 9) & 1) << 5)); }
__host__ __device__ __forceinline__ void stage_rc(int b, int& R, int& C) { const int st = b / 1024, sb = b % 1024, swz = sb ^ (((sb >> 9) & 1) << 5); R = (st >> 1) * 16 + swz / 64; C = (st & 1) * 32 + (swz % 64) / 2; }
__host__ __device__ __forceinline__ int perm32(int rho) { const int n = rho >> 4, i = rho & 15; return 8 * (i >> 2) + 4 * n + (i & 3); }

struct Unit { int pm, pn; };
struct Gemm { const bf16_t* A; const bf16_t* Bt; int M, N, K, lda; };

struct StaticOrder {
    int nM, nN, nwg, G, c;
    __host__ __device__ void init(int M, int N, int G_, int c_) { nM = M / BM; nN = N / BM; nwg = nM * nN; G = G_; c = c_; }
    __host__ __device__ bool next(int i, Unit& u) const {
        const long L = (long)i * G + c; if (L >= nwg) return false;
        int wgid = (int)L; { const int q = nwg / NXCD, r = nwg % NXCD, xcd = wgid % NXCD, off = wgid / NXCD; wgid = (xcd < r ? xcd * (q + 1) : r * (q + 1) + (xcd - r) * q) + off; }
        const int nig = WGM * nN, gid = wgid / nig, fm = gid * WGM, gsz = (nM - fm) < WGM ? (nM - fm) : WGM;
        u.pm = fm + ((wgid % nig) % gsz); u.pn = (wgid % nig) / gsz; return true;
    }
    __device__ __forceinline__ void a_ready(const Unit&) const {}
    __device__ __forceinline__ void done(const Unit&) const {}
};

__device__ __forceinline__ unsigned cvt_pk_bf16(float lo, float hi) { unsigned r; asm volatile("v_cvt_pk_bf16_f32 %0, %1, %2" : "=v"(r) : "v"(lo), "v"(hi)); return r; }
typedef float f32x2 __attribute__((ext_vector_type(2)));
template <class Epi, class Sched, bool ALIGN_EPI = false, bool SP2 = false>
__device__ __forceinline__ void gemm_phase(PG8_LAS unsigned char* lds, const Gemm g, const Sched& S, const Epi& E) {
    int tid_ = threadIdx.x; asm volatile("" : "+v"(tid_)); const int tid = tid_, wid = __builtin_amdgcn_readfirstlane(tid >> 6), lane = tid & 63, wr = wid >> 2, wc = wid & 3, fr = lane & 15, fq = lane >> 4;
    const int K = g.K, nt = K / BK;
    unsigned voffA[2], voffB[2];
#pragma unroll
    for (int i = 0; i < 2; ++i) { int R, C; stage_rc(tid * 16 + i * 8192, R, C); const int Rb = Epi::PERM ? ((R & ~31) + perm32(R & 31)) : R;
        voffA[i] = (unsigned)(R * g.lda + C) * 2u; voffB[i] = (unsigned)(Rb * K + C) * 2u; }
    const size_t kstep = (size_t)(BK * 2);
    const size_t hstepB = (size_t)HALF * K * 2, hstepA = (size_t)HALF * g.lda * 2;
    const size_t tstepB = 2 * hstepB, tstepA = 2 * hstepA;
    const unsigned ldsw = (unsigned)wid * 1024u;
    const int aoff = lds_byte(wr * 64 + fr, fq * 8), boff = lds_byte(wc * 32 + fr, fq * 8);
#define PG8_SA(b, h) (((b) * 2 + (h)) * HTB)
#define PG8_SB(b, h) ((4 + (b) * 2 + (h)) * HTB)
#define PG8_STAGE(bufoff, gbase, voff) do { _Pragma("unroll") for (int _i = 0; _i < 2; ++_i) \
        __builtin_amdgcn_global_load_lds((const unsigned*)((const char*)(gbase) + (voff)[_i]), (PG8_LAS unsigned*)(lds + (bufoff) + ldsw + _i * 8192), 16, 0, 0); } while (0)
#define PG8_LDA(dst, b, h) do { _Pragma("unroll") for (int m = 0; m < 4; ++m) _Pragma("unroll") for (int k = 0; k < 2; ++k) dst[m][k] = *(const PG8_LAS bf16x8*)(lds + PG8_SA(b, h) + aoff + m * 2048 + k * 1024); } while (0)
#define PG8_LDB(dst, b, h) do { _Pragma("unroll") for (int n = 0; n < 2; ++n) _Pragma("unroll") for (int k = 0; k < 2; ++k) dst[n][k] = *(const PG8_LAS bf16x8*)(lds + PG8_SB(b, h) + boff + n * 2048 + k * 1024); } while (0)
#define PG8_MMA(ai, bj, At, Bt) do { __builtin_amdgcn_s_setprio(1); _Pragma("unroll") for (int m = 0; m < 4; ++m) _Pragma("unroll") for (int n = 0; n < 2; ++n) _Pragma("unroll") for (int k = 0; k < 2; ++k) \
        acc[ai][bj][m][n] = __builtin_amdgcn_mfma_f32_16x16x32_bf16(Bt[n][k], At[m][k], acc[ai][bj][m][n], 0, 0, 0); __builtin_amdgcn_s_setprio(0); } while (0)
#define PG8_WAIT_V(n) asm volatile("s_waitcnt vmcnt(" #n ")" ::: "memory")
#define PG8_WAIT_L(n) asm volatile("s_waitcnt lgkmcnt(" #n ")" ::: "memory")
#define PG8_BAR __builtin_amdgcn_s_barrier()
#define PG8_SCHED __builtin_amdgcn_sched_barrier(0)
    Unit cur, nxt; int ui = 0;
    if (!S.next(0, cur)) return;
    f32x4 acc[2][2][4][2];
#pragma unroll
    for (int a = 0; a < 2; ++a)
#pragma unroll
        for (int b = 0; b < 2; ++b)
#pragma unroll
            for (int m = 0; m < 4; ++m)
#pragma unroll
                for (int n = 0; n < 2; ++n) acc[a][b][m][n] = (f32x4){0.f, 0.f, 0.f, 0.f};
    bf16x8 At[4][2], B0[2][2], B1[2][2];
    const char* cA = (const char*)g.A + (size_t)cur.pm * tstepA; const char* cB = (const char*)g.Bt + (size_t)cur.pn * tstepB;
    S.a_ready(cur);
    if constexpr (SP2) {
        PG8_STAGE(PG8_SB(0, 0), cB, voffB); PG8_STAGE(PG8_SB(0, 1), cB + hstepB, voffB); PG8_STAGE(PG8_SA(0, 0), cA, voffA); PG8_STAGE(PG8_SA(0, 1), cA + hstepA, voffA);
        if (wr == 1) PG8_BAR;
        PG8_WAIT_V(2); PG8_BAR;
        PG8_STAGE(PG8_SB(1, 0), cB + kstep, voffB); PG8_STAGE(PG8_SA(1, 0), cA + kstep, voffA); PG8_STAGE(PG8_SB(1, 1), cB + hstepB + kstep, voffB);
        PG8_WAIT_V(6); PG8_BAR;
    } else {
        PG8_STAGE(PG8_SB(0, 0), cB, voffB); PG8_STAGE(PG8_SA(0, 0), cA, voffA); PG8_STAGE(PG8_SB(0, 1), cB + hstepB, voffB); PG8_STAGE(PG8_SA(0, 1), cA + hstepA, voffA);
        if (wr == 1) PG8_BAR;
        PG8_WAIT_V(4); PG8_BAR;
        PG8_STAGE(PG8_SB(1, 0), cB + kstep, voffB); PG8_STAGE(PG8_SA(1, 0), cA + kstep, voffA); PG8_STAGE(PG8_SB(1, 1), cB + hstepB + kstep, voffB);
        PG8_WAIT_V(6); PG8_BAR;
    }
    for (;;) {
        const bool has_next = S.next(ui + 1, nxt);
        const char* nA = has_next ? (const char*)g.A + (size_t)nxt.pm * tstepA : cA; const char* nB = has_next ? (const char*)g.Bt + (size_t)nxt.pn * tstepB : cB;
        for (int t = 0; t < nt; t += 2) {
            const bool last = (t == nt - 2);
            const char* a1 = cA + (size_t)(t + 1) * kstep;
            const char* a2 = last ? nA : cA + (size_t)(t + 2) * kstep; const char* b2 = last ? nB : cB + (size_t)(t + 2) * kstep;
            const char* a3 = a2 + kstep; const char* b3 = b2 + kstep;
            if (last && has_next) S.a_ready(nxt);
            if constexpr (SP2) {
            PG8_LDB(B0, 0, 0); PG8_LDB(B1, 0, 1); PG8_SCHED; PG8_LDA(At, 0, 0); PG8_STAGE(PG8_SA(1, 1), a1 + hstepA, voffA);
            PG8_WAIT_V(8); PG8_WAIT_L(0); PG8_BAR; PG8_MMA(0, 0, At, B0); PG8_MMA(0, 1, At, B1); PG8_BAR; PG8_SCHED;
            PG8_LDA(At, 0, 1); PG8_STAGE(PG8_SB(0, 0), b2, voffB); PG8_STAGE(PG8_SB(0, 1), b2 + hstepB, voffB); PG8_STAGE(PG8_SA(0, 0), a2, voffA);
            PG8_WAIT_V(8); PG8_WAIT_L(0); PG8_BAR; PG8_MMA(1, 0, At, B0); PG8_MMA(1, 1, At, B1); PG8_BAR; PG8_SCHED;
            PG8_LDB(B0, 1, 0); PG8_LDB(B1, 1, 1); PG8_SCHED; PG8_LDA(At, 1, 0); PG8_STAGE(PG8_SA(0, 1), a2 + hstepA, voffA);
            PG8_WAIT_V(8); PG8_WAIT_L(0); PG8_BAR; PG8_MMA(0, 0, At, B0); PG8_MMA(0, 1, At, B1); PG8_BAR; PG8_SCHED;
            PG8_LDA(At, 1, 1); PG8_STAGE(PG8_SB(1, 0), b3, voffB); PG8_STAGE(PG8_SB(1, 1), b3 + hstepB, voffB); PG8_STAGE(PG8_SA(1, 0), a3, voffA);
            PG8_WAIT_V(8); PG8_WAIT_L(0); PG8_BAR; PG8_MMA(1, 0, At, B0); PG8_MMA(1, 1, At, B1); PG8_BAR; PG8_SCHED;
            } else {
            PG8_LDB(B0, 0, 0); PG8_SCHED; PG8_LDA(At, 0, 0); PG8_STAGE(PG8_SA(1, 1), a1 + hstepA, voffA);
            PG8_WAIT_L(8); PG8_BAR; PG8_WAIT_L(0); PG8_MMA(0, 0, At, B0); PG8_BAR; PG8_SCHED;
            PG8_LDB(B1, 0, 1); PG8_STAGE(PG8_SB(0, 0), b2, voffB);
            PG8_BAR; PG8_WAIT_L(0); PG8_MMA(0, 1, At, B1); PG8_BAR;
            PG8_LDA(At, 0, 1); PG8_STAGE(PG8_SA(0, 0), a2, voffA);
            PG8_BAR; PG8_WAIT_L(0); PG8_MMA(1, 0, At, B0); PG8_BAR; PG8_SCHED;
            PG8_STAGE(PG8_SB(0, 1), b2 + hstepB, voffB);
            PG8_WAIT_V(6); PG8_BAR; PG8_MMA(1, 1, At, B1); PG8_BAR;
            PG8_LDB(B0, 1, 0); PG8_SCHED; PG8_LDA(At, 1, 0); PG8_STAGE(PG8_SA(0, 1), a2 + hstepA, voffA);
            PG8_WAIT_L(8); PG8_BAR; PG8_WAIT_L(0); PG8_MMA(0, 0, At, B0); PG8_BAR; PG8_SCHED;
            PG8_LDB(B1, 1, 1); PG8_STAGE(PG8_SB(1, 0), b3, voffB);
            PG8_BAR; PG8_WAIT_L(0); PG8_MMA(0, 1, At, B1); PG8_BAR;
            PG8_LDA(At, 1, 1); PG8_STAGE(PG8_SA(1, 0), a3, voffA);
            PG8_BAR; PG8_WAIT_L(0); PG8_MMA(1, 0, At, B0); PG8_BAR; PG8_SCHED;
            PG8_STAGE(PG8_SB(1, 1), b3 + hstepB, voffB);
            PG8_WAIT_V(6); PG8_BAR; PG8_MMA(1, 1, At, B1); PG8_BAR;
            }
        }
        if constexpr (ALIGN_EPI) { if (wr == 0) PG8_BAR; }
        if constexpr (!Epi::AFTER_DRAIN) { E(acc, cur, wr, wc, fr, fq); S.done(cur); }
        if (!has_next) break;
#pragma unroll
        for (int a = 0; a < 2; ++a)
#pragma unroll
            for (int b = 0; b < 2; ++b)
#pragma unroll
                for (int m = 0; m < 4; ++m)
#pragma unroll
                    for (int n = 0; n < 2; ++n) acc[a][b][m][n] = (f32x4){0.f, 0.f, 0.f, 0.f};
        cur = nxt; cA = nA; cB = nB; ++ui;
        if constexpr (ALIGN_EPI) { if (wr == 1) PG8_BAR; }
    }
    PG8_WAIT_V(0);
    if constexpr (!ALIGN_EPI) { if (wr == 0) PG8_BAR; }
    PG8_BAR;
    if constexpr (Epi::AFTER_DRAIN) { E.fused(acc, cur, wr, wc, fr, fq, lds, wid, lane); S.done(cur); }
#undef PG8_SA
#undef PG8_SB
#undef PG8_STAGE
#undef PG8_LDA
#undef PG8_LDB
#undef PG8_MMA
#undef PG8_WAIT_V
#undef PG8_WAIT_L
#undef PG8_BAR
#undef PG8_SCHED
}
}

typedef unsigned short bf16_t;
typedef short bf16x8 __attribute__((ext_vector_type(8)));
typedef short s16x4 __attribute__((ext_vector_type(4)));
typedef float f32x4 __attribute__((ext_vector_type(4)));
typedef float f32x16 __attribute__((ext_vector_type(16)));
typedef unsigned u32x4 __attribute__((ext_vector_type(4)));
typedef unsigned u32x2 __attribute__((ext_vector_type(2)));
typedef float f32x2_t __attribute__((ext_vector_type(2)));
typedef __bf16 bf16x2_t __attribute__((ext_vector_type(2)));
#define DI __device__ __forceinline__
template <class T> DI T* opq2(T* q) { asm volatile("" : "+s"(q)); return q; }
DI int ltid() { int t = threadIdx.x; asm volatile("" : "+v"(t)); return t; }

constexpr int NB = 8, SEQL = 4096, CTXL = 256, DM = 1024, NLAYER = 4;
constexpr int ML = NB * SEQL, MC = NB * CTXL, MT = ML + MC;
constexpr int POSN = SEQL + CTXL;
constexpr int INW = 2752, INWP = 2816, FFH = 2816;
constexpr float EPS = 1e-6f;
constexpr float LOG2E = 1.4426950408889634f;

constexpr size_t OFF_CTL = 0;
constexpr size_t OFF_MODS = 4096;
constexpr size_t OFF_ROPE = OFF_MODS + 884736;
constexpr size_t OFF_STQ = OFF_ROPE + 524288;
constexpr size_t OFF_STKV = OFF_STQ + 1114112;
constexpr size_t OFF_XCTX = OFF_STKV + 557056;
constexpr size_t OFF_W = OFF_XCTX + 8388608;
constexpr size_t W_IN = 0, W_OUT = 5767168, W_F1 = 7864320, W_F2 = 19398656, W_UQ = 25165824, W_UKV = 25427968, W_TOTAL = 25559040;
constexpr size_t OFF_HC = OFF_W + W_TOTAL;
constexpr size_t OFF_PA = OFF_HC + 71303168;
constexpr size_t OFF_Y = OFF_PA + 196083712;
constexpr size_t OFF_MLAQ = OFF_Y + 71303168;
constexpr size_t OFF_MLAK = OFF_MLAQ + 26738688;
constexpr size_t OFF_VT = OFF_MLAK + 17825792;
constexpr size_t VT_TYPE_ELEMS = (size_t)NB * 4 * 64 * POSN;
constexpr size_t WS_END = OFF_VT + 4 * VT_TYPE_ELEMS * 2;
constexpr size_t OFF_BAR = WS_END, WS_END2 = WS_END + 16384;
static_assert(WS_END2 <= 536870912, "workspace map");

#ifndef USE_CG_SYNC
#define USE_CG_SYNC 0
#endif
#ifndef REP_SYNC
#define REP_SYNC 0
#endif
#ifndef REP_C
#define REP_C 1
#endif
#ifndef REP_CONV
#define REP_CONV 1
#endif
#ifndef REP_RP0
#define REP_RP0 0
#endif
#ifndef REP_MIX_ONLY
#define REP_MIX_ONLY 0
#endif
#ifndef REP_MIX
#define REP_MIX 1
#endif
#ifndef REP_GEMM
#define REP_GEMM 1
#endif
#ifndef REP_G3
#define REP_G3 REP_GEMM
#endif
#ifndef REP_G7
#define REP_G7 REP_GEMM
#endif
#ifndef REP_G9
#define REP_G9 REP_GEMM
#endif
#ifndef REP_G10
#define REP_G10 REP_GEMM
#endif
#ifndef PHMASK
#define PHMASK 0xFFFF
#endif
#define PH(k) ((PHMASK >> (k)) & 1)
constexpr int LDS_BYTES = 147456;
constexpr int LDS_CTL_OFF = 131072;

struct Params { const float* in[22]; float* out; unsigned char* ws; };
enum { I_X = 0, I_C, I_CTX, I_CCTX, I_ADAW, I_ADAB, I_NORMG, I_WIN, I_DLAM, I_DNORM, I_MQN, I_MKVN, I_WUQ, I_WUKV, I_GWG, I_GBG, I_GNORM, I_RDEC, I_RNORM, I_WOUT, I_FIN, I_FOUT };

typedef const unsigned char __attribute__((address_space(4)))* kaptr_t;
DI kaptr_t kargs() { kaptr_t ka = (kaptr_t)__builtin_amdgcn_kernarg_segment_ptr(); asm volatile("" : "+s"(ka)); return ka; }
#define KIN(k) (*(const float* const __attribute__((address_space(4)))*)(kargs() + 8 * (k)))
#define KOUT (*(float* const __attribute__((address_space(4)))*)(kargs() + 8 * 22))
#define KWS (*(unsigned char* const __attribute__((address_space(4)))*)(kargs() + 8 * 23))
DI unsigned pk2(float lo, float hi) { f32x2_t v = {lo, hi}; bf16x2_t b = __builtin_convertvector(v, bf16x2_t); return __builtin_bit_cast(unsigned, b); }
DI unsigned f2bf(float f) { return pk2(f, f) & 0xffffu; }
DI float bflo(unsigned w) { return __uint_as_float(w << 16); }
DI float bfhi(unsigned w) { return __uint_as_float(w & 0xffff0000u); }
DI int crow(int i, int h) { return (i & 3) + 8 * (i >> 2) + 4 * h; }
DI float wave_sum(float v) {
#pragma unroll
    for (int o = 1; o < 64; o <<= 1) v += __shfl_xor(v, o);
    return v;
}
DI float silu_f(float x) { return x / (1.f + __expf(-x)); }
DI float logsig_f(float x) { return fminf(x, 0.f) - __logf(1.f + __expf(-fabsf(x))); }
#define LBAR() asm volatile("s_waitcnt lgkmcnt(0)\n\ts_barrier" ::: "memory")
#define MFMA32(a, b, c) __builtin_amdgcn_mfma_f32_32x32x16_bf16((a), (b), (c), 0, 0, 0)

DI void row_bpos(int row, int& b, int& pos) { if (row < ML) { b = row >> 12; pos = CTXL + (row & 4095); } else { const int r = row - ML; b = r >> 8; pos = r & 255; } }
DI int pos_row(int b, int pos) { return pos < CTXL ? ML + b * CTXL + pos : b * SEQL + pos - CTXL; }

namespace pg8 {
struct EpiY {
    static constexpr bool PERM = true, AFTER_DRAIN = false;
    bf16_t* O; int ldc;
    __device__ __forceinline__ void operator()(const f32x4 (&acc)[2][2][4][2], const Unit& u, int wr, int wc, int fr, int fq) const {
        const int row0 = u.pm * BM + wr * 64 + fr, col0 = u.pn * BM + wc * 32 + 8 * fq;
#pragma unroll
        for (int ai = 0; ai < 2; ++ai)
#pragma unroll
            for (int m = 0; m < 4; ++m) { bf16_t* rowp = O + (size_t)(row0 + ai * HALF + m * 16) * ldc + col0;
#pragma unroll
                for (int bj = 0; bj < 2; ++bj) { const f32x4 v0 = acc[ai][bj][m][0], v1 = acc[ai][bj][m][1];
                    u32x4 w; w.x = pk2(v0[0], v0[1]); w.y = pk2(v0[2], v0[3]); w.z = pk2(v1[0], v1[1]); w.w = pk2(v1[2], v1[3]);
                    *(u32x4*)(rowp + bj * HALF) = w; } }
    }
};
struct EpiSwiglu {
    static constexpr bool PERM = true, AFTER_DRAIN = false;
    bf16_t* O;
    __device__ __forceinline__ void operator()(const f32x4 (&acc)[2][2][4][2], const Unit& u, int wr, int wc, int fr, int fq) const {
        const int row0 = u.pm * BM + wr * 64 + fr, col0 = u.pn * HALF + wc * 32 + 8 * fq;
#pragma unroll
        for (int ai = 0; ai < 2; ++ai)
#pragma unroll
            for (int m = 0; m < 4; ++m) { bf16_t* rowp = O + (size_t)(row0 + ai * HALF + m * 16) * FFH + col0;
                float r[8];
#pragma unroll
                for (int n = 0; n < 2; ++n)
#pragma unroll
                    for (int i = 0; i < 4; ++i) { const float g = acc[ai][0][m][n][i], up = acc[ai][1][m][n][i]; r[4 * n + i] = g / (1.f + __expf(-g)) * up; }
                u32x4 w; w.x = pk2(r[0], r[1]); w.y = pk2(r[2], r[3]); w.z = pk2(r[4], r[5]); w.w = pk2(r[6], r[7]);
                *(u32x4*)rowp = w; }
    }
};
DI void rope_pair(f32x4& a, f32x4& b, const float* rc, const float* rs, int row, int fq) {
    if (row < ML) { const int t = row & 4095; const f32x4 c = *(const f32x4*)(rc + t * 16 + 4 * fq), s = *(const f32x4*)(rs + t * 16 + 4 * fq);
        const f32x4 x1 = a, x2 = b; a = x1 * c - x2 * s; b = x1 * s + x2 * c; }
}
DI void store4(bf16_t* p, const f32x4& v) { u32x2 w; w.x = pk2(v[0], v[1]); w.y = pk2(v[2], v[3]); *(u32x2*)p = w; }
DI void store_vt(bf16_t* VT, int type, int hd, int e0, int row, const f32x4& v) {
    int b, pos; row_bpos(row, b, pos);
    pos = (pos & ~12) | ((pos & 4) << 1) | ((pos & 8) >> 1);
    bf16_t* q = VT + ((size_t)((type * NB + b) * 4 + hd) * 64 + e0) * POSN + pos;
#pragma unroll
    for (int i = 0; i < 4; ++i) q[(size_t)i * POSN] = (bf16_t)f2bf(v[i]);
}
DI void store_vt_tile(bf16_t* VT, int type, int hd, int e0, int row0, const f32x4& v0, const f32x4& v1, bf16_t* scr, int fr, int c0, int c1, int lane) {
    const int pr = (fr & ~12) | ((fr & 4) << 1) | ((fr & 8) >> 1);
#pragma unroll
    for (int i = 0; i < 4; ++i) { scr[(c0 + i) * 24 + pr] = (bf16_t)f2bf(v0[i]); scr[(c1 + i) * 24 + pr] = (bf16_t)f2bf(v1[i]); }
    asm volatile("s_waitcnt lgkmcnt(0)" ::: "memory");
    const int col = lane >> 1, half = lane & 1;
    const u32x4 w = *(const u32x4*)(scr + col * 24 + 8 * half);
    int b, pos; row_bpos(row0, b, pos);
    *(u32x4*)(VT + ((size_t)((type * NB + b) * 4 + hd) * 64 + e0 + col) * POSN + pos + 8 * half) = w;
    asm volatile("s_waitcnt lgkmcnt(0)" ::: "memory");
}
struct EpiProj {
    static constexpr bool PERM = true, AFTER_DRAIN = false;
    bf16_t* PROJ; bf16_t* VT; float* stq; float* stkv; const float* rc; const float* rs; unsigned char* scr;
    __device__ __forceinline__ void operator()(const f32x4 (&acc)[2][2][4][2], const Unit& u, int wr, int wc, int fr, int fq) const {
#pragma unroll
        for (int bj = 0; bj < 2; ++bj) {
            const int g = u.pn * 8 + bj * 4 + wc;
            if (g >= 86) continue;
            const int colbase = g * 32;
            int kind = 0; float scale = 1.f; int vtype = 0, vc0 = 0, slot = 0;
            if (g < 8) { kind = 1; scale = 0.17677669529663687f * LOG2E; }
            else if (g < 16) { kind = 1; }
            else if (g < 24) { kind = 2; vtype = 0; vc0 = colbase - 512; }
            else if (g < 32) { kind = 3; slot = g - 24; }
            else if (g < 36) { kind = 4; slot = g - 32; }
            else if (g == 36) { kind = 1; }
            else if (g < 41) { kind = 0; scale = 0.17677669529663687f; }
            else if (g < 45) { kind = 0; }
            else if (g < 53) { kind = 2; vtype = 2; vc0 = colbase - 1440; }
            else if (g < 62) { kind = 0; }
            else if (g < 66) { kind = 1; scale = 0.17677669529663687f; }
            else if (g < 70) { kind = 1; }
            else if (g < 78) { kind = 2; vtype = 3; vc0 = colbase - 2240; }
            else { kind = 0; }
#pragma unroll
            for (int ai = 0; ai < 2; ++ai)
#pragma unroll
                for (int m = 0; m < 4; ++m) {
                    const int row = u.pm * BM + ai * HALF + wr * 64 + m * 16 + fr;
                    f32x4 v0 = acc[ai][bj][m][0], v1 = acc[ai][bj][m][1];
                    if (kind == 1) {
                        f32x4 w0, w1;
#pragma unroll
                        for (int i = 0; i < 4; ++i) { w0[i] = __shfl_xor(v0[i], 32); w1[i] = __shfl_xor(v1[i], 32); }
                        if (row < ML) { const int t = row & 4095; const float* cb = rc + t * 16 + 8 * (fq & 1); const float* sb = rs + t * 16 + 8 * (fq & 1);
                            const f32x4 c0 = *(const f32x4*)cb, c1 = *(const f32x4*)(cb + 4), s0 = *(const f32x4*)sb, s1 = *(const f32x4*)(sb + 4);
                            if (fq < 2) { v0 = v0 * c0 - w0 * s0; v1 = v1 * c1 - w1 * s1; } else { v0 = w0 * s0 + v0 * c0; v1 = w1 * s1 + v1 * c1; } }
                    }
                    v0 = v0 * scale; v1 = v1 * scale;
                    if (kind == 2) {
                        store_vt_tile(VT, vtype, vc0 >> 6, vc0 & 63, row - fr, v0, v1, (bf16_t*)(scr + (wr * 4 + wc) * 1536), fr, 8 * fq, 8 * fq + 4, fr + 16 * fq);
                    } else {
                        { u32x4 ww; ww.x = pk2(v0[0], v0[1]); ww.y = pk2(v0[2], v0[3]); ww.z = pk2(v1[0], v1[1]); ww.w = pk2(v1[2], v1[3]);
                          *(u32x4*)(PROJ + (size_t)row * INWP + colbase + 8 * fq) = ww; }
                        if (kind >= 3) {
                            float ss = (v0[0] * v0[0] + v0[1] * v0[1]) + (v0[2] * v0[2] + v0[3] * v0[3]) + (v1[0] * v1[0] + v1[1] * v1[1]) + (v1[2] * v1[2] + v1[3] * v1[3]);
                            ss += __shfl_xor(ss, 16); ss += __shfl_xor(ss, 32);
                            if (fq == 0) { if (kind == 3) stq[(size_t)row * 8 + slot] = ss; else stkv[(size_t)row * 4 + slot] = ss; }
                        }
                    }
                }
        }
    }
};
struct EpiUpQ {
    static constexpr bool PERM = false, AFTER_DRAIN = false;
    bf16_t* MQ; const float* stq; const float* rc; const float* rs;
    __device__ __forceinline__ void operator()(const f32x4 (&acc)[2][2][4][2], const Unit& u, int wr, int wc, int fr, int fq) const {
#pragma unroll
        for (int ai = 0; ai < 2; ++ai)
#pragma unroll
            for (int m = 0; m < 4; ++m) {
                const int row = u.pm * BM + ai * HALF + wr * 64 + m * 16 + fr;
                const f32x4 s0 = *(const f32x4*)(stq + (size_t)row * 8), s1 = *(const f32x4*)(stq + (size_t)row * 8 + 4);
                const float ss = ((s0[0] + s0[1]) + (s0[2] + s0[3])) + ((s1[0] + s1[1]) + (s1[2] + s1[3]));
                const float sc = rsqrtf(ss * (1.f / 256.f) + EPS) * (0.10206207261596575f * LOG2E);
#pragma unroll
                for (int bj = 0; bj < 2; ++bj) {
                    const int g = u.pn * 8 + bj * 4 + wc;
                    if (g >= 12) continue;
                    f32x4 v0 = acc[ai][bj][m][0], v1 = acc[ai][bj][m][1];
                    if ((g % 3) == 2) rope_pair(v0, v1, rc, rs, row, fq);
                    v0 = v0 * sc; v1 = v1 * sc;
                    bf16_t* pp = MQ + (size_t)row * 384 + g * 32 + 4 * fq;
                    store4(pp, v0); store4(pp + 16, v1);
                }
                asm volatile("" ::: "memory");
            }
    }
};
struct EpiUpKV {
    static constexpr bool PERM = false, AFTER_DRAIN = false;
    bf16_t* MK; bf16_t* VT; const float* stkv; unsigned char* scr;
    __device__ __forceinline__ void operator()(const f32x4 (&acc)[2][2][4][2], const Unit& u, int wr, int wc, int fr, int fq) const {
#pragma unroll
        for (int ai = 0; ai < 2; ++ai)
#pragma unroll
            for (int m = 0; m < 4; ++m) {
                const int row = u.pm * BM + ai * HALF + wr * 64 + m * 16 + fr;
                const f32x4 s0 = *(const f32x4*)(stkv + (size_t)row * 4);
                const float sc = rsqrtf(((s0[0] + s0[1]) + (s0[2] + s0[3])) * (1.f / 128.f) + EPS);
#pragma unroll
                for (int bj = 0; bj < 2; ++bj) {
                    const int g = u.pn * 8 + bj * 4 + wc, hd = g >> 2, part = g & 3;
                    const f32x4 v0 = acc[ai][bj][m][0] * sc, v1 = acc[ai][bj][m][1] * sc;
                    if (part < 2) { bf16_t* pp = MK + (size_t)row * 256 + hd * 64 + part * 32 + 4 * fq; store4(pp, v0); store4(pp + 16, v1); }
                    else { store_vt_tile(VT, 1, hd, (part - 2) * 32, row - fr, v0, v1, (bf16_t*)(scr + (wr * 4 + wc) * 1536), fr, 4 * fq, 16 + 4 * fq, fr + 16 * fq); }
                }
                asm volatile("" ::: "memory");
            }
    }
};
}

DI void phase0(const Params& p, unsigned char* lds) {
    const int tid = ltid(); const size_t gt = (size_t)blockIdx.x * 512 + tid, gn = (size_t)gridDim.x * 512;
    if (blockIdx.x == 0) for (int i = tid; i < 1024; i += 512) ((unsigned*)(KWS + OFF_CTL))[i] = 0u;
    float* rc = (float*)(KWS + OFF_ROPE); float* rs = rc + 4096 * 16;
    for (size_t i = gt; i < 65536; i += gn) { const int t = (int)(i >> 4), jj = (int)(i & 15), k = jj & 7;
        const float freq = powf(10000.f, -(float)k * 0.125f); const float pos = jj < 8 ? (float)(t >> 6) : (float)(t & 63); const float a = pos * freq;
        rc[i] = cosf(a); rs[i] = sinf(a); }
    float* S = (float*)lds;
    float* red = S + 9216;
    for (int i = tid; i < 9216; i += 512) { const int r = i >> 10, k = i & 1023; const float c = r < 8 ? KIN(I_C)[r * 1024 + k] : KIN(I_CCTX)[k]; S[i] = c / (1.f + expf(-c)); }
    __syncthreads();
    float* MODS = (float*)(KWS + OFF_MODS);
    for (int item = blockIdx.x; item < 384; item += gridDim.x) {
        const int l = item / 96, n0 = (item % 96) * 64, kg = tid >> 6, c = tid & 63;
        const float* W = KIN(I_ADAW) + (size_t)l * 1024 * 6144 + n0 + c;
        float acc[9];
#pragma unroll
        for (int r = 0; r < 9; ++r) acc[r] = 0.f;
#pragma unroll 8
        for (int kk = 0; kk < 128; ++kk) { const int k = kg * 128 + kk; const float w = __builtin_nontemporal_load(W + (size_t)k * 6144);
#pragma unroll
            for (int r = 0; r < 9; ++r) acc[r] += S[r * 1024 + k] * w; }
#pragma unroll
        for (int r = 0; r < 9; ++r) red[(kg * 9 + r) * 64 + c] = acc[r];
        __syncthreads();
        for (int o = tid; o < 576; o += 512) { const int r = o >> 6, cc = o & 63; float s = 0.f;
#pragma unroll
            for (int k2 = 0; k2 < 8; ++k2) s += red[(k2 * 9 + r) * 64 + cc];
            MODS[(size_t)(l * 9 + r) * 6144 + n0 + cc] = s + KIN(I_ADAB)[l * 6144 + n0 + cc]; }
        __syncthreads();
    }
}

DI void tr_item(const float* W, int K, int N, bf16_t* WT, int k0, int n0, int drow0, const float* kscale, float* scr, int lane) {
#pragma unroll 8
    for (int i = 0; i < 32; ++i) { const int kk = 2 * i + (lane >> 5); float v = __builtin_nontemporal_load(W + (size_t)(k0 + kk) * N + n0 + (lane & 31)); if (kscale) v *= kscale[k0 + kk]; scr[kk * 33 + (lane & 31)] = v; }
    asm volatile("s_waitcnt lgkmcnt(0)" ::: "memory");
    const int c = lane & 7;
#pragma unroll
    for (int j = 0; j < 4; ++j) { const int n = (lane >> 3) + 8 * j; const float* s = scr + (8 * c) * 33 + n;
        u32x4 o; o.x = pk2(s[0 * 33], s[1 * 33]); o.y = pk2(s[2 * 33], s[3 * 33]); o.z = pk2(s[4 * 33], s[5 * 33]); o.w = pk2(s[6 * 33], s[7 * 33]);
        *(u32x4*)(WT + (size_t)(drow0 + n) * K + k0 + 8 * c) = o; }
    asm volatile("s_waitcnt lgkmcnt(0)" ::: "memory");
}
DI void convert_weights(const Params& p, int l, unsigned char* lds, int mask, int vblock, int vgrid) {
    asm volatile("" : "+s"(l));
    const int tid = ltid(), wave = tid >> 6, lane = tid & 63; const int gw = vblock * 8 + wave, NGW = vgrid * 8;
    float* scr = (float*)lds + wave * 2112;
    bf16_t* Wb = (bf16_t*)(KWS + OFF_W);
    bf16_t* WT_IN = Wb + W_IN / 2; bf16_t* WT_OUT = Wb + W_OUT / 2; bf16_t* WT_F1 = Wb + W_F1 / 2; bf16_t* WT_F2 = Wb + W_F2 / 2; bf16_t* WT_UQ = Wb + W_UQ / 2; bf16_t* WT_UKV = Wb + W_UKV / 2;
    for (int it = gw; it < 6192; it += NGW) {
        int r = it;
        { const bool isf2 = (it >= 4704 && it < 6112); if (!((mask >> (isf2 ? 1 : 0)) & 1)) continue; }
        if (r < 1376) { tr_item(KIN(I_WIN) + (size_t)l * 1024 * INW, 1024, INW, WT_IN, 64 * (r / 86), 32 * (r % 86), 32 * (r % 86), nullptr, scr, lane); continue; } r -= 1376;
        if (r < 512) { tr_item(KIN(I_WOUT) + (size_t)l * 1024 * 1024, 1024, 1024, WT_OUT, 64 * (r / 32), 32 * (r % 32), 32 * (r % 32), nullptr, scr, lane); continue; } r -= 512;
        if (r < 2816) { const int n0 = 32 * (r % 176); const int j = n0 < FFH ? n0 : n0 - FFH; const int drow = 256 * (j / 128) + (j % 128) + (n0 < FFH ? 0 : 128);
            tr_item(KIN(I_FIN) + (size_t)l * 1024 * 5632, 1024, 5632, WT_F1, 64 * (r / 176), n0, drow, nullptr, scr, lane); continue; } r -= 2816;
        if (r < 1408) { tr_item(KIN(I_FOUT) + (size_t)l * FFH * 1024, FFH, 1024, WT_F2, 64 * (r / 32), 32 * (r % 32), 32 * (r % 32), nullptr, scr, lane); continue; } r -= 1408;
        if (r < 48) { tr_item(KIN(I_WUQ) + (size_t)l * 256 * 384, 256, 384, WT_UQ, 64 * (r / 12), 32 * (r % 12), 32 * (r % 12), KIN(I_MQN) + l * 256, scr, lane); continue; } r -= 48;
        tr_item(KIN(I_WUKV) + (size_t)l * 128 * 512, 128, 512, WT_UKV, 64 * (r / 16), 32 * (r % 16), 32 * (r % 16), KIN(I_MKVN) + l * 128, scr, lane);
    }
    if (!(mask & 1)) return;
    const size_t gt = (size_t)vblock * 512 + tid, gn = (size_t)vgrid * 512; unsigned zz = 0u; asm volatile("" : "+v"(zz)); const u32x4 z = {zz, zz, zz, zz};
    for (size_t i = gt; i < 8192; i += gn) ((u32x4*)(WT_IN + (size_t)INW * 1024))[i] = z;
    for (size_t i = gt; i < 4096; i += gn) ((u32x4*)(WT_UQ + (size_t)384 * 256))[i] = z;
}

DI void rowpass(int row_begin, int row_end, int vblock, int vgrid, const float* xinL, const float* xinC, float* xoutL, float* xoutC, const bf16_t* Y, const float* mgate, const float* gpost,
                bf16_t* H, const float* gpre, const float* mshift, const float* mscale) {
    const int tid = ltid(), wave = tid >> 6, lane = tid & 63; const int gw = vblock * 8 + wave, NGW = vgrid * 8;
    f32x4 vn[4]; u32x2 yn[4];
    auto fetch = [&](int row) {
        const float* xr = row < ML ? xinL + (size_t)row * DM : xinC + (size_t)(row - ML) * DM;
#pragma unroll
        for (int j = 0; j < 4; ++j) vn[j] = __builtin_nontemporal_load((const f32x4*)(xr + 4 * lane + 256 * j));
        if (Y) {
#pragma unroll
            for (int j = 0; j < 4; ++j) yn[j] = __builtin_nontemporal_load((const u32x2*)(Y + (size_t)row * DM + 4 * lane + 256 * j)); }
    };
    f32x4 gpo[4], gpr[4], gat[4], shf[4], scl[4];
#pragma unroll
    for (int j = 0; j < 4; ++j) { gpo[j] = Y ? *(const f32x4*)(gpost + 4 * lane + 256 * j) : (f32x4){0.f, 0.f, 0.f, 0.f}; gpr[j] = H ? *(const f32x4*)(gpre + 4 * lane + 256 * j) : (f32x4){0.f, 0.f, 0.f, 0.f};
        gat[j] = gpo[j]; shf[j] = gpo[j]; scl[j] = gpo[j]; }
    int mb_cur = -1;
    int row = row_begin + gw;
    if (row < row_end) fetch(row);
    for (; row < row_end; row += NGW) {
        const int mb = row < ML ? (row >> 12) : 8;
        f32x4 v[4]; u32x2 yw[4];
#pragma unroll
        for (int j = 0; j < 4; ++j) { v[j] = vn[j]; yw[j] = yn[j]; }
        if (row + NGW < row_end) fetch(row + NGW);
        if (mb != mb_cur) {
            mb_cur = mb;
#pragma unroll
            for (int j = 0; j < 4; ++j) { const int c = 4 * lane + 256 * j;
                if (Y) gat[j] = *(const f32x4*)(mgate + (size_t)mb * 6144 + c);
                if (H) { shf[j] = *(const f32x4*)(mshift + (size_t)mb * 6144 + c); scl[j] = *(const f32x4*)(mscale + (size_t)mb * 6144 + c) + 1.f; } }
        }
        if (Y) {
            f32x4 y[4]; float ss = 0.f;
#pragma unroll
            for (int j = 0; j < 4; ++j) { const u32x2 w = yw[j]; y[j] = (f32x4){bflo(w.x), bfhi(w.x), bflo(w.y), bfhi(w.y)};
                ss += (y[j][0] * y[j][0] + y[j][1] * y[j][1]) + (y[j][2] * y[j][2] + y[j][3] * y[j][3]); }
            const float ry = rsqrtf(wave_sum(ss) * (1.f / DM) + EPS);
            float* xo = row < ML ? xoutL + (size_t)row * DM : xoutC + (size_t)(row - ML) * DM;
#pragma unroll
            for (int j = 0; j < 4; ++j) { v[j] = v[j] + gat[j] * (y[j] * ry * gpo[j]); __builtin_nontemporal_store(v[j], (f32x4*)(xo + 4 * lane + 256 * j)); }
        }
        if (H) {
            float ss = 0.f;
#pragma unroll
            for (int j = 0; j < 4; ++j) ss += (v[j][0] * v[j][0] + v[j][1] * v[j][1]) + (v[j][2] * v[j][2] + v[j][3] * v[j][3]);
            const float rx = rsqrtf(wave_sum(ss) * (1.f / DM) + EPS);
#pragma unroll
            for (int j = 0; j < 4; ++j) { const int c = 4 * lane + 256 * j;
                const f32x4 hv = v[j] * rx * gpr[j] * scl[j] + shf[j]; u32x2 w; w.x = pk2(hv[0], hv[1]); w.y = pk2(hv[2], hv[3]); *(u32x2*)(H + (size_t)row * DM + c) = w; }
        }
    }
}

template <int TYPE>
DI void attn_unit(const Params& p, unsigned char* lds, int l, int b, int hd, int qrow0, int NT) {
    asm volatile("" : "+s"(l), "+s"(b), "+s"(hd), "+s"(qrow0), "+s"(NT));
    constexpr int NMAP = TYPE == 0 ? 2 : 1, KS = TYPE == 0 ? 2 : 6, DQ = NMAP * KS * 16, KP = DQ + 8, CPR = DQ / 8;
    constexpr int TK = TYPE == 0 ? 64 : 128, VP = TK + 8, KCH = TK * CPR / 512, VCPR = TK / 8, VCH = 64 * VCPR / 512;
    const int tid = ltid(), lane = tid & 63, w = tid >> 6, r32 = lane & 31, h = lane >> 5;
    bf16_t* Kl = (bf16_t*)lds;
    bf16_t* Vl = (bf16_t*)(lds + 2 * TK * KP * 2);
    const bf16_t* PROJ = (const bf16_t*)(KWS + OFF_PA);
    const bf16_t* MQ = (const bf16_t*)(KWS + OFF_MLAQ);
    const bf16_t* MK = (const bf16_t*)(KWS + OFF_MLAK);
    const bf16_t* VTb = (const bf16_t*)(KWS + OFF_VT) + ((size_t)((TYPE * NB + b) * 4 + hd) * 64) * POSN;
    bf16_t* CC = (bf16_t*)(KWS + OFF_HC);
    bf16x8 qf[NMAP][KS];
    const int qrow = qrow0 + 32 * w + r32;
#pragma unroll
    for (int mp = 0; mp < NMAP; ++mp)
#pragma unroll
        for (int s = 0; s < KS; ++s)
            qf[mp][s] = TYPE == 0 ? *(const bf16x8*)(PROJ + (size_t)qrow * INWP + 64 * hd + mp * 32 + 16 * s + 8 * h)
                                  : *(const bf16x8*)(MQ + (size_t)qrow * 384 + 96 * hd + 16 * s + 8 * h);
    float mrun[NMAP], lsum[NMAP]; f32x16 o[NMAP][2];
#pragma unroll
    for (int mp = 0; mp < NMAP; ++mp) { mrun[mp] = 0.f; lsum[mp] = 0.f;
#pragma unroll
        for (int i = 0; i < 16; ++i) { o[mp][0][i] = 0.f; o[mp][1][i] = 0.f; } }
    u32x4 kreg[KCH], vreg[VCH];
    auto gload = [&](int t) {
#pragma unroll
        for (int i = 0; i < KCH; ++i) { const int c = tid + 512 * i, kr = c / CPR, cc = c % CPR; const int grow = pos_row(b, TK * t + kr);
            if (TYPE == 0) kreg[i] = *(const u32x4*)(PROJ + (size_t)grow * INWP + 256 + 64 * hd + 8 * cc);
            else kreg[i] = cc < 8 ? *(const u32x4*)(MK + (size_t)grow * 256 + 64 * hd + 8 * cc) : *(const u32x4*)(PROJ + (size_t)grow * INWP + 1152 + 8 * (cc - 8)); }
#pragma unroll
        for (int i = 0; i < VCH; ++i) { const int c = tid + 512 * i, e = c / VCPR, jc = c % VCPR; vreg[i] = *(const u32x4*)(VTb + (size_t)e * POSN + TK * t + 8 * jc); }
    };
    auto lstore = [&](int buf) {
#pragma unroll
        for (int i = 0; i < KCH; ++i) { const int c = tid + 512 * i, kr = c / CPR, cc = c % CPR; *(u32x4*)(Kl + (size_t)buf * TK * KP + kr * KP + 8 * cc) = kreg[i]; }
#pragma unroll
        for (int i = 0; i < VCH; ++i) { const int c = tid + 512 * i, e = c / VCPR, jc = c % VCPR; *(u32x4*)(Vl + (size_t)buf * 64 * VP + e * VP + 8 * jc) = vreg[i]; }
    };
    const int NTI = NT * 64 / TK;
    gload(0); lstore(0); __syncthreads();
    bool shifted = false;
    for (int t = 0; t < NTI; ++t) {
        const int buf = t & 1;
        if (t + 1 < NTI) gload(t + 1);
        const bf16_t* Kb = Kl + (size_t)buf * TK * KP; const bf16_t* Vb = Vl + (size_t)buf * 64 * VP;
        bf16x8 pbd[2][4];
        f32x16 a0, a1, b0, b1;
        auto kfrag = [&](int st, int half, int s) { return TYPE == 0 ? *(const bf16x8*)(Kb + (32 * half + r32) * KP + st * 32 + 16 * s + 8 * h)
                                                                       : *(const bf16x8*)(Kb + (64 * st + 32 * half + r32) * KP + 16 * s + 8 * h); };
        auto vfrag = [&](int st, int eb, int s) { return *(const bf16x8*)(Vb + (32 * eb + r32) * VP + (TYPE == 0 ? 0 : 64 * st) + 16 * s + 8 * h); };
        auto sub_ref = [&](f32x16& x0, f32x16& x1, int mi) {
            if (__builtin_expect(shifted, 0)) { asm volatile("" ::: "memory");
#pragma unroll
                for (int i = 0; i < 16; ++i) { x0[i] -= mrun[mi]; x1[i] -= mrun[mi]; } } };
        auto pack8 = [&](const f32x16& x, int base) { u32x4 tt; tt.x = pk2(x[base], x[base + 1]); tt.y = pk2(x[base + 2], x[base + 3]); tt.z = pk2(x[base + 4], x[base + 5]); tt.w = pk2(x[base + 6], x[base + 7]); return __builtin_bit_cast(bf16x8, tt); };
        auto slow = [&](int st, f32x16& x0, f32x16& x1, float& ps) {
            const int mi = TYPE == 0 ? st : 0;
#pragma unroll
            for (int i = 0; i < 16; ++i) { x0[i] = 0.f; x1[i] = 0.f; }
#pragma unroll
            for (int s2 = 0; s2 < KS; ++s2) { x0 = MFMA32(kfrag(st, 0, s2), qf[mi][s2], x0); x1 = MFMA32(kfrag(st, 1, s2), qf[mi][s2], x1); }
            sub_ref(x0, x1, mi);
            float tm = fmaxf(x0[0], x1[0]);
#pragma unroll
            for (int i = 1; i < 16; ++i) tm = fmaxf(tm, fmaxf(x0[i], x1[i]));
            tm = fmaxf(tm, __shfl_xor(tm, 32));
            const bool first = (t == 0) && (TYPE == 0 || st == 0);
            const float dl = first ? tm : fmaxf(tm, 0.f);
            mrun[mi] += dl;
            if (!first) { const float alpha = __builtin_amdgcn_exp2f(-dl); lsum[mi] *= alpha;
#pragma unroll
                for (int i = 0; i < 16; ++i) { o[mi][0][i] *= alpha; o[mi][1][i] *= alpha; } }
            ps = 0.f;
#pragma unroll
            for (int i = 0; i < 16; ++i) { x0[i] = __builtin_amdgcn_exp2f(x0[i] - dl); x1[i] = __builtin_amdgcn_exp2f(x1[i] - dl); ps += x0[i] + x1[i]; }
            shifted = true;
        };
        constexpr int M0 = 0, M1 = TYPE == 0 ? 1 : 0;
#pragma unroll
        for (int i = 0; i < 16; ++i) { a0[i] = 0.f; a1[i] = 0.f; b0[i] = 0.f; b1[i] = 0.f; }
#pragma unroll
        for (int s2 = 0; s2 < KS; ++s2) { a0 = MFMA32(kfrag(0, 0, s2), qf[M0][s2], a0); a1 = MFMA32(kfrag(0, 1, s2), qf[M0][s2], a1); }
        sub_ref(a0, a1, M0);
        float psa = 0.f;
#pragma unroll
        for (int n = 0; n < 2 * KS; ++n) {
            if (n & 1) b1 = MFMA32(kfrag(1, 1, n >> 1), qf[M1][n >> 1], b1); else b0 = MFMA32(kfrag(1, 0, n >> 1), qf[M1][n >> 1], b0);
#pragma unroll
            for (int r = (32 * n) / (2 * KS); r < (32 * (n + 1)) / (2 * KS); ++r) {
                if (r < 16) { a0[r] = __builtin_amdgcn_exp2f(a0[r]); psa += a0[r]; } else { a1[r - 16] = __builtin_amdgcn_exp2f(a1[r - 16]); psa += a1[r - 16]; } }
        }
        {   const bool firstA = (t == 0);
            if (__builtin_expect(__any(!(psa <= 1e13f) || (firstA && psa < 1e-13f)), 0)) slow(0, a0, a1, psa); }
        lsum[M0] += psa;
        pbd[0][0] = pack8(a0, 0); pbd[0][1] = pack8(a0, 8); pbd[0][2] = pack8(a1, 0); pbd[0][3] = pack8(a1, 8);
        sub_ref(b0, b1, M1);
        float psb = 0.f;
#pragma unroll
        for (int eb = 0; eb < 2; ++eb)
#pragma unroll
            for (int s2 = 0; s2 < 4; ++s2) {
                o[M0][eb] = MFMA32(vfrag(0, eb, s2), pbd[0][s2], o[M0][eb]);
                const int q4 = (eb * 4 + s2) * 4;
#pragma unroll
                for (int i = 0; i < 4; ++i) { const int r = q4 + i; if (r < 16) { b0[r] = __builtin_amdgcn_exp2f(b0[r]); psb += b0[r]; } else { b1[r - 16] = __builtin_amdgcn_exp2f(b1[r - 16]); psb += b1[r - 16]; } }
            }
        {   const bool firstB = (t == 0) && TYPE == 0;
            if (__builtin_expect(__any(!(psb <= 1e13f) || (firstB && psb < 1e-13f)), 0)) slow(1, b0, b1, psb); }
        lsum[M1] += psb;
        pbd[1][0] = pack8(b0, 0); pbd[1][1] = pack8(b0, 8); pbd[1][2] = pack8(b1, 0); pbd[1][3] = pack8(b1, 8);
#pragma unroll
        for (int eb = 0; eb < 2; ++eb)
#pragma unroll
            for (int s2 = 0; s2 < 4; ++s2) o[M1][eb] = MFMA32(vfrag(1, eb, s2), pbd[1][s2], o[M1][eb]);
        if (t + 1 < NTI) lstore(buf ^ 1);
        __syncthreads();
    }
    float inv[NMAP];
#pragma unroll
    for (int mp = 0; mp < NMAP; ++mp) { const float lt = lsum[mp] + __shfl_xor(lsum[mp], 32); inv[mp] = 1.f / lt; }
    if (TYPE == 1) {
        bf16_t* op = CC + (size_t)qrow * DM + 256 + 64 * hd;
#pragma unroll
        for (int eb = 0; eb < 2; ++eb)
#pragma unroll
            for (int g = 0; g < 4; ++g) { const f32x4 v = {o[0][eb][4 * g] * inv[0], o[0][eb][4 * g + 1] * inv[0], o[0][eb][4 * g + 2] * inv[0], o[0][eb][4 * g + 3] * inv[0]};
                pg8::store4(op + 32 * eb + 8 * g + 4 * h, v); }
    } else {
        int l2 = l; asm volatile("" : "+s"(l2));
        const float* dl = opq2(KIN(I_DLAM)) + l2 * 128; float d1 = 0.f, d2 = 0.f;
        for (int i = 0; i < 32; ++i) { d1 += dl[i] * dl[32 + i]; d2 += dl[64 + i] * dl[96 + i]; }
        float c08 = 0.8f, c06 = 0.6f; asm volatile("" : "+v"(c08), "+v"(c06));
        const float lam_init = c08 - c06 * __expf(-0.3f * (float)l2);
        const float lam = __expf(d1) - __expf(d2) + lam_init;
        const float* sg = opq2(KIN(I_DNORM)) + l2 * 64;
        float ss = 0.f; const float li1 = lam * inv[NMAP - 1];
#pragma unroll
        for (int eb = 0; eb < 2; ++eb)
#pragma unroll
            for (int i = 0; i < 16; ++i) { const float v = o[0][eb][i] * inv[0] - li1 * o[NMAP - 1][eb][i]; o[0][eb][i] = v; ss += v * v; }
        ss += __shfl_xor(ss, 32);
        const float rn = rsqrtf(ss * (1.f / 64.f) + EPS) * (1.f - lam_init);
        bf16_t* op = CC + (size_t)qrow * DM + 64 * hd;
#pragma unroll
        for (int eb = 0; eb < 2; ++eb)
#pragma unroll
            for (int g = 0; g < 4; ++g) { const int e0 = 32 * eb + 8 * g + 4 * h; const f32x4 gg = *(const f32x4*)(sg + e0);
                const f32x4 v = {o[0][eb][4 * g] * rn * gg[0], o[0][eb][4 * g + 1] * rn * gg[1], o[0][eb][4 * g + 2] * rn * gg[2], o[0][eb][4 * g + 3] * rn * gg[3]};
                pg8::store4(op + e0, v); }
    }
}

DI void scan_unit(const Params& p, unsigned char* lds, int l, int mixer, int b, int hd, int item) {
    asm volatile("" : "+s"(l), "+s"(mixer), "+s"(b), "+s"(hd), "+s"(item));
    const int tid = ltid(), dir = tid >> 8, td = tid & 255, lane = tid & 63, wd = (tid >> 6) & 3, r32 = lane & 31, h = lane >> 5;
    unsigned char* L = lds + dir * 55296;
    bf16_t* QT = (bf16_t*)(L);
    bf16_t* KT = (bf16_t*)(L + 5120);
    bf16_t* KH = (bf16_t*)(L + 10240);
    bf16_t* ST = (bf16_t*)(L + 14848);
    bf16_t* VTt = (bf16_t*)(L + 19968);
    bf16_t* SC = (bf16_t*)(L + 29184);
    float* OL = (float*)(L + 19968);
    float* BB = (float*)(L + 38400);
    float* SEG = (float*)(L + 46592);
    float* BEND = (float*)(L + 47616);
    float* WG = (float*)(L + 47744);
    float* GT = (float*)(L + 49920);
    const bf16_t* PROJ = (const bf16_t*)(KWS + OFF_PA);
    bf16_t* CC = (bf16_t*)(KWS + OFF_HC);
    float* OTMP = (float*)(KWS + OFF_Y) + (size_t)item * 68 * 4096;
    const int qcol = (mixer == 0 ? 1184 : 1984) + 32 * hd, kcol = (mixer == 0 ? 1312 : 2112) + 32 * hd, ogcol = (mixer == 0 ? 1696 : 2496) + 64 * hd;
    const int ccol = 512 + 256 * mixer + 64 * hd;
    const bf16_t* VTb = (const bf16_t*)(KWS + OFF_VT) + ((size_t)(((mixer == 0 ? 2 : 3) * NB + b) * 4 + hd) * 64) * POSN;
    const float* og = (mixer == 0 ? KIN(I_GNORM) : KIN(I_RNORM)) + l * 64;
    float lg = 0.f;
    float ogr[16];
#pragma unroll
    for (int i = 0; i < 16; ++i) ogr[i] = og[16 * (td & 3) + i];
    float wg[16], wb = 0.f;
#pragma unroll
    for (int r = 0; r < 16; ++r) wg[r] = 0.f;
    if (mixer == 0) {
        const float* gw = KIN(I_GWG) + (size_t)((l * 2 + dir) * 16) * 128 + 32 * hd + (td & 31);
#pragma unroll
        for (int r = 0; r < 16; ++r) wg[r] = gw[r * 128];
        wb = KIN(I_GBG)[(l * 2 + dir) * 128 + 32 * hd + (td & 31)];
    } else lg = logsig_f(KIN(I_RDEC)[(l * 2 + dir) * 4 + hd]);
    for (int idx = td; idx < 64 * 40; idx += 256) ST[idx] = 0;
    f32x16 Sacc;
#pragma unroll
    for (int i = 0; i < 16; ++i) Sacc[i] = 0.f;
    u32x4 qreg, kreg, vreg0, vreg1, greg;
    auto chunk_of = [&](int s) { return dir == 0 ? s : (s < 4 ? 3 - s : 71 - s); };
    auto chunk_row0 = [&](int g) { return g < 4 ? ML + b * CTXL + 64 * g : b * SEQL + 64 * (g - 4); };
    auto gload = [&](int s) {
        const int g = chunk_of(s), row0 = chunk_row0(g);
        qreg = *(const u32x4*)(PROJ + (size_t)(row0 + (td >> 2)) * INWP + qcol + 8 * (td & 3));
        kreg = *(const u32x4*)(PROJ + (size_t)(row0 + (td >> 2)) * INWP + kcol + 8 * (td & 3));
        vreg0 = *(const u32x4*)(VTb + (size_t)(td >> 3) * POSN + 64 * g + 8 * (td & 7));
        vreg1 = *(const u32x4*)(VTb + (size_t)(32 + (td >> 3)) * POSN + 64 * g + 8 * (td & 7));
        if (mixer == 0 && td < 128) greg = *(const u32x4*)(PROJ + (size_t)(row0 + (td >> 1)) * INWP + 1952 + 16 * dir + 8 * (td & 1));
    };
    gload(0);
    __syncthreads();
    for (int s = 0; s < 68; ++s) {
        const int g = chunk_of(s), row0 = chunk_row0(g);
        *(u32x4*)(VTt + (td >> 3) * 72 + 8 * (td & 7)) = vreg0;
        *(u32x4*)(VTt + (32 + (td >> 3)) * 72 + 8 * (td & 7)) = vreg1;
        if (mixer == 0 && td < 128) { float* gp = GT + (td >> 1) * 16 + 8 * (td & 1);
            gp[0] = bflo(greg.x); gp[1] = bfhi(greg.x); gp[2] = bflo(greg.y); gp[3] = bfhi(greg.y); gp[4] = bflo(greg.z); gp[5] = bfhi(greg.z); gp[6] = bflo(greg.w); gp[7] = bfhi(greg.w); }
        const u32x4 qc = qreg, kc = kreg;
        if (s + 1 < 68) gload(s + 1);
        const int s_other = dir == 0 ? (g < 4 ? 3 - g : 71 - g) : g;
        const bool fin = s_other < s;
        float* ot = OTMP + (size_t)g * 4096 + (td >> 2) * 64 + 16 * (td & 3);
        f32x4 pf0, pf1, pf2, pf3; u32x4 g0, g1;
        LBAR();
        { const int d = td & 31, seg = td >> 5; float a[8];
          if (mixer == 0) {
#pragma unroll
              for (int i = 0; i < 8; ++i) { const float* gr = GT + (8 * seg + i) * 16;
                  const f32x4 x0 = *(const f32x4*)gr, x1 = *(const f32x4*)(gr + 4), x2 = *(const f32x4*)(gr + 8), x3 = *(const f32x4*)(gr + 12);
                  float acc = wb;
                  acc += x0[0] * wg[0]; acc += x0[1] * wg[1]; acc += x0[2] * wg[2]; acc += x0[3] * wg[3];
                  acc += x1[0] * wg[4]; acc += x1[1] * wg[5]; acc += x1[2] * wg[6]; acc += x1[3] * wg[7];
                  acc += x2[0] * wg[8]; acc += x2[1] * wg[9]; acc += x2[2] * wg[10]; acc += x2[3] * wg[11];
                  acc += x3[0] * wg[12]; acc += x3[1] * wg[13]; acc += x3[2] * wg[14]; acc += x3[3] * wg[15];
                  a[i] = logsig_f(acc) * (1.f / 16.f); }
          } else {
#pragma unroll
              for (int i = 0; i < 8; ++i) a[i] = lg;
          }
          float run = 0.f;
          if (dir == 0) {
#pragma unroll
              for (int i = 0; i < 8; ++i) { run += a[i]; a[i] = run; }
          } else {
#pragma unroll
              for (int i = 7; i >= 0; --i) { run += a[i]; a[i] = run; }
          }
          SEG[seg * 32 + d] = run;
          LBAR();
          float off = 0.f, tot = 0.f;
#pragma unroll
          for (int s2 = 0; s2 < 8; ++s2) { const float sv = SEG[s2 * 32 + d]; tot += sv; if (dir == 0 ? (s2 < seg) : (s2 > seg)) off += sv; }
#pragma unroll
          for (int i = 0; i < 8; ++i) BB[(8 * seg + i) * 32 + d] = a[i] + off;
          if (seg == 0) { BEND[d] = tot; BEND[32 + d] = __expf(tot); } }
        LBAR();
        { const int j = td >> 2, cc = td & 3;
          float qv[8] = {bflo(qc.x), bfhi(qc.x), bflo(qc.y), bfhi(qc.y), bflo(qc.z), bfhi(qc.z), bflo(qc.w), bfhi(qc.w)};
          float kv[8] = {bflo(kc.x), bfhi(kc.x), bflo(kc.y), bfhi(kc.y), bflo(kc.z), bfhi(kc.z), bflo(kc.w), bfhi(kc.w)};
          float k1[8];
#pragma unroll
          for (int i = 0; i < 8; ++i) { const int d = 8 * cc + i; const float bv = BB[j * 32 + d], ee = BEND[32 + d];
              const float eb = __expf(bv), en = __builtin_amdgcn_rcpf(eb); qv[i] *= eb; k1[i] = kv[i] * en; KH[d * 72 + ((j & ~12) | ((j & 4) << 1) | ((j & 8) >> 1))] = (bf16_t)f2bf(kv[i] * (ee * en)); }
          u32x4 wq, wk; wq.x = pk2(qv[0], qv[1]); wq.y = pk2(qv[2], qv[3]); wq.z = pk2(qv[4], qv[5]); wq.w = pk2(qv[6], qv[7]);
          wk.x = pk2(k1[0], k1[1]); wk.y = pk2(k1[2], k1[3]); wk.z = pk2(k1[4], k1[5]); wk.w = pk2(k1[6], k1[7]);
          *(u32x4*)(QT + j * 40 + 8 * cc) = wq; *(u32x4*)(KT + j * 40 + 8 * cc) = wk; }
        __syncthreads();
        if (fin) { pf0 = *(const f32x4*)(ot); pf1 = *(const f32x4*)(ot + 4); pf2 = *(const f32x4*)(ot + 8); pf3 = *(const f32x4*)(ot + 12);
            const bf16_t* gp = PROJ + (size_t)(row0 + (td >> 2)) * INWP + ogcol + 16 * (td & 3); g0 = *(const u32x4*)gp; g1 = *(const u32x4*)(gp + 8); }
        { const int jb = wd >> 1, ib = wd & 1; const bool skip = dir == 0 ? (jb > ib) : (jb < ib);
          f32x16 pa;
#pragma unroll
          for (int i = 0; i < 16; ++i) pa[i] = 0.f;
          if (!skip) {
#pragma unroll
              for (int s2 = 0; s2 < 2; ++s2) { const bf16x8 a = *(const bf16x8*)(KT + (32 * jb + r32) * 40 + 16 * s2 + 8 * h), bq = *(const bf16x8*)(QT + (32 * ib + r32) * 40 + 16 * s2 + 8 * h);
                  pa = MFMA32(a, bq, pa); }
          }
          const int itok = 32 * ib + r32;
#pragma unroll
          for (int gq = 0; gq < 4; ++gq) { f32x4 v;
#pragma unroll
              for (int i = 0; i < 4; ++i) { const int j = 32 * jb + 8 * gq + 4 * h + i; const bool keep = dir == 0 ? (j <= itok) : (j >= itok); v[i] = keep ? pa[4 * gq + i] : 0.f; }
              pg8::store4(SC + itok * 72 + 32 * jb + 16 * (gq >> 1) + 8 * h + 4 * (gq & 1), v); } }
        LBAR();
        f32x16 oacc;
        { const int eb = wd >> 1, ib = wd & 1;
#pragma unroll
          for (int i = 0; i < 16; ++i) oacc[i] = 0.f;
#pragma unroll
          for (int s2 = 0; s2 < 4; ++s2) { const bf16x8 a = *(const bf16x8*)(VTt + (32 * eb + r32) * 72 + 16 * s2 + 8 * h), bb = *(const bf16x8*)(SC + (32 * ib + r32) * 72 + 16 * s2 + 8 * h);
              oacc = MFMA32(a, bb, oacc); }
#pragma unroll
          for (int s2 = 0; s2 < 2; ++s2) { const bf16x8 a = *(const bf16x8*)(ST + (32 * eb + r32) * 40 + 16 * s2 + 8 * h), bb = *(const bf16x8*)(QT + (32 * ib + r32) * 40 + 16 * s2 + 8 * h);
              oacc = MFMA32(a, bb, oacc); }
          if (wd < 2) { const float dec = BEND[32 + r32];
#pragma unroll
              for (int i = 0; i < 16; ++i) Sacc[i] *= dec;
#pragma unroll
              for (int s2 = 0; s2 < 4; ++s2) { const bf16x8 a = *(const bf16x8*)(VTt + (32 * wd + r32) * 72 + 16 * s2 + 8 * h), bb = *(const bf16x8*)(KH + r32 * 72 + 16 * s2 + 8 * h);
                  Sacc = MFMA32(a, bb, Sacc); } } }
        LBAR();
        { const int eb = wd >> 1, ib = wd & 1;
#pragma unroll
          for (int gq = 0; gq < 4; ++gq) *(f32x4*)(OL + (32 * ib + r32) * 68 + 32 * eb + 8 * gq + 4 * h) = (f32x4){oacc[4 * gq], oacc[4 * gq + 1], oacc[4 * gq + 2], oacc[4 * gq + 3]};
          if (wd < 2) {
#pragma unroll
              for (int i = 0; i < 16; ++i) ST[(32 * wd + crow(i, h)) * 40 + r32] = (bf16_t)f2bf(Sacc[i]); } }
        LBAR();
        { const int j = td >> 2, e0 = 16 * (td & 3); float ov[16];
#pragma unroll
          for (int q4 = 0; q4 < 4; ++q4) { const f32x4 v = *(const f32x4*)(OL + j * 68 + e0 + 4 * q4); ov[4 * q4] = v[0]; ov[4 * q4 + 1] = v[1]; ov[4 * q4 + 2] = v[2]; ov[4 * q4 + 3] = v[3]; }
          if (fin) {
              float ss = 0.f;
              const float pv[16] = {pf0[0], pf0[1], pf0[2], pf0[3], pf1[0], pf1[1], pf1[2], pf1[3], pf2[0], pf2[1], pf2[2], pf2[3], pf3[0], pf3[1], pf3[2], pf3[3]};
#pragma unroll
              for (int i = 0; i < 16; ++i) { ov[i] += pv[i]; ss += ov[i] * ov[i]; }
              ss += __shfl_xor(ss, 1); ss += __shfl_xor(ss, 2);
              const float rn = rsqrtf(ss * (1.f / 64.f) + EPS);
              const int row = row0 + j;
              const float gv[16] = {bflo(g0.x), bfhi(g0.x), bflo(g0.y), bfhi(g0.y), bflo(g0.z), bfhi(g0.z), bflo(g0.w), bfhi(g0.w),
                                    bflo(g1.x), bfhi(g1.x), bflo(g1.y), bfhi(g1.y), bflo(g1.z), bfhi(g1.z), bflo(g1.w), bfhi(g1.w)};
              float r[16];
#pragma unroll
              for (int i = 0; i < 16; ++i) r[i] = ov[i] * rn * ogr[i] * silu_f(gv[i]);
              u32x4 w0, w1; w0.x = pk2(r[0], r[1]); w0.y = pk2(r[2], r[3]); w0.z = pk2(r[4], r[5]); w0.w = pk2(r[6], r[7]);
              w1.x = pk2(r[8], r[9]); w1.y = pk2(r[10], r[11]); w1.z = pk2(r[12], r[13]); w1.w = pk2(r[14], r[15]);
              *(u32x4*)(CC + (size_t)row * DM + ccol + e0) = w0; *(u32x4*)(CC + (size_t)row * DM + ccol + e0 + 8) = w1;
          } else {
#pragma unroll
              for (int q4 = 0; q4 < 4; ++q4) *(f32x4*)(ot + 4 * q4) = (f32x4){ov[4 * q4], ov[4 * q4 + 1], ov[4 * q4 + 2], ov[4 * q4 + 3]};
          } }
        LBAR();
    }
    __syncthreads();
}

DI void mixer_phase(const Params& p, unsigned char* lds, int l, int rep) {
    asm volatile("" : "+s"(l));
    const int tid = ltid();
    unsigned* ctr = (unsigned*)(KWS + OFF_CTL) + 64 * (l + 1 + 4 * rep);
    volatile int* s_item = (volatile int*)(lds + LDS_CTL_OFF);
    const bool with_ctx = l < NLAYER - 1;
    const int nitems = 64 + 1024 + (with_ctx ? 64 : 0);
    for (;;) {
        if (tid == 0) *s_item = (int)atomicAdd(ctr, 1u);
        __syncthreads();
        const int it = __builtin_amdgcn_readfirstlane(*s_item);
        __syncthreads();
        if (it >= nitems) break;
        if (rep > 0 && ((REP_MIX_ONLY == 1 && it >= 64) || (REP_MIX_ONLY == 2 && it < 64))) continue;
        if (it < 64) { if (PH(11)) scan_unit(p, lds, l, it >> 5, (it >> 2) & 7, it & 3, it); }
        else { int type, b, hd, qrow0, NT;
            if (it < 64 + 1024) { const int u = it - 64, rem = u & 511, qb = rem & 15; type = u >> 9; b = rem >> 6; hd = (rem >> 4) & 3; qrow0 = b * SEQL + 256 * qb; NT = POSN / 64; }
            else { const int u = it - 1088; type = u >> 5; b = (u >> 2) & 7; hd = u & 3; qrow0 = ML + b * CTXL; NT = CTXL / 64; }
            if (type == 0) { if (PH(12)) attn_unit<0>(p, lds, l, b, hd, qrow0, NT); } else { if (PH(13)) attn_unit<1>(p, lds, l, b, hd, qrow0, NT); } }
    }
}

#define LAS __attribute__((address_space(3)))
#define XB_TMO      128
#define XB_XCNT(j)  (256  + 64 * (j))
#define XB_XSUB(j)  (1280 + 64 * (j))
#define XB_XGEN(j)  (2304 + 64 * (j))
#define XB_TOP      3328
#define XB_TOPGEN   3392
#define XCD_BAR_WORDS 3456
#define XB_SPIN_CAP (1u << 18)

__device__ __forceinline__ unsigned xb_ld(unsigned* p)              { return __hip_atomic_load(p, __ATOMIC_RELAXED, __HIP_MEMORY_SCOPE_AGENT); }
__device__ __forceinline__ unsigned xb_add(unsigned* p, unsigned v) { return __hip_atomic_fetch_add(p, v, __ATOMIC_RELAXED, __HIP_MEMORY_SCOPE_AGENT); }
__device__ __forceinline__ unsigned xb_xcc_id() { return (unsigned)__builtin_amdgcn_s_getreg((3 << 11) | 20) & 0xFu; }
#define XB_SPIN(cond, bar) do { unsigned _sp = 0; while (cond) { __builtin_amdgcn_s_sleep(1); \
    if ((++_sp & 255u) == 0u) { if (xb_ld(&(bar)[XB_TMO])) break; if (_sp > XB_SPIN_CAP) { atomicAdd(&(bar)[XB_TMO], 1u); break; } } } } while (0)

struct XcdBarrier {
    unsigned* bar; unsigned x;
    volatile LAS unsigned* st;
};

__device__ __forceinline__ XcdBarrier xcd_barrier_post(unsigned* bar, volatile LAS unsigned* st) {
    XcdBarrier b; b.bar = bar; b.x = xb_xcc_id(); b.st = st;
    if (threadIdx.x == 0) (void)xb_add(&bar[XB_XCNT(b.x)], 1u);
    return b;
}
__device__ __forceinline__ void xcd_barrier_complete(unsigned* bar, unsigned x, unsigned& nloc, unsigned& nx) {
    const unsigned G = gridDim.x * gridDim.y * gridDim.z;
    unsigned sum, cnt, mine, sp = 0u;
    for (;;) {
        sum = 0u; cnt = 0u; mine = 0u;
#pragma unroll
        for (unsigned j = 0; j < 16; ++j) { const unsigned c = xb_ld(&bar[XB_XCNT(j)]); sum += c; cnt += (c > 0u) ? 1u : 0u; mine = (j == x) ? c : mine; }
        if (sum == G) break;
        __builtin_amdgcn_s_sleep(1);
        if ((++sp & 255u) == 0u) { if (xb_ld(&bar[XB_TMO])) break; if (sp > XB_SPIN_CAP) { atomicAdd(&bar[XB_TMO], 1u); break; } }
    }
    nloc = mine > 0u ? mine : 1u; nx = cnt > 0u ? cnt : 1u;
}

__device__ __forceinline__ void xcd_barrier(const XcdBarrier& b) {
    asm volatile("s_waitcnt vmcnt(0)" ::: "memory");
    __syncthreads();
    if (threadIdx.x == 0) {
        unsigned* bar = b.bar;
        __builtin_amdgcn_s_waitcnt(0);
        unsigned nloc = b.st[0], nx = b.st[1];
        if (nloc == 0u) { xcd_barrier_complete(bar, b.x, nloc, nx); b.st[0] = nloc; b.st[1] = nx; }
        const unsigned old = xb_add(&bar[XB_XSUB(b.x)], 1u);
        const unsigned gen = old / nloc;
        if (old + 1u == (gen + 1u) * nloc) {
            __builtin_amdgcn_fence(__ATOMIC_RELEASE, "agent");
            asm volatile("s_waitcnt vmcnt(0)" ::: "memory");
            const unsigned og = xb_add(&bar[XB_TOP], 1u);
            const unsigned tg = og / nx;
            if (og + 1u == (tg + 1u) * nx) xb_add(&bar[XB_TOPGEN], 1u);
            else XB_SPIN(xb_ld(&bar[XB_TOPGEN]) == tg, bar);
            __builtin_amdgcn_fence(__ATOMIC_ACQUIRE, "agent");
            xb_add(&bar[XB_XGEN(b.x)], 1u);
            asm volatile("s_waitcnt vmcnt(0)" ::: "memory");
        } else {
            XB_SPIN(xb_ld(&bar[XB_XGEN(b.x)]) == gen, bar);
            __builtin_amdgcn_fence(__ATOMIC_ACQUIRE, "agent");
            asm volatile("s_waitcnt vmcnt(0)" ::: "memory");
        }
    }
    __syncthreads();
}

template <class T> DI T* opq(T* q) { asm volatile("" : "+s"(q)); return q; }
__global__ void __launch_bounds__(512, 2) mega(Params p) {
    extern __shared__ __attribute__((aligned(16))) unsigned char lds[];
    cg::grid_group grid = cg::this_grid();
    { volatile LAS unsigned* z = (volatile LAS unsigned*)((LAS unsigned char*)lds + LDS_CTL_OFF); if (threadIdx.x < 16) z[threadIdx.x] = 0u; }
    __syncthreads();
    const XcdBarrier xbar = xcd_barrier_post((unsigned*)(KWS + OFF_BAR), (volatile LAS unsigned*)((LAS unsigned char*)lds + LDS_CTL_OFF + 32));
#if USE_CG_SYNC
#define GSYNC() grid.sync()
#else
#define GSYNC() xcd_barrier(xbar)
#endif
    PG8_LAS unsigned char* lds3 = (PG8_LAS unsigned char*)lds;
    const int G = gridDim.x, c = blockIdx.x;
#define WSB(off) (opq(KWS) + (off))
#define WGT(off) ((bf16_t*)(opq(KWS) + OFF_W + (off)))

    if (PH(0)) phase0(p, lds);
    grid.sync();
#pragma unroll 1
    for (int l = 0; l < NLAYER; ++l) {
        const bool with_ctx = l < NLAYER - 1;
        const int Mrows = with_ctx ? MT : ML;
        if (PH(1)) {
            const float* ng = opq(KIN(I_NORMG)) + (size_t)l * 4 * DM; const float* MODS = (const float*)WSB(OFF_MODS); const float* ml = MODS + (size_t)l * 9 * 6144;
            bf16_t* HC = (bf16_t*)WSB(OFF_HC); float* XC = (float*)WSB(OFF_XCTX); float* outp = opq(KOUT);
            if (l == 0) rowpass(0, MT, c, G, KIN(I_X), KIN(I_CTX), nullptr, nullptr, nullptr, nullptr, nullptr, HC, ng, ml, ml + 1024);
            else {
                if (c < 32) { pg8::Gemm g{(const bf16_t*)WSB(OFF_PA) + (size_t)ML * FFH, WGT(W_F2), MC, DM, FFH, FFH}; pg8::StaticOrder S; S.init(MC, DM, G, c);
                    pg8::EpiY E{(bf16_t*)WSB(OFF_Y) + (size_t)ML * DM, DM};
                    pg8::gemm_phase<pg8::EpiY, pg8::StaticOrder, true, true>(lds3, g, S, E); }
                else { rowpass(0, ML, c - 32, G - 32, outp, XC, outp, XC, (const bf16_t*)WSB(OFF_Y), MODS + (size_t)(l - 1) * 9 * 6144 + 5 * 1024, ng - DM, HC, ng, ml, ml + 1024);
                    if (PH(2)) convert_weights(p, l, lds, 1, c - 32, G - 32); }
                GSYNC();
                rowpass(ML, MT, c, G, outp, XC, outp, XC, (const bf16_t*)WSB(OFF_Y), MODS + (size_t)(l - 1) * 9 * 6144 + 5 * 1024, ng - DM, HC, ng, ml, ml + 1024);
            }
        }
        for (int rep = 0; rep < REP_CONV; ++rep) { if (PH(2)) convert_weights(p, l, lds, l == 0 ? 3 : 2, c, G); }
        for (int rep = 0; rep < REP_RP0; ++rep) { const float* ng = opq(KIN(I_NORMG)); const float* ml = (const float*)WSB(OFF_MODS); rowpass(0, MT, c, G, KIN(I_X), KIN(I_CTX), nullptr, nullptr, nullptr, nullptr, nullptr, (bf16_t*)WSB(OFF_Y), ng, ml, ml + 1024); }
        GSYNC();
        for (int rep = 0; rep < REP_SYNC; ++rep) GSYNC();
        for (int rep = 0; rep < REP_G3; ++rep) { if (rep) GSYNC();
        if (PH(3)) { pg8::Gemm g{(const bf16_t*)WSB(OFF_HC), WGT(W_IN), MT, INWP, DM, DM}; pg8::StaticOrder S; S.init(MT, INWP, G, c);
          const float* rc = (const float*)WSB(OFF_ROPE);
          pg8::EpiProj E{(bf16_t*)WSB(OFF_PA), (bf16_t*)WSB(OFF_VT), (float*)WSB(OFF_STQ), (float*)WSB(OFF_STKV), rc, rc + 4096 * 16, lds + LDS_CTL_OFF + 256};
          pg8::gemm_phase<pg8::EpiProj, pg8::StaticOrder, true, true>(lds3, g, S, E); } }
        GSYNC();
        for (int rep = 0; rep < REP_C; ++rep) {
        if (PH(4)) { int Kq = 256; asm volatile("" : "+s"(Kq)); pg8::Gemm g{(const bf16_t*)WSB(OFF_PA) + 768, WGT(W_UQ), MT, 512, Kq, INWP}; pg8::StaticOrder S; S.init(MT, 512, G, c);
          const float* rc = (const float*)WSB(OFF_ROPE);
          pg8::EpiUpQ E{(bf16_t*)WSB(OFF_MLAQ), (const float*)WSB(OFF_STQ), rc, rc + 4096 * 16};
          pg8::gemm_phase<pg8::EpiUpQ, pg8::StaticOrder, true, true>(lds3, g, S, E); }
        if (PH(5)) { int Kq = 128; asm volatile("" : "+s"(Kq)); pg8::Gemm g{(const bf16_t*)WSB(OFF_PA) + 1024, WGT(W_UKV), MT, 512, Kq, INWP}; pg8::StaticOrder S; S.init(MT, 512, G, (c + G / 2) % G);
          pg8::EpiUpKV E{(bf16_t*)WSB(OFF_MLAK), (bf16_t*)WSB(OFF_VT), (const float*)WSB(OFF_STKV), lds + LDS_CTL_OFF + 256};
          pg8::gemm_phase<pg8::EpiUpKV, pg8::StaticOrder, true, true>(lds3, g, S, E); }
        GSYNC(); }
        for (int rep = 0; rep < REP_MIX; ++rep) { if (PH(6)) mixer_phase(p, lds, l, rep); GSYNC(); }
        for (int rep = 0; rep < REP_G7; ++rep) { if (rep) GSYNC();
        if (PH(7)) { pg8::Gemm g{(const bf16_t*)WSB(OFF_HC), WGT(W_OUT), Mrows, DM, DM, DM}; pg8::StaticOrder S; S.init(Mrows, DM, G, c);
          pg8::EpiY E{(bf16_t*)WSB(OFF_Y), DM};
          pg8::gemm_phase<pg8::EpiY, pg8::StaticOrder, true, true>(lds3, g, S, E); } }
        GSYNC();
        if (PH(8)) {
            const float* ng = opq(KIN(I_NORMG)) + (size_t)l * 4 * DM; const float* ml = (const float*)WSB(OFF_MODS) + (size_t)l * 9 * 6144;
            float* XC = (float*)WSB(OFF_XCTX); float* outp = opq(KOUT);
            rowpass(0, Mrows, c, G, l == 0 ? KIN(I_X) : outp, l == 0 ? KIN(I_CTX) : XC, outp, XC, (const bf16_t*)WSB(OFF_Y), ml + 2 * 1024, ng + DM, (bf16_t*)WSB(OFF_HC), ng + 2 * DM, ml + 3 * 1024, ml + 4 * 1024);
        }
        GSYNC();
        for (int rep = 0; rep < REP_G9; ++rep) { if (rep) GSYNC();
        if (PH(9)) { pg8::Gemm g{(const bf16_t*)WSB(OFF_HC), WGT(W_F1), Mrows, 2 * FFH, DM, DM}; pg8::StaticOrder S; S.init(Mrows, 2 * FFH, G, c);
          pg8::EpiSwiglu E{(bf16_t*)WSB(OFF_PA)};
          pg8::gemm_phase<pg8::EpiSwiglu, pg8::StaticOrder, true, true>(lds3, g, S, E); } }
        GSYNC();
        for (int rep = 0; rep < REP_G10; ++rep) { if (rep) GSYNC();
        if (PH(10)) { pg8::Gemm g{(const bf16_t*)WSB(OFF_PA), WGT(W_F2), ML, DM, FFH, FFH}; pg8::StaticOrder S; S.init(ML, DM, G, c);
          pg8::EpiY E{(bf16_t*)WSB(OFF_Y), DM};
          pg8::gemm_phase<pg8::EpiY, pg8::StaticOrder, true, true>(lds3, g, S, E); } }
        GSYNC();
    }
    { float* XC = (float*)WSB(OFF_XCTX); float* outp = opq(KOUT);
      rowpass(0, ML, c, G, outp, XC, outp, XC, (const bf16_t*)WSB(OFF_Y), (const float*)WSB(OFF_MODS) + (size_t)3 * 9 * 6144 + 5 * 1024, KIN(I_NORMG) + (size_t)3 * 4 * DM + 3 * DM, nullptr, nullptr, nullptr, nullptr); }
}

extern "C" void kernel_launch(void* const* d_in, const int* in_sizes, int n_in, void* d_out, int out_size, void* d_ws, size_t ws_size, hipStream_t stream) {
    static int grid_blocks = 0;
    if (!grid_blocks) {
        if (n_in != 22 || ws_size < WS_END2) { fprintf(stderr, "kernel_launch: unexpected n_in %d or ws_size %zu (need %zu)\n", n_in, ws_size, (size_t)WS_END2); grid_blocks = -1; return; }
        int dev = 0, cus = 0, per_cu = 0;
        (void)hipGetDevice(&dev);
        (void)hipDeviceGetAttribute(&cus, hipDeviceAttributeMultiprocessorCount, dev);
        (void)hipFuncSetAttribute((const void*)mega, hipFuncAttributeMaxDynamicSharedMemorySize, LDS_BYTES);
        (void)hipOccupancyMaxActiveBlocksPerMultiprocessor(&per_cu, (const void*)mega, 512, LDS_BYTES);
        if (per_cu < 1) per_cu = 1;
        grid_blocks = cus * per_cu;
    }
    if (grid_blocks < 0) return;
    (void)hipMemsetAsync((unsigned char*)d_ws + OFF_BAR, 0, 16384, stream);
    Params p{};
    for (int i = 0; i < 22; ++i) p.in[i] = (const float*)d_in[i];
    p.out = (float*)d_out; p.ws = (unsigned char*)d_ws;
    void* args[] = {&p};
    hipError_t e = hipLaunchCooperativeKernel((const void*)mega, dim3(grid_blocks), dim3(512), args, LDS_BYTES, stream);
    if (e != hipSuccess) fprintf(stderr, "cooperative launch failed: %s (grid %d)\n", hipGetErrorString(e), grid_blocks);
}
```

```cpp
#include <hip/hip_runtime.h>
#include <hip/hip_cooperative_groups.h>
#include <cstdio>
#include <cstdint>
namespace cg = cooperative_groups;
namespace pg8 {
#define PG8_LAS __attribute__((address_space(3)))
typedef unsigned short bf16_t;
typedef short bf16x8 __attribute__((ext_vector_type(8)));
typedef float f32x4 __attribute__((ext_vector_type(4)));
typedef unsigned u32x4 __attribute__((ext_vector_type(4)));
constexpr int BM = 256, BK = 64, HALF = 128, HTB = HALF * BK * 2  , STAGE_BYTES = 8 * HTB, NXCD = 8, WGM = 8;

__host__ __device__ __forceinline__ int lds_byte(int r, int c) { const int st = (r >> 4) * 2 + (c >> 5), rr = r & 15, cc = c & 31, ob = rr * 64 + cc * 2; return st * 1024 + (ob ^ (((ob >> 9) & 1) << 5)); }
__host__ __device__ __forceinline__ void stage_rc(int b, int& R, int& C) { const int st = b / 1024, sb = b % 1024, swz = sb ^ (((sb >> 9) & 1) << 5); R = (st >> 1) * 16 + swz / 64; C = (st & 1) * 32 + (swz % 64) / 2; }
__host__ __device__ __forceinline__ int perm32(int rho) { const int n = rho >> 4, i = rho & 15; return 8 * (i >> 2) + 4 * n + (i & 3); }

struct Unit { int pm, pn; };
struct Gemm { const bf16_t* A; const bf16_t* Bt; int M, N, K, lda; };

struct StaticOrder {
    int nM, nN, nwg, G, c;
    __host__ __device__ void init(int M, int N, int G_, int c_) { nM = M / BM; nN = N / BM; nwg = nM * nN; G = G_; c = c_; }
    __host__ __device__ bool next(int i, Unit& u) const {
        const long L = (long)i * G + c; if (L >= nwg) return false;
        int wgid = (int)L; { const int q = nwg / NXCD, r = nwg % NXCD, xcd = wgid % NXCD, off = wgid / NXCD; wgid = (xcd < r ? xcd * (q + 1) : r * (q + 1) + (xcd - r) * q) + off; }
        const int nig = WGM * nN, gid = wgid / nig, fm = gid * WGM, gsz = (nM - fm) < WGM ? (nM - fm) : WGM;
        u.pm = fm + ((wgid % nig) % gsz); u.pn = (wgid % nig) / gsz; return true;
    }
    __device__ __forceinline__ void a_ready(const Unit&) const {}
    __device__ __forceinline__ void done(const Unit&) const {}
};

__device__ __forceinline__ unsigned cvt_pk_bf16(float lo, float hi) { unsigned r; asm volatile("v_cvt_pk_bf16_f32 %0, %1, %2" : "=v"(r) : "v"(lo), "v"(hi)); return r; }
typedef float f32x2 __attribute__((ext_vector_type(2)));
template <class Epi, class Sched, bool ALIGN_EPI = false, bool SP2 = false>
__device__ __forceinline__ void gemm_phase(PG8_LAS unsigned char* lds, const Gemm g, const Sched& S, const Epi& E) {
    int tid_ = threadIdx.x; asm volatile("" : "+v"(tid_)); const int tid = tid_, wid = __builtin_amdgcn_readfirstlane(tid >> 6), lane = tid & 63, wr = wid >> 2, wc = wid & 3, fr = lane & 15, fq = lane >> 4;
    const int K = g.K, nt = K / BK;
    unsigned voffA[2], voffB[2];
#pragma unroll
    for (int i = 0; i < 2; ++i) { int R, C; stage_rc(tid * 16 + i * 8192, R, C); const int Rb = Epi::PERM ? ((R & ~31) + perm32(R & 31)) : R;
        voffA[i] = (unsigned)(R * g.lda + C) * 2u; voffB[i] = (unsigned)(Rb * K + C) * 2u; }
    const size_t kstep = (size_t)(BK * 2);
    const size_t hstepB = (size_t)HALF * K * 2, hstepA = (size_t)HALF * g.lda * 2;
    const size_t tstepB = 2 * hstepB, tstepA = 2 * hstepA;
    const unsigned ldsw = (unsigned)wid * 1024u;
    const int aoff = lds_byte(wr * 64 + fr, fq * 8), boff = lds_byte(wc * 32 + fr, fq * 8);
#define PG8_SA(b, h) (((b) * 2 + (h)) * HTB)
#define PG8_SB(b, h) ((4 + (b) * 2 + (h)) * HTB)
#define PG8_STAGE(bufoff, gbase, voff) do { _Pragma("unroll") for (int _i = 0; _i < 2; ++_i) \
        __builtin_amdgcn_global_load_lds((const unsigned*)((const char*)(gbase) + (voff)[_i]), (PG8_LAS unsigned*)(lds + (bufoff) + ldsw + _i * 8192), 16, 0, 0); } while (0)
#define PG8_LDA(dst, b, h) do { _Pragma("unroll") for (int m = 0; m < 4; ++m) _Pragma("unroll") for (int k = 0; k < 2; ++k) dst[m][k] = *(const PG8_LAS bf16x8*)(lds + PG8_SA(b, h) + aoff + m * 2048 + k * 1024); } while (0)
#define PG8_LDB(dst, b, h) do { _Pragma("unroll") for (int n = 0; n < 2; ++n) _Pragma("unroll") for (int k = 0; k < 2; ++k) dst[n][k] = *(const PG8_LAS bf16x8*)(lds + PG8_SB(b, h) + boff + n * 2048 + k * 1024); } while (0)
#define PG8_MMA(ai, bj, At, Bt) do { __builtin_amdgcn_s_setprio(1); _Pragma("unroll") for (int m = 0; m < 4; ++m) _Pragma("unroll") for (int n = 0; n < 2; ++n) _Pragma("unroll") for (int k = 0; k < 2; ++k) \
        acc[ai][bj][m][n] = __builtin_amdgcn_mfma_f32_16x16x32_bf16(Bt[n][k], At[m][k], acc[ai][bj][m][n], 0, 0, 0); __builtin_amdgcn_s_setprio(0); } while (0)
#define PG8_WAIT_V(n) asm volatile("s_waitcnt vmcnt(" #n ")" ::: "memory")
#define PG8_WAIT_L(n) asm volatile("s_waitcnt lgkmcnt(" #n ")" ::: "memory")
#define PG8_BAR __builtin_amdgcn_s_barrier()
#define PG8_SCHED __builtin_amdgcn_sched_barrier(0)
    Unit cur, nxt; int ui = 0;
    if (!S.next(0, cur)) return;
    f32x4 acc[2][2][4][2];
#pragma unroll
    for (int a = 0; a < 2; ++a)
#pragma unroll
        for (int b = 0; b < 2; ++b)
#pragma unroll
            for (int m = 0; m < 4; ++m)
#pragma unroll
                for (int n = 0; n < 2; ++n) acc[a][b][m][n] = (f32x4){0.f, 0.f, 0.f, 0.f};
    bf16x8 At[4][2], B0[2][2], B1[2][2];
    const char* cA = (const char*)g.A + (size_t)cur.pm * tstepA; const char* cB = (const char*)g.Bt + (size_t)cur.pn * tstepB;
    S.a_ready(cur);
    if constexpr (SP2) {
        PG8_STAGE(PG8_SB(0, 0), cB, voffB); PG8_STAGE(PG8_SB(0, 1), cB + hstepB, voffB); PG8_STAGE(PG8_SA(0, 0), cA, voffA); PG8_STAGE(PG8_SA(0, 1), cA + hstepA, voffA);
        if (wr == 1) PG8_BAR;
        PG8_WAIT_V(2); PG8_BAR;
        PG8_STAGE(PG8_SB(1, 0), cB + kstep, voffB); PG8_STAGE(PG8_SA(1, 0), cA + kstep, voffA); PG8_STAGE(PG8_SB(1, 1), cB + hstepB + kstep, voffB);
        PG8_WAIT_V(6); PG8_BAR;
    } else {
        PG8_STAGE(PG8_SB(0, 0), cB, voffB); PG8_STAGE(PG8_SA(0, 0), cA, voffA); PG8_STAGE(PG8_SB(0, 1), cB + hstepB, voffB); PG8_STAGE(PG8_SA(0, 1), cA + hstepA, voffA);
        if (wr == 1) PG8_BAR;
        PG8_WAIT_V(4); PG8_BAR;
        PG8_STAGE(PG8_SB(1, 0), cB + kstep, voffB); PG8_STAGE(PG8_SA(1, 0), cA + kstep, voffA); PG8_STAGE(PG8_SB(1, 1), cB + hstepB + kstep, voffB);
        PG8_WAIT_V(6); PG8_BAR;
    }
    for (;;) {
        const bool has_next = S.next(ui + 1, nxt);
        const char* nA = has_next ? (const char*)g.A + (size_t)nxt.pm * tstepA : cA; const char* nB = has_next ? (const char*)g.Bt + (size_t)nxt.pn * tstepB : cB;
        for (int t = 0; t < nt; t += 2) {
            const bool last = (t == nt - 2);
            const char* a1 = cA + (size_t)(t + 1) * kstep;
            const char* a2 = last ? nA : cA + (size_t)(t + 2) * kstep; const char* b2 = last ? nB : cB + (size_t)(t + 2) * kstep;
            const char* a3 = a2 + kstep; const char* b3 = b2 + kstep;
            if (last && has_next) S.a_ready(nxt);
            if constexpr (SP2) {
            PG8_LDB(B0, 0, 0); PG8_LDB(B1, 0, 1); PG8_SCHED; PG8_LDA(At, 0, 0); PG8_STAGE(PG8_SA(1, 1), a1 + hstepA, voffA);
            PG8_WAIT_V(8); PG8_WAIT_L(0); PG8_BAR; PG8_MMA(0, 0, At, B0); PG8_MMA(0, 1, At, B1); PG8_BAR; PG8_SCHED;
            PG8_LDA(At, 0, 1); PG8_STAGE(PG8_SB(0, 0), b2, voffB); PG8_STAGE(PG8_SB(0, 1), b2 + hstepB, voffB); PG8_STAGE(PG8_SA(0, 0), a2, voffA);
            PG8_WAIT_V(8); PG8_WAIT_L(0); PG8_BAR; PG8_MMA(1, 0, At, B0); PG8_MMA(1, 1, At, B1); PG8_BAR; PG8_SCHED;
            PG8_LDB(B0, 1, 0); PG8_LDB(B1, 1, 1); PG8_SCHED; PG8_LDA(At, 1, 0); PG8_STAGE(PG8_SA(0, 1), a2 + hstepA, voffA);
            PG8_WAIT_V(8); PG8_WAIT_L(0); PG8_BAR; PG8_MMA(0, 0, At, B0); PG8_MMA(0, 1, At, B1); PG8_BAR; PG8_SCHED;
            PG8_LDA(At, 1, 1); PG8_STAGE(PG8_SB(1, 0), b3, voffB); PG8_STAGE(PG8_SB(1, 1), b3 + hstepB, voffB); PG8_STAGE(PG8_SA(1, 0), a3, voffA);
            PG8_WAIT_V(8); PG8_WAIT_L(0); PG8_BAR; PG8_MMA(1, 0, At, B0); PG8_MMA(1, 1, At, B1); PG8_BAR; PG8_SCHED;
            } else {
            PG8_LDB(B0, 0, 0); PG8_SCHED; PG8_LDA(At, 0, 0); PG8_STAGE(PG8_SA(1, 1), a1 + hstepA, voffA);
            PG8_WAIT_L(8); PG8_BAR; PG8_WAIT_L(0); PG8_MMA(0, 0, At, B0); PG8_BAR; PG8_SCHED;
            PG8_LDB(B1, 0, 1); PG8_STAGE(PG8_SB(0, 0), b2, voffB);
            PG8_BAR; PG8_WAIT_L(0); PG8_MMA(0, 1, At, B1); PG8_BAR;
            PG8_LDA(At, 0, 1); PG8_STAGE(PG8_SA(0, 0), a2, voffA);
            PG8_BAR; PG8_WAIT_L(0); PG8_MMA(1, 0, At, B0); PG8_BAR; PG8_SCHED;
            PG8_STAGE(PG8_SB(0, 1), b2 + hstepB, voffB);
            PG8_WAIT_V(6); PG8_BAR; PG8_MMA(1, 1, At, B1); PG8_BAR;
            PG8_LDB(B0, 1, 0); PG8_SCHED; PG8_LDA(At, 1, 0); PG8_STAGE(PG8_SA(0, 1), a2 + hstepA, voffA);
            PG8_WAIT_L(8); PG8_BAR; PG8_WAIT_L(0); PG8_MMA(0, 0, At, B0); PG8_BAR; PG8_SCHED;
            PG8_LDB(B1, 1, 1); PG8_STAGE(PG8_SB(1, 0), b3, voffB);
            PG8_BAR; PG8_WAIT_L(0); PG8_MMA(0, 1, At, B1); PG8_BAR;
            PG8_LDA(At, 1, 1); PG8_STAGE(PG8_SA(1, 0), a3, voffA);
            PG8_BAR; PG8_WAIT_L(0); PG8_MMA(1, 0, At, B0); PG8_BAR; PG8_SCHED;
            PG8_STAGE(PG8_SB(1, 1), b3 + hstepB, voffB);
            PG8_WAIT_V(6); PG8_BAR; PG8_MMA(1, 1, At, B1); PG8_BAR;
            }
        }
        if constexpr (ALIGN_EPI) { if (wr == 0) PG8_BAR; }
        if constexpr (!Epi::AFTER_DRAIN) { E(acc, cur, wr, wc, fr, fq); S.done(cur); }
        if (!has_next) break;
#pragma unroll
        for (int a = 0; a < 2; ++a)
#pragma unroll
            for (int b = 0; b < 2; ++b)
#pragma unroll
                for (int m = 0; m < 4; ++m)
#pragma unroll
                    for (int n = 0; n < 2; ++n) acc[a][b][m][n] = (f32x4){0.f, 0.f, 0.f, 0.f};
        cur = nxt; cA = nA; cB = nB; ++ui;
        if constexpr (ALIGN_EPI) { if (wr == 1) PG8_BAR; }
    }
    PG8_WAIT_V(0);
    if constexpr (!ALIGN_EPI) { if (wr == 0) PG8_BAR; }
    PG8_BAR;
    if constexpr (Epi::AFTER_DRAIN) { E.fused(acc, cur, wr, wc, fr, fq, lds, wid, lane); S.done(cur); }
#undef PG8_SA
#undef PG8_SB
#undef PG8_STAGE
#undef PG8_LDA
#undef PG8_LDB
#undef PG8_MMA
#undef PG8_WAIT_V
#undef PG8_WAIT_L
#undef PG8_BAR
#undef PG8_SCHED
}
}

typedef unsigned short bf16_t;
typedef short bf16x8 __attribute__((ext_vector_type(8)));
typedef short s16x4 __attribute__((ext_vector_type(4)));
typedef float f32x4 __attribute__((ext_vector_type(4)));
typedef float f32x16 __attribute__((ext_vector_type(16)));
typedef unsigned u32x4 __attribute__((ext_vector_type(4)));
typedef unsigned u32x2 __attribute__((ext_vector_type(2)));
typedef float f32x2_t __attribute__((ext_vector_type(2)));
typedef __bf16 bf16x2_t __attribute__((ext_vector_type(2)));
#define DI __device__ __forceinline__
template <class T> DI T* opq2(T* q) { asm volatile("" : "+s"(q)); return q; }
DI int ltid() { int t = threadIdx.x; asm volatile("" : "+v"(t)); return t; }

constexpr int NB = 8, SEQL = 4096, CTXL = 256, DM = 1024, NLAYER = 4;
constexpr int ML = NB * SEQL, MC = NB * CTXL, MT = ML + MC;
constexpr int POSN = SEQL + CTXL;
constexpr int INW = 2752, INWP = 2816, FFH = 2816;
constexpr float EPS = 1e-6f;
constexpr float LOG2E = 1.4426950408889634f;

constexpr size_t OFF_CTL = 0;
constexpr size_t OFF_MODS = 4096;
constexpr size_t OFF_ROPE = OFF_MODS + 884736;
constexpr size_t OFF_STQ = OFF_ROPE + 524288;
constexpr size_t OFF_STKV = OFF_STQ + 1114112;
constexpr size_t OFF_XCTX = OFF_STKV + 557056;
constexpr size_t OFF_W = OFF_XCTX + 8388608;
constexpr size_t W_IN = 0, W_OUT = 5767168, W_F1 = 7864320, W_F2 = 19398656, W_UQ = 25165824, W_UKV = 25427968, W_TOTAL = 25559040;
constexpr size_t OFF_HC = OFF_W + W_TOTAL;
constexpr size_t OFF_PA = OFF_HC + 71303168;
constexpr size_t OFF_Y = OFF_PA + 196083712;
constexpr size_t OFF_MLAQ = OFF_Y + 71303168;
constexpr size_t OFF_MLAK = OFF_MLAQ + 26738688;
constexpr size_t OFF_VT = OFF_MLAK + 17825792;
constexpr size_t VT_TYPE_ELEMS = (size_t)NB * 4 * 64 * POSN;
constexpr size_t WS_END = OFF_VT + 4 * VT_TYPE_ELEMS * 2;
constexpr size_t OFF_BAR = WS_END, WS_END2 = WS_END + 16384;
static_assert(WS_END2 <= 536870912, "workspace map");

#ifndef USE_CG_SYNC
#define USE_CG_SYNC 0
#endif
#ifndef REP_SYNC
#define REP_SYNC 0
#endif
#ifndef REP_C
#define REP_C 1
#endif
#ifndef REP_CONV
#define REP_CONV 1
#endif
#ifndef REP_RP0
#define REP_RP0 0
#endif
#ifndef REP_MIX_ONLY
#define REP_MIX_ONLY 0
#endif
#ifndef REP_MIX
#define REP_MIX 1
#endif
#ifndef REP_GEMM
#define REP_GEMM 1
#endif
#ifndef REP_G3
#define REP_G3 REP_GEMM
#endif
#ifndef REP_G7
#define REP_G7 REP_GEMM
#endif
#ifndef REP_G9
#define REP_G9 REP_GEMM
#endif
#ifndef REP_G10
#define REP_G10 REP_GEMM
#endif
#ifndef PHMASK
#define PHMASK 0xFFFF
#endif
#define PH(k) ((PHMASK >> (k)) & 1)
constexpr int LDS_BYTES = 147456;
constexpr int LDS_CTL_OFF = 131072;

struct Params { const float* in[22]; float* out; unsigned char* ws; };
enum { I_X = 0, I_C, I_CTX, I_CCTX, I_ADAW, I_ADAB, I_NORMG, I_WIN, I_DLAM, I_DNORM, I_MQN, I_MKVN, I_WUQ, I_WUKV, I_GWG, I_GBG, I_GNORM, I_RDEC, I_RNORM, I_WOUT, I_FIN, I_FOUT };

typedef const unsigned char __attribute__((address_space(4)))* kaptr_t;
DI kaptr_t kargs() { kaptr_t ka = (kaptr_t)__builtin_amdgcn_kernarg_segment_ptr(); asm volatile("" : "+s"(ka)); return ka; }
#define KIN(k) (*(const float* const __attribute__((address_space(4)))*)(kargs() + 8 * (k)))
#define KOUT (*(float* const __attribute__((address_space(4)))*)(kargs() + 8 * 22))
#define KWS (*(unsigned char* const __attribute__((address_space(4)))*)(kargs() + 8 * 23))
DI unsigned pk2(float lo, float hi) { f32x2_t v = {lo, hi}; bf16x2_t b = __builtin_convertvector(v, bf16x2_t); return __builtin_bit_cast(unsigned, b); }
DI unsigned f2bf(float f) { return pk2(f, f) & 0xffffu; }
DI float bflo(unsigned w) { return __uint_as_float(w << 16); }
DI float bfhi(unsigned w) { return __uint_as_float(w & 0xffff0000u); }
DI int crow(int i, int h) { return (i & 3) + 8 * (i >> 2) + 4 * h; }
DI float wave_sum(float v) {
#pragma unroll
    for (int o = 1; o < 64; o <<= 1) v += __shfl_xor(v, o);
    return v;
}
DI float silu_f(float x) { return x / (1.f + __expf(-x)); }
DI float logsig_f(float x) { return fminf(x, 0.f) - __logf(1.f + __expf(-fabsf(x))); }
#define LBAR() asm volatile("s_waitcnt lgkmcnt(0)\n\ts_barrier" ::: "memory")
#define MFMA32(a, b, c) __builtin_amdgcn_mfma_f32_32x32x16_bf16((a), (b), (c), 0, 0, 0)

DI void row_bpos(int row, int& b, int& pos) { if (row < ML) { b = row >> 12; pos = CTXL + (row & 4095); } else { const int r = row - ML; b = r >> 8; pos = r & 255; } }
DI int pos_row(int b, int pos) { return pos < CTXL ? ML + b * CTXL + pos : b * SEQL + pos - CTXL; }

namespace pg8 {
struct EpiY {
    static constexpr bool PERM = true, AFTER_DRAIN = false;
    bf16_t* O; int ldc;
    __device__ __forceinline__ void operator()(const f32x4 (&acc)[2][2][4][2], const Unit& u, int wr, int wc, int fr, int fq) const {
        const int row0 = u.pm * BM + wr * 64 + fr, col0 = u.pn * BM + wc * 32 + 8 * fq;
#pragma unroll
        for (int ai = 0; ai < 2; ++ai)
#pragma unroll
            for (int m = 0; m < 4; ++m) { bf16_t* rowp = O + (size_t)(row0 + ai * HALF + m * 16) * ldc + col0;
#pragma unroll
                for (int bj = 0; bj < 2; ++bj) { const f32x4 v0 = acc[ai][bj][m][0], v1 = acc[ai][bj][m][1];
                    u32x4 w; w.x = pk2(v0[0], v0[1]); w.y = pk2(v0[2], v0[3]); w.z = pk2(v1[0], v1[1]); w.w = pk2(v1[2], v1[3]);
                    *(u32x4*)(rowp + bj * HALF) = w; } }
    }
};
struct EpiSwiglu {
    static constexpr bool PERM = true, AFTER_DRAIN = false;
    bf16_t* O;
    __device__ __forceinline__ void operator()(const f32x4 (&acc)[2][2][4][2], const Unit& u, int wr, int wc, int fr, int fq) const {
        const int row0 = u.pm * BM + wr * 64 + fr, col0 = u.pn * HALF + wc * 32 + 8 * fq;
#pragma unroll
        for (int ai = 0; ai < 2; ++ai)
#pragma unroll
            for (int m = 0; m < 4; ++m) { bf16_t* rowp = O + (size_t)(row0 + ai * HALF + m * 16) * FFH + col0;
                float r[8];
#pragma unroll
                for (int n = 0; n < 2; ++n)
#pragma unroll
                    for (int i = 0; i < 4; ++i) { const float g = acc[ai][0][m][n][i], up = acc[ai][1][m][n][i]; r[4 * n + i] = g / (1.f + __expf(-g)) * up; }
                u32x4 w; w.x = pk2(r[0], r[1]); w.y = pk2(r[2], r[3]); w.z = pk2(r[4], r[5]); w.w = pk2(r[6], r[7]);
                *(u32x4*)rowp = w; }
    }
};
DI void rope_pair(f32x4& a, f32x4& b, const float* rc, const float* rs, int row, int fq) {
    if (row < ML) { const int t = row & 4095; const f32x4 c = *(const f32x4*)(rc + t * 16 + 4 * fq), s = *(const f32x4*)(rs + t * 16 + 4 * fq);
        const f32x4 x1 = a, x2 = b; a = x1 * c - x2 * s; b = x1 * s + x2 * c; }
}
DI void store4(bf16_t* p, const f32x4& v) { u32x2 w; w.x = pk2(v[0], v[1]); w.y = pk2(v[2], v[3]); *(u32x2*)p = w; }
DI void store_vt(bf16_t* VT, int type, int hd, int e0, int row, const f32x4& v) {
    int b, pos; row_bpos(row, b, pos);
    pos = (pos & ~12) | ((pos & 4) << 1) | ((pos & 8) >> 1);
    bf16_t* q = VT + ((size_t)((type * NB + b) * 4 + hd) * 64 + e0) * POSN + pos;
#pragma unroll
    for (int i = 0; i < 4; ++i) q[(size_t)i * POSN] = (bf16_t)f2bf(v[i]);
}
DI void store_vt_tile(bf16_t* VT, int type, int hd, int e0, int row0, const f32x4& v0, const f32x4& v1, bf16_t* scr, int fr, int c0, int c1, int lane) {
    const int pr = (fr & ~12) | ((fr & 4) << 1) | ((fr & 8) >> 1);
#pragma unroll
    for (int i = 0; i < 4; ++i) { scr[(c0 + i) * 24 + pr] = (bf16_t)f2bf(v0[i]); scr[(c1 + i) * 24 + pr] = (bf16_t)f2bf(v1[i]); }
    asm volatile("s_waitcnt lgkmcnt(0)" ::: "memory");
    const int col = lane >> 1, half = lane & 1;
    const u32x4 w = *(const u32x4*)(scr + col * 24 + 8 * half);
    int b, pos; row_bpos(row0, b, pos);
    *(u32x4*)(VT + ((size_t)((type * NB + b) * 4 + hd) * 64 + e0 + col) * POSN + pos + 8 * half) = w;
    asm volatile("s_waitcnt lgkmcnt(0)" ::: "memory");
}
struct EpiProj {
    static constexpr bool PERM = true, AFTER_DRAIN = false;
    bf16_t* PROJ; bf16_t* VT; float* stq; float* stkv; const float* rc; const float* rs; unsigned char* scr;
    __device__ __forceinline__ void operator()(const f32x4 (&acc)[2][2][4][2], const Unit& u, int wr, int wc, int fr, int fq) const {
#pragma unroll
        for (int bj = 0; bj < 2; ++bj) {
            const int g = u.pn * 8 + bj * 4 + wc;
            if (g >= 86) continue;
            const int colbase = g * 32;
            int kind = 0; float scale = 1.f; int vtype = 0, vc0 = 0, slot = 0;
            if (g < 8) { kind = 1; scale = 0.17677669529663687f * LOG2E; }
            else if (g < 16) { kind = 1; }
            else if (g < 24) { kind = 2; vtype = 0; vc0 = colbase - 512; }
            else if (g < 32) { kind = 3; slot = g - 24; }
            else if (g < 36) { kind = 4; slot = g - 32; }
            else if (g == 36) { kind = 1; }
            else if (g < 41) { kind = 0; scale = 0.17677669529663687f; }
            else if (g < 45) { kind = 0; }
            else if (g < 53) { kind = 2; vtype = 2; vc0 = colbase - 1440; }
            else if (g < 62) { kind = 0; }
            else if (g < 66) { kind = 1; scale = 0.17677669529663687f; }
            else if (g < 70) { kind = 1; }
            else if (g < 78) { kind = 2; vtype = 3; vc0 = colbase - 2240; }
            else { kind = 0; }
#pragma unroll
            for (int ai = 0; ai < 2; ++ai)
#pragma unroll
                for (int m = 0; m < 4; ++m) {
                    const int row = u.pm * BM + ai * HALF + wr * 64 + m * 16 + fr;
                    f32x4 v0 = acc[ai][bj][m][0], v1 = acc[ai][bj][m][1];
                    if (kind == 1) {
                        f32x4 w0, w1;
#pragma unroll
                        for (int i = 0; i < 4; ++i) { w0[i] = __shfl_xor(v0[i], 32); w1[i] = __shfl_xor(v1[i], 32); }
                        if (row < ML) { const int t = row & 4095; const float* cb = rc + t * 16 + 8 * (fq & 1); const float* sb = rs + t * 16 + 8 * (fq & 1);
                            const f32x4 c0 = *(const f32x4*)cb, c1 = *(const f32x4*)(cb + 4), s0 = *(const f32x4*)sb, s1 = *(const f32x4*)(sb + 4);
                            if (fq < 2) { v0 = v0 * c0 - w0 * s0; v1 = v1 * c1 - w1 * s1; } else { v0 = w0 * s0 + v0 * c0; v1 = w1 * s1 + v1 * c1; } }
                    }
                    v0 = v0 * scale; v1 = v1 * scale;
                    if (kind == 2) {
                        store_vt_tile(VT, vtype, vc0 >> 6, vc0 & 63, row - fr, v0, v1, (bf16_t*)(scr + (wr * 4 + wc) * 1536), fr, 8 * fq, 8 * fq + 4, fr + 16 * fq);
                    } else {
                        { u32x4 ww; ww.x = pk2(v0[0], v0[1]); ww.y = pk2(v0[2], v0[3]); ww.z = pk2(v1[0], v1[1]); ww.w = pk2(v1[2], v1[3]);
                          *(u32x4*)(PROJ + (size_t)row * INWP + colbase + 8 * fq) = ww; }
                        if (kind >= 3) {
                            float ss = (v0[0] * v0[0] + v0[1] * v0[1]) + (v0[2] * v0[2] + v0[3] * v0[3]) + (v1[0] * v1[0] + v1[1] * v1[1]) + (v1[2] * v1[2] + v1[3] * v1[3]);
                            ss += __shfl_xor(ss, 16); ss += __shfl_xor(ss, 32);
                            if (fq == 0) { if (kind == 3) stq[(size_t)row * 8 + slot] = ss; else stkv[(size_t)row * 4 + slot] = ss; }
                        }
                    }
                }
        }
    }
};
struct EpiUpQ {
    static constexpr bool PERM = false, AFTER_DRAIN = false;
    bf16_t* MQ; const float* stq; const float* rc; const float* rs;
    __device__ __forceinline__ void operator()(const f32x4 (&acc)[2][2][4][2], const Unit& u, int wr, int wc, int fr, int fq) const {
#pragma unroll
        for (int ai = 0; ai < 2; ++ai)
#pragma unroll
            for (int m = 0; m < 4; ++m) {
                const int row = u.pm * BM + ai * HALF + wr * 64 + m * 16 + fr;
                const f32x4 s0 = *(const f32x4*)(stq + (size_t)row * 8), s1 = *(const f32x4*)(stq + (size_t)row * 8 + 4);
                const float ss = ((s0[0] + s0[1]) + (s0[2] + s0[3])) + ((s1[0] + s1[1]) + (s1[2] + s1[3]));
                const float sc = rsqrtf(ss * (1.f / 256.f) + EPS) * (0.10206207261596575f * LOG2E);
#pragma unroll
                for (int bj = 0; bj < 2; ++bj) {
                    const int g = u.pn * 8 + bj * 4 + wc;
                    if (g >= 12) continue;
                    f32x4 v0 = acc[ai][bj][m][0], v1 = acc[ai][bj][m][1];
                    if ((g % 3) == 2) rope_pair(v0, v1, rc, rs, row, fq);
                    v0 = v0 * sc; v1 = v1 * sc;
                    bf16_t* pp = MQ + (size_t)row * 384 + g * 32 + 4 * fq;
                    store4(pp, v0); store4(pp + 16, v1);
                }
                asm volatile("" ::: "memory");
            }
    }
};
struct EpiUpKV {
    static constexpr bool PERM = false, AFTER_DRAIN = false;
    bf16_t* MK; bf16_t* VT; const float* stkv; unsigned char* scr;
    __device__ __forceinline__ void operator()(const f32x4 (&acc)[2][2][4][2], const Unit& u, int wr, int wc, int fr, int fq) const {
#pragma unroll
        for (int ai = 0; ai < 2; ++ai)
#pragma unroll
            for (int m = 0; m < 4; ++m) {
                const int row = u.pm * BM + ai * HALF + wr * 64 + m * 16 + fr;
                const f32x4 s0 = *(const f32x4*)(stkv + (size_t)row * 4);
                const float sc = rsqrtf(((s0[0] + s0[1]) + (s0[2] + s0[3])) * (1.f / 128.f) + EPS);
#pragma unroll
                for (int bj = 0; bj < 2; ++bj) {
                    const int g = u.pn * 8 + bj * 4 + wc, hd = g >> 2, part = g & 3;
                    const f32x4 v0 = acc[ai][bj][m][0] * sc, v1 = acc[ai][bj][m][1] * sc;
                    if (part < 2) { bf16_t* pp = MK + (size_t)row * 256 + hd * 64 + part * 32 + 4 * fq; store4(pp, v0); store4(pp + 16, v1); }
                    else { store_vt_tile(VT, 1, hd, (part - 2) * 32, row - fr, v0, v1, (bf16_t*)(scr + (wr * 4 + wc) * 1536), fr, 4 * fq, 16 + 4 * fq, fr + 16 * fq); }
                }
                asm volatile("" ::: "memory");
            }
    }
};
}

DI void phase0(const Params& p, unsigned char* lds) {
    const int tid = ltid(); const size_t gt = (size_t)blockIdx.x * 512 + tid, gn = (size_t)gridDim.x * 512;
    if (blockIdx.x == 0) { for (int i = tid; i < 1024; i += 512) ((unsigned*)(KWS + OFF_CTL))[i] = 0u;
        for (int i = tid; i < 4096; i += 512) ((unsigned*)(KWS + OFF_BAR))[i] = 0u; }
    float* rc = (float*)(KWS + OFF_ROPE); float* rs = rc + 4096 * 16;
    for (size_t i = gt; i < 65536; i += gn) { const int t = (int)(i >> 4), jj = (int)(i & 15), k = jj & 7;
        const float freq = powf(10000.f, -(float)k * 0.125f); const float pos = jj < 8 ? (float)(t >> 6) : (float)(t & 63); const float a = pos * freq;
        rc[i] = cosf(a); rs[i] = sinf(a); }
    float* S = (float*)lds;
    float* red = S + 9216;
    for (int i = tid; i < 9216; i += 512) { const int r = i >> 10, k = i & 1023; const float c = r < 8 ? KIN(I_C)[r * 1024 + k] : KIN(I_CCTX)[k]; S[i] = c / (1.f + expf(-c)); }
    __syncthreads();
    float* MODS = (float*)(KWS + OFF_MODS);
    for (int item = blockIdx.x; item < 384; item += gridDim.x) {
        const int l = item / 96, n0 = (item % 96) * 64, kg = tid >> 6, c = tid & 63;
        const float* W = KIN(I_ADAW) + (size_t)l * 1024 * 6144 + n0 + c;
        float acc[9];
#pragma unroll
        for (int r = 0; r < 9; ++r) acc[r] = 0.f;
#pragma unroll 8
        for (int kk = 0; kk < 128; ++kk) { const int k = kg * 128 + kk; const float w = __builtin_nontemporal_load(W + (size_t)k * 6144);
#pragma unroll
            for (int r = 0; r < 9; ++r) acc[r] += S[r * 1024 + k] * w; }
#pragma unroll
        for (int r = 0; r < 9; ++r) red[(kg * 9 + r) * 64 + c] = acc[r];
        __syncthreads();
        for (int o = tid; o < 576; o += 512) { const int r = o >> 6, cc = o & 63; float s = 0.f;
#pragma unroll
            for (int k2 = 0; k2 < 8; ++k2) s += red[(k2 * 9 + r) * 64 + cc];
            MODS[(size_t)(l * 9 + r) * 6144 + n0 + cc] = s + KIN(I_ADAB)[l * 6144 + n0 + cc]; }
        __syncthreads();
    }
}

DI void tr_item(const float* W, int K, int N, bf16_t* WT, int k0, int n0, int drow0, const float* kscale, float* scr, int lane) {
#pragma unroll 8
    for (int i = 0; i < 32; ++i) { const int kk = 2 * i + (lane >> 5); float v = __builtin_nontemporal_load(W + (size_t)(k0 + kk) * N + n0 + (lane & 31)); if (kscale) v *= kscale[k0 + kk]; scr[kk * 33 + (lane & 31)] = v; }
    asm volatile("s_waitcnt lgkmcnt(0)" ::: "memory");
    const int c = lane & 7;
#pragma unroll
    for (int j = 0; j < 4; ++j) { const int n = (lane >> 3) + 8 * j; const float* s = scr + (8 * c) * 33 + n;
        u32x4 o; o.x = pk2(s[0 * 33], s[1 * 33]); o.y = pk2(s[2 * 33], s[3 * 33]); o.z = pk2(s[4 * 33], s[5 * 33]); o.w = pk2(s[6 * 33], s[7 * 33]);
        *(u32x4*)(WT + (size_t)(drow0 + n) * K + k0 + 8 * c) = o; }
    asm volatile("s_waitcnt lgkmcnt(0)" ::: "memory");
}
DI void convert_weights(const Params& p, int l, unsigned char* lds, int mask, int vblock, int vgrid) {
    asm volatile("" : "+s"(l));
    const int tid = ltid(), wave = tid >> 6, lane = tid & 63; const int gw = vblock * 8 + wave, NGW = vgrid * 8;
    float* scr = (float*)lds + wave * 2112;
    bf16_t* Wb = (bf16_t*)(KWS + OFF_W);
    bf16_t* WT_IN = Wb + W_IN / 2; bf16_t* WT_OUT = Wb + W_OUT / 2; bf16_t* WT_F1 = Wb + W_F1 / 2; bf16_t* WT_F2 = Wb + W_F2 / 2; bf16_t* WT_UQ = Wb + W_UQ / 2; bf16_t* WT_UKV = Wb + W_UKV / 2;
    for (int it = gw; it < 6192; it += NGW) {
        int r = it;
        { const bool isf2 = (it >= 4704 && it < 6112); if (!((mask >> (isf2 ? 1 : 0)) & 1)) continue; }
        if (r < 1376) { tr_item(KIN(I_WIN) + (size_t)l * 1024 * INW, 1024, INW, WT_IN, 64 * (r / 86), 32 * (r % 86), 32 * (r % 86), nullptr, scr, lane); continue; } r -= 1376;
        if (r < 512) { tr_item(KIN(I_WOUT) + (size_t)l * 1024 * 1024, 1024, 1024, WT_OUT, 64 * (r / 32), 32 * (r % 32), 32 * (r % 32), nullptr, scr, lane); continue; } r -= 512;
        if (r < 2816) { const int n0 = 32 * (r % 176); const int j = n0 < FFH ? n0 : n0 - FFH; const int drow = 256 * (j / 128) + (j % 128) + (n0 < FFH ? 0 : 128);
            tr_item(KIN(I_FIN) + (size_t)l * 1024 * 5632, 1024, 5632, WT_F1, 64 * (r / 176), n0, drow, nullptr, scr, lane); continue; } r -= 2816;
        if (r < 1408) { tr_item(KIN(I_FOUT) + (size_t)l * FFH * 1024, FFH, 1024, WT_F2, 64 * (r / 32), 32 * (r % 32), 32 * (r % 32), nullptr, scr, lane); continue; } r -= 1408;
        if (r < 48) { tr_item(KIN(I_WUQ) + (size_t)l * 256 * 384, 256, 384, WT_UQ, 64 * (r / 12), 32 * (r % 12), 32 * (r % 12), KIN(I_MQN) + l * 256, scr, lane); continue; } r -= 48;
        tr_item(KIN(I_WUKV) + (size_t)l * 128 * 512, 128, 512, WT_UKV, 64 * (r / 16), 32 * (r % 16), 32 * (r % 16), KIN(I_MKVN) + l * 128, scr, lane);
    }
    if (!(mask & 1)) return;
    const size_t gt = (size_t)vblock * 512 + tid, gn = (size_t)vgrid * 512; unsigned zz = 0u; asm volatile("" : "+v"(zz)); const u32x4 z = {zz, zz, zz, zz};
    for (size_t i = gt; i < 8192; i += gn) ((u32x4*)(WT_IN + (size_t)INW * 1024))[i] = z;
    for (size_t i = gt; i < 4096; i += gn) ((u32x4*)(WT_UQ + (size_t)384 * 256))[i] = z;
}

DI void rowpass(int row_begin, int row_end, int vblock, int vgrid, const float* xinL, const float* xinC, float* xoutL, float* xoutC, const bf16_t* Y, const float* mgate, const float* gpost,
                bf16_t* H, const float* gpre, const float* mshift, const float* mscale) {
    const int tid = ltid(), wave = tid >> 6, lane = tid & 63; const int gw = vblock * 8 + wave, NGW = vgrid * 8;
    f32x4 vn[4]; u32x2 yn[4];
    auto fetch = [&](int row) {
        const float* xr = row < ML ? xinL + (size_t)row * DM : xinC + (size_t)(row - ML) * DM;
#pragma unroll
        for (int j = 0; j < 4; ++j) vn[j] = __builtin_nontemporal_load((const f32x4*)(xr + 4 * lane + 256 * j));
        if (Y) {
#pragma unroll
            for (int j = 0; j < 4; ++j) yn[j] = __builtin_nontemporal_load((const u32x2*)(Y + (size_t)row * DM + 4 * lane + 256 * j)); }
    };
    f32x4 gpo[4], gpr[4], gat[4], shf[4], scl[4];
#pragma unroll
    for (int j = 0; j < 4; ++j) { gpo[j] = Y ? *(const f32x4*)(gpost + 4 * lane + 256 * j) : (f32x4){0.f, 0.f, 0.f, 0.f}; gpr[j] = H ? *(const f32x4*)(gpre + 4 * lane + 256 * j) : (f32x4){0.f, 0.f, 0.f, 0.f};
        gat[j] = gpo[j]; shf[j] = gpo[j]; scl[j] = gpo[j]; }
    int mb_cur = -1;
    int row = row_begin + gw;
    if (row < row_end) fetch(row);
    for (; row < row_end; row += NGW) {
        const int mb = row < ML ? (row >> 12) : 8;
        f32x4 v[4]; u32x2 yw[4];
#pragma unroll
        for (int j = 0; j < 4; ++j) { v[j] = vn[j]; yw[j] = yn[j]; }
        if (row + NGW < row_end) fetch(row + NGW);
        if (mb != mb_cur) {
            mb_cur = mb;
#pragma unroll
            for (int j = 0; j < 4; ++j) { const int c = 4 * lane + 256 * j;
                if (Y) gat[j] = *(const f32x4*)(mgate + (size_t)mb * 6144 + c);
                if (H) { shf[j] = *(const f32x4*)(mshift + (size_t)mb * 6144 + c); scl[j] = *(const f32x4*)(mscale + (size_t)mb * 6144 + c) + 1.f; } }
        }
        if (Y) {
            f32x4 y[4]; float ss = 0.f;
#pragma unroll
            for (int j = 0; j < 4; ++j) { const u32x2 w = yw[j]; y[j] = (f32x4){bflo(w.x), bfhi(w.x), bflo(w.y), bfhi(w.y)};
                ss += (y[j][0] * y[j][0] + y[j][1] * y[j][1]) + (y[j][2] * y[j][2] + y[j][3] * y[j][3]); }
            const float ry = rsqrtf(wave_sum(ss) * (1.f / DM) + EPS);
            float* xo = row < ML ? xoutL + (size_t)row * DM : xoutC + (size_t)(row - ML) * DM;
#pragma unroll
            for (int j = 0; j < 4; ++j) { v[j] = v[j] + gat[j] * (y[j] * ry * gpo[j]); __builtin_nontemporal_store(v[j], (f32x4*)(xo + 4 * lane + 256 * j)); }
        }
        if (H) {
            float ss = 0.f;
#pragma unroll
            for (int j = 0; j < 4; ++j) ss += (v[j][0] * v[j][0] + v[j][1] * v[j][1]) + (v[j][2] * v[j][2] + v[j][3] * v[j][3]);
            const float rx = rsqrtf(wave_sum(ss) * (1.f / DM) + EPS);
#pragma unroll
            for (int j = 0; j < 4; ++j) { const int c = 4 * lane + 256 * j;
                const f32x4 hv = v[j] * rx * gpr[j] * scl[j] + shf[j]; u32x2 w; w.x = pk2(hv[0], hv[1]); w.y = pk2(hv[2], hv[3]); *(u32x2*)(H + (size_t)row * DM + c) = w; }
        }
    }
}

template <int TYPE>
DI void attn_unit(const Params& p, unsigned char* lds, int l, int b, int hd, int qrow0, int NT) {
    asm volatile("" : "+s"(l), "+s"(b), "+s"(hd), "+s"(qrow0), "+s"(NT));
    constexpr int NMAP = TYPE == 0 ? 2 : 1, KS = TYPE == 0 ? 2 : 6, DQ = NMAP * KS * 16, KP = DQ + 8, CPR = DQ / 8;
    constexpr int TK = TYPE == 0 ? 64 : 128, VP = TK + 8, KCH = TK * CPR / 512, VCPR = TK / 8, VCH = 64 * VCPR / 512;
    const int tid = ltid(), lane = tid & 63, w = tid >> 6, r32 = lane & 31, h = lane >> 5;
    bf16_t* Kl = (bf16_t*)lds;
    bf16_t* Vl = (bf16_t*)(lds + 2 * TK * KP * 2);
    const bf16_t* PROJ = (const bf16_t*)(KWS + OFF_PA);
    const bf16_t* MQ = (const bf16_t*)(KWS + OFF_MLAQ);
    const bf16_t* MK = (const bf16_t*)(KWS + OFF_MLAK);
    const bf16_t* VTb = (const bf16_t*)(KWS + OFF_VT) + ((size_t)((TYPE * NB + b) * 4 + hd) * 64) * POSN;
    bf16_t* CC = (bf16_t*)(KWS + OFF_HC);
    bf16x8 qf[NMAP][KS];
    const int qrow = qrow0 + 32 * w + r32;
#pragma unroll
    for (int mp = 0; mp < NMAP; ++mp)
#pragma unroll
        for (int s = 0; s < KS; ++s)
            qf[mp][s] = TYPE == 0 ? *(const bf16x8*)(PROJ + (size_t)qrow * INWP + 64 * hd + mp * 32 + 16 * s + 8 * h)
                                  : *(const bf16x8*)(MQ + (size_t)qrow * 384 + 96 * hd + 16 * s + 8 * h);
    float mrun[NMAP], lsum[NMAP]; f32x16 o[NMAP][2];
#pragma unroll
    for (int mp = 0; mp < NMAP; ++mp) { mrun[mp] = 0.f; lsum[mp] = 0.f;
#pragma unroll
        for (int i = 0; i < 16; ++i) { o[mp][0][i] = 0.f; o[mp][1][i] = 0.f; } }
    u32x4 kreg[KCH], vreg[VCH];
    auto gload = [&](int t) {
#pragma unroll
        for (int i = 0; i < KCH; ++i) { const int c = tid + 512 * i, kr = c / CPR, cc = c % CPR; const int grow = pos_row(b, TK * t + kr);
            if (TYPE == 0) kreg[i] = *(const u32x4*)(PROJ + (size_t)grow * INWP + 256 + 64 * hd + 8 * cc);
            else kreg[i] = cc < 8 ? *(const u32x4*)(MK + (size_t)grow * 256 + 64 * hd + 8 * cc) : *(const u32x4*)(PROJ + (size_t)grow * INWP + 1152 + 8 * (cc - 8)); }
#pragma unroll
        for (int i = 0; i < VCH; ++i) { const int c = tid + 512 * i, e = c / VCPR, jc = c % VCPR; vreg[i] = *(const u32x4*)(VTb + (size_t)e * POSN + TK * t + 8 * jc); }
    };
    auto lstore = [&](int buf) {
#pragma unroll
        for (int i = 0; i < KCH; ++i) { const int c = tid + 512 * i, kr = c / CPR, cc = c % CPR; *(u32x4*)(Kl + (size_t)buf * TK * KP + kr * KP + 8 * cc) = kreg[i]; }
#pragma unroll
        for (int i = 0; i < VCH; ++i) { const int c = tid + 512 * i, e = c / VCPR, jc = c % VCPR; *(u32x4*)(Vl + (size_t)buf * 64 * VP + e * VP + 8 * jc) = vreg[i]; }
    };
    const int NTI = NT * 64 / TK;
    gload(0); lstore(0); __syncthreads();
    bool shifted = false;
    for (int t = 0; t < NTI; ++t) {
        const int buf = t & 1;
        if (t + 1 < NTI) gload(t + 1);
        const bf16_t* Kb = Kl + (size_t)buf * TK * KP; const bf16_t* Vb = Vl + (size_t)buf * 64 * VP;
        bf16x8 pbd[2][4];
        f32x16 a0, a1, b0, b1;
        auto kfrag = [&](int st, int half, int s) { return TYPE == 0 ? *(const bf16x8*)(Kb + (32 * half + r32) * KP + st * 32 + 16 * s + 8 * h)
                                                                       : *(const bf16x8*)(Kb + (64 * st + 32 * half + r32) * KP + 16 * s + 8 * h); };
        auto vfrag = [&](int st, int eb, int s) { return *(const bf16x8*)(Vb + (32 * eb + r32) * VP + (TYPE == 0 ? 0 : 64 * st) + 16 * s + 8 * h); };
        auto sub_ref = [&](f32x16& x0, f32x16& x1, int mi) {
            if (__builtin_expect(shifted, 0)) { asm volatile("" ::: "memory");
#pragma unroll
                for (int i = 0; i < 16; ++i) { x0[i] -= mrun[mi]; x1[i] -= mrun[mi]; } } };
        auto pack8 = [&](const f32x16& x, int base) { u32x4 tt; tt.x = pk2(x[base], x[base + 1]); tt.y = pk2(x[base + 2], x[base + 3]); tt.z = pk2(x[base + 4], x[base + 5]); tt.w = pk2(x[base + 6], x[base + 7]); return __builtin_bit_cast(bf16x8, tt); };
        auto slow = [&](int st, f32x16& x0, f32x16& x1, float& ps) {
            const int mi = TYPE == 0 ? st : 0;
#pragma unroll
            for (int i = 0; i < 16; ++i) { x0[i] = 0.f; x1[i] = 0.f; }
#pragma unroll
            for (int s2 = 0; s2 < KS; ++s2) { x0 = MFMA32(kfrag(st, 0, s2), qf[mi][s2], x0); x1 = MFMA32(kfrag(st, 1, s2), qf[mi][s2], x1); }
            sub_ref(x0, x1, mi);
            float tm = fmaxf(x0[0], x1[0]);
#pragma unroll
            for (int i = 1; i < 16; ++i) tm = fmaxf(tm, fmaxf(x0[i], x1[i]));
            tm = fmaxf(tm, __shfl_xor(tm, 32));
            const bool first = (t == 0) && (TYPE == 0 || st == 0);
            const float dl = first ? tm : fmaxf(tm, 0.f);
            mrun[mi] += dl;
            if (!first) { const float alpha = __builtin_amdgcn_exp2f(-dl); lsum[mi] *= alpha;
#pragma unroll
                for (int i = 0; i < 16; ++i) { o[mi][0][i] *= alpha; o[mi][1][i] *= alpha; } }
            ps = 0.f;
#pragma unroll
            for (int i = 0; i < 16; ++i) { x0[i] = __builtin_amdgcn_exp2f(x0[i] - dl); x1[i] = __builtin_amdgcn_exp2f(x1[i] - dl); ps += x0[i] + x1[i]; }
            shifted = true;
        };
        constexpr int M0 = 0, M1 = TYPE == 0 ? 1 : 0;
#pragma unroll
        for (int i = 0; i < 16; ++i) { a0[i] = 0.f; a1[i] = 0.f; b0[i] = 0.f; b1[i] = 0.f; }
#pragma unroll
        for (int s2 = 0; s2 < KS; ++s2) { a0 = MFMA32(kfrag(0, 0, s2), qf[M0][s2], a0); a1 = MFMA32(kfrag(0, 1, s2), qf[M0][s2], a1); }
        sub_ref(a0, a1, M0);
        float psa = 0.f;
#pragma unroll
        for (int n = 0; n < 2 * KS; ++n) {
            if (n & 1) b1 = MFMA32(kfrag(1, 1, n >> 1), qf[M1][n >> 1], b1); else b0 = MFMA32(kfrag(1, 0, n >> 1), qf[M1][n >> 1], b0);
#pragma unroll
            for (int r = (32 * n) / (2 * KS); r < (32 * (n + 1)) / (2 * KS); ++r) {
                if (r < 16) { a0[r] = __builtin_amdgcn_exp2f(a0[r]); psa += a0[r]; } else { a1[r - 16] = __builtin_amdgcn_exp2f(a1[r - 16]); psa += a1[r - 16]; } }
        }
        {   const bool firstA = (t == 0);
            if (__builtin_expect(__any(!(psa <= 1e13f) || (firstA && psa < 1e-13f)), 0)) slow(0, a0, a1, psa); }
        lsum[M0] += psa;
        pbd[0][0] = pack8(a0, 0); pbd[0][1] = pack8(a0, 8); pbd[0][2] = pack8(a1, 0); pbd[0][3] = pack8(a1, 8);
        sub_ref(b0, b1, M1);
        float psb = 0.f;
#pragma unroll
        for (int eb = 0; eb < 2; ++eb)
#pragma unroll
            for (int s2 = 0; s2 < 4; ++s2) {
                o[M0][eb] = MFMA32(vfrag(0, eb, s2), pbd[0][s2], o[M0][eb]);
                const int q4 = (eb * 4 + s2) * 4;
#pragma unroll
                for (int i = 0; i < 4; ++i) { const int r = q4 + i; if (r < 16) { b0[r] = __builtin_amdgcn_exp2f(b0[r]); psb += b0[r]; } else { b1[r - 16] = __builtin_amdgcn_exp2f(b1[r - 16]); psb += b1[r - 16]; } }
            }
        {   const bool firstB = (t == 0) && TYPE == 0;
            if (__builtin_expect(__any(!(psb <= 1e13f) || (firstB && psb < 1e-13f)), 0)) slow(1, b0, b1, psb); }
        lsum[M1] += psb;
        pbd[1][0] = pack8(b0, 0); pbd[1][1] = pack8(b0, 8); pbd[1][2] = pack8(b1, 0); pbd[1][3] = pack8(b1, 8);
#pragma unroll
        for (int eb = 0; eb < 2; ++eb)
#pragma unroll
            for (int s2 = 0; s2 < 4; ++s2) o[M1][eb] = MFMA32(vfrag(1, eb, s2), pbd[1][s2], o[M1][eb]);
        if (t + 1 < NTI) lstore(buf ^ 1);
        __syncthreads();
    }
    float inv[NMAP];
#pragma unroll
    for (int mp = 0; mp < NMAP; ++mp) { const float lt = lsum[mp] + __shfl_xor(lsum[mp], 32); inv[mp] = 1.f / lt; }
    if (TYPE == 1) {
        bf16_t* op = CC + (size_t)qrow * DM + 256 + 64 * hd;
#pragma unroll
        for (int eb = 0; eb < 2; ++eb)
#pragma unroll
            for (int g = 0; g < 4; ++g) { const f32x4 v = {o[0][eb][4 * g] * inv[0], o[0][eb][4 * g + 1] * inv[0], o[0][eb][4 * g + 2] * inv[0], o[0][eb][4 * g + 3] * inv[0]};
                pg8::store4(op + 32 * eb + 8 * g + 4 * h, v); }
    } else {
        int l2 = l; asm volatile("" : "+s"(l2));
        const float* dl = opq2(KIN(I_DLAM)) + l2 * 128; float d1 = 0.f, d2 = 0.f;
        for (int i = 0; i < 32; ++i) { d1 += dl[i] * dl[32 + i]; d2 += dl[64 + i] * dl[96 + i]; }
        float c08 = 0.8f, c06 = 0.6f; asm volatile("" : "+v"(c08), "+v"(c06));
        const float lam_init = c08 - c06 * __expf(-0.3f * (float)l2);
        const float lam = __expf(d1) - __expf(d2) + lam_init;
        const float* sg = opq2(KIN(I_DNORM)) + l2 * 64;
        float ss = 0.f; const float li1 = lam * inv[NMAP - 1];
#pragma unroll
        for (int eb = 0; eb < 2; ++eb)
#pragma unroll
            for (int i = 0; i < 16; ++i) { const float v = o[0][eb][i] * inv[0] - li1 * o[NMAP - 1][eb][i]; o[0][eb][i] = v; ss += v * v; }
        ss += __shfl_xor(ss, 32);
        const float rn = rsqrtf(ss * (1.f / 64.f) + EPS) * (1.f - lam_init);
        bf16_t* op = CC + (size_t)qrow * DM + 64 * hd;
#pragma unroll
        for (int eb = 0; eb < 2; ++eb)
#pragma unroll
            for (int g = 0; g < 4; ++g) { const int e0 = 32 * eb + 8 * g + 4 * h; const f32x4 gg = *(const f32x4*)(sg + e0);
                const f32x4 v = {o[0][eb][4 * g] * rn * gg[0], o[0][eb][4 * g + 1] * rn * gg[1], o[0][eb][4 * g + 2] * rn * gg[2], o[0][eb][4 * g + 3] * rn * gg[3]};
                pg8::store4(op + e0, v); }
    }
}

DI void scan_unit(const Params& p, unsigned char* lds, int l, int mixer, int b, int hd, int item) {
    asm volatile("" : "+s"(l), "+s"(mixer), "+s"(b), "+s"(hd), "+s"(item));
    const int tid = ltid(), dir = tid >> 8, td = tid & 255, lane = tid & 63, wd = (tid >> 6) & 3, r32 = lane & 31, h = lane >> 5;
    unsigned char* L = lds + dir * 55296;
    bf16_t* QT = (bf16_t*)(L);
    bf16_t* KT = (bf16_t*)(L + 5120);
    bf16_t* KH = (bf16_t*)(L + 10240);
    bf16_t* ST = (bf16_t*)(L + 14848);
    bf16_t* VTt = (bf16_t*)(L + 19968);
    bf16_t* SC = (bf16_t*)(L + 29184);
    float* OL = (float*)(L + 19968);
    float* BB = (float*)(L + 38400);
    float* SEG = (float*)(L + 46592);
    float* BEND = (float*)(L + 47616);
    float* WG = (float*)(L + 47744);
    float* GT = (float*)(L + 49920);
    const bf16_t* PROJ = (const bf16_t*)(KWS + OFF_PA);
    bf16_t* CC = (bf16_t*)(KWS + OFF_HC);
    float* OTMP = (float*)(KWS + OFF_Y) + (size_t)item * 68 * 4096;
    const int qcol = (mixer == 0 ? 1184 : 1984) + 32 * hd, kcol = (mixer == 0 ? 1312 : 2112) + 32 * hd, ogcol = (mixer == 0 ? 1696 : 2496) + 64 * hd;
    const int ccol = 512 + 256 * mixer + 64 * hd;
    const bf16_t* VTb = (const bf16_t*)(KWS + OFF_VT) + ((size_t)(((mixer == 0 ? 2 : 3) * NB + b) * 4 + hd) * 64) * POSN;
    const float* og = (mixer == 0 ? KIN(I_GNORM) : KIN(I_RNORM)) + l * 64;
    float lg = 0.f;
    float ogr[16];
#pragma unroll
    for (int i = 0; i < 16; ++i) ogr[i] = og[16 * (td & 3) + i];
    float wg[16], wb = 0.f;
#pragma unroll
    for (int r = 0; r < 16; ++r) wg[r] = 0.f;
    if (mixer == 0) {
        const float* gw = KIN(I_GWG) + (size_t)((l * 2 + dir) * 16) * 128 + 32 * hd + (td & 31);
#pragma unroll
        for (int r = 0; r < 16; ++r) wg[r] = gw[r * 128];
        wb = KIN(I_GBG)[(l * 2 + dir) * 128 + 32 * hd + (td & 31)];
    } else lg = logsig_f(KIN(I_RDEC)[(l * 2 + dir) * 4 + hd]);
    for (int idx = td; idx < 64 * 40; idx += 256) ST[idx] = 0;
    f32x16 Sacc;
#pragma unroll
    for (int i = 0; i < 16; ++i) Sacc[i] = 0.f;
    u32x4 qreg, kreg, vreg0, vreg1, greg;
    auto chunk_of = [&](int s) { return dir == 0 ? s : (s < 4 ? 3 - s : 71 - s); };
    auto chunk_row0 = [&](int g) { return g < 4 ? ML + b * CTXL + 64 * g : b * SEQL + 64 * (g - 4); };
    auto gload = [&](int s) {
        const int g = chunk_of(s), row0 = chunk_row0(g);
        qreg = *(const u32x4*)(PROJ + (size_t)(row0 + (td >> 2)) * INWP + qcol + 8 * (td & 3));
        kreg = *(const u32x4*)(PROJ + (size_t)(row0 + (td >> 2)) * INWP + kcol + 8 * (td & 3));
        vreg0 = *(const u32x4*)(VTb + (size_t)(td >> 3) * POSN + 64 * g + 8 * (td & 7));
        vreg1 = *(const u32x4*)(VTb + (size_t)(32 + (td >> 3)) * POSN + 64 * g + 8 * (td & 7));
        if (mixer == 0 && td < 128) greg = *(const u32x4*)(PROJ + (size_t)(row0 + (td >> 1)) * INWP + 1952 + 16 * dir + 8 * (td & 1));
    };
    gload(0);
    __syncthreads();
    for (int s = 0; s < 68; ++s) {
        const int g = chunk_of(s), row0 = chunk_row0(g);
        *(u32x4*)(VTt + (td >> 3) * 72 + 8 * (td & 7)) = vreg0;
        *(u32x4*)(VTt + (32 + (td >> 3)) * 72 + 8 * (td & 7)) = vreg1;
        if (mixer == 0 && td < 128) { float* gp = GT + (td >> 1) * 16 + 8 * (td & 1);
            gp[0] = bflo(greg.x); gp[1] = bfhi(greg.x); gp[2] = bflo(greg.y); gp[3] = bfhi(greg.y); gp[4] = bflo(greg.z); gp[5] = bfhi(greg.z); gp[6] = bflo(greg.w); gp[7] = bfhi(greg.w); }
        const u32x4 qc = qreg, kc = kreg;
        if (s + 1 < 68) gload(s + 1);
        const int s_other = dir == 0 ? (g < 4 ? 3 - g : 71 - g) : g;
        const bool fin = s_other < s;
        float* ot = OTMP + (size_t)g * 4096 + (td >> 2) * 64 + 16 * (td & 3);
        f32x4 pf0, pf1, pf2, pf3; u32x4 g0, g1;
        LBAR();
        { const int d = td & 31, seg = td >> 5; float a[8];
          if (mixer == 0) {
#pragma unroll
              for (int i = 0; i < 8; ++i) { const float* gr = GT + (8 * seg + i) * 16;
                  const f32x4 x0 = *(const f32x4*)gr, x1 = *(const f32x4*)(gr + 4), x2 = *(const f32x4*)(gr + 8), x3 = *(const f32x4*)(gr + 12);
                  float acc = wb;
                  acc += x0[0] * wg[0]; acc += x0[1] * wg[1]; acc += x0[2] * wg[2]; acc += x0[3] * wg[3];
                  acc += x1[0] * wg[4]; acc += x1[1] * wg[5]; acc += x1[2] * wg[6]; acc += x1[3] * wg[7];
                  acc += x2[0] * wg[8]; acc += x2[1] * wg[9]; acc += x2[2] * wg[10]; acc += x2[3] * wg[11];
                  acc += x3[0] * wg[12]; acc += x3[1] * wg[13]; acc += x3[2] * wg[14]; acc += x3[3] * wg[15];
                  a[i] = logsig_f(acc) * (1.f / 16.f); }
          } else {
#pragma unroll
              for (int i = 0; i < 8; ++i) a[i] = lg;
          }
          float run = 0.f;
          if (dir == 0) {
#pragma unroll
              for (int i = 0; i < 8; ++i) { run += a[i]; a[i] = run; }
          } else {
#pragma unroll
              for (int i = 7; i >= 0; --i) { run += a[i]; a[i] = run; }
          }
          SEG[seg * 32 + d] = run;
          LBAR();
          float off = 0.f, tot = 0.f;
#pragma unroll
          for (int s2 = 0; s2 < 8; ++s2) { const float sv = SEG[s2 * 32 + d]; tot += sv; if (dir == 0 ? (s2 < seg) : (s2 > seg)) off += sv; }
#pragma unroll
          for (int i = 0; i < 8; ++i) BB[(8 * seg + i) * 32 + d] = a[i] + off;
          if (seg == 0) { BEND[d] = tot; BEND[32 + d] = __expf(tot); } }
        LBAR();
        { const int j = td >> 2, cc = td & 3;
          float qv[8] = {bflo(qc.x), bfhi(qc.x), bflo(qc.y), bfhi(qc.y), bflo(qc.z), bfhi(qc.z), bflo(qc.w), bfhi(qc.w)};
          float kv[8] = {bflo(kc.x), bfhi(kc.x), bflo(kc.y), bfhi(kc.y), bflo(kc.z), bfhi(kc.z), bflo(kc.w), bfhi(kc.w)};
          float k1[8];
#pragma unroll
          for (int i = 0; i < 8; ++i) { const int d = 8 * cc + i; const float bv = BB[j * 32 + d], ee = BEND[32 + d];
              const float eb = __expf(bv), en = __builtin_amdgcn_rcpf(eb); qv[i] *= eb; k1[i] = kv[i] * en; KH[d * 72 + ((j & ~12) | ((j & 4) << 1) | ((j & 8) >> 1))] = (bf16_t)f2bf(kv[i] * (ee * en)); }
          u32x4 wq, wk; wq.x = pk2(qv[0], qv[1]); wq.y = pk2(qv[2], qv[3]); wq.z = pk2(qv[4], qv[5]); wq.w = pk2(qv[6], qv[7]);
          wk.x = pk2(k1[0], k1[1]); wk.y = pk2(k1[2], k1[3]); wk.z = pk2(k1[4], k1[5]); wk.w = pk2(k1[6], k1[7]);
          *(u32x4*)(QT + j * 40 + 8 * cc) = wq; *(u32x4*)(KT + j * 40 + 8 * cc) = wk; }
        __syncthreads();
        if (fin) { pf0 = *(const f32x4*)(ot); pf1 = *(const f32x4*)(ot + 4); pf2 = *(const f32x4*)(ot + 8); pf3 = *(const f32x4*)(ot + 12);
            const bf16_t* gp = PROJ + (size_t)(row0 + (td >> 2)) * INWP + ogcol + 16 * (td & 3); g0 = *(const u32x4*)gp; g1 = *(const u32x4*)(gp + 8); }
        { const int jb = wd >> 1, ib = wd & 1; const bool skip = dir == 0 ? (jb > ib) : (jb < ib);
          f32x16 pa;
#pragma unroll
          for (int i = 0; i < 16; ++i) pa[i] = 0.f;
          if (!skip) {
#pragma unroll
              for (int s2 = 0; s2 < 2; ++s2) { const bf16x8 a = *(const bf16x8*)(KT + (32 * jb + r32) * 40 + 16 * s2 + 8 * h), bq = *(const bf16x8*)(QT + (32 * ib + r32) * 40 + 16 * s2 + 8 * h);
                  pa = MFMA32(a, bq, pa); }
          }
          const int itok = 32 * ib + r32;
#pragma unroll
          for (int gq = 0; gq < 4; ++gq) { f32x4 v;
#pragma unroll
              for (int i = 0; i < 4; ++i) { const int j = 32 * jb + 8 * gq + 4 * h + i; const bool keep = dir == 0 ? (j <= itok) : (j >= itok); v[i] = keep ? pa[4 * gq + i] : 0.f; }
              pg8::store4(SC + itok * 72 + 32 * jb + 16 * (gq >> 1) + 8 * h + 4 * (gq & 1), v); } }
        LBAR();
        f32x16 oacc;
        { const int eb = wd >> 1, ib = wd & 1;
#pragma unroll
          for (int i = 0; i < 16; ++i) oacc[i] = 0.f;
#pragma unroll
          for (int s2 = 0; s2 < 4; ++s2) { const bf16x8 a = *(const bf16x8*)(VTt + (32 * eb + r32) * 72 + 16 * s2 + 8 * h), bb = *(const bf16x8*)(SC + (32 * ib + r32) * 72 + 16 * s2 + 8 * h);
              oacc = MFMA32(a, bb, oacc); }
#pragma unroll
          for (int s2 = 0; s2 < 2; ++s2) { const bf16x8 a = *(const bf16x8*)(ST + (32 * eb + r32) * 40 + 16 * s2 + 8 * h), bb = *(const bf16x8*)(QT + (32 * ib + r32) * 40 + 16 * s2 + 8 * h);
              oacc = MFMA32(a, bb, oacc); }
          if (wd < 2) { const float dec = BEND[32 + r32];
#pragma unroll
              for (int i = 0; i < 16; ++i) Sacc[i] *= dec;
#pragma unroll
              for (int s2 = 0; s2 < 4; ++s2) { const bf16x8 a = *(const bf16x8*)(VTt + (32 * wd + r32) * 72 + 16 * s2 + 8 * h), bb = *(const bf16x8*)(KH + r32 * 72 + 16 * s2 + 8 * h);
                  Sacc = MFMA32(a, bb, Sacc); } } }
        LBAR();
        { const int eb = wd >> 1, ib = wd & 1;
#pragma unroll
          for (int gq = 0; gq < 4; ++gq) *(f32x4*)(OL + (32 * ib + r32) * 68 + 32 * eb + 8 * gq + 4 * h) = (f32x4){oacc[4 * gq], oacc[4 * gq + 1], oacc[4 * gq + 2], oacc[4 * gq + 3]};
          if (wd < 2) {
#pragma unroll
              for (int i = 0; i < 16; ++i) ST[(32 * wd + crow(i, h)) * 40 + r32] = (bf16_t)f2bf(Sacc[i]); } }
        LBAR();
        { const int j = td >> 2, e0 = 16 * (td & 3); float ov[16];
#pragma unroll
          for (int q4 = 0; q4 < 4; ++q4) { const f32x4 v = *(const f32x4*)(OL + j * 68 + e0 + 4 * q4); ov[4 * q4] = v[0]; ov[4 * q4 + 1] = v[1]; ov[4 * q4 + 2] = v[2]; ov[4 * q4 + 3] = v[3]; }
          if (fin) {
              float ss = 0.f;
              const float pv[16] = {pf0[0], pf0[1], pf0[2], pf0[3], pf1[0], pf1[1], pf1[2], pf1[3], pf2[0], pf2[1], pf2[2], pf2[3], pf3[0], pf3[1], pf3[2], pf3[3]};
#pragma unroll
              for (int i = 0; i < 16; ++i) { ov[i] += pv[i]; ss += ov[i] * ov[i]; }
              ss += __shfl_xor(ss, 1); ss += __shfl_xor(ss, 2);
              const float rn = rsqrtf(ss * (1.f / 64.f) + EPS);
              const int row = row0 + j;
              const float gv[16] = {bflo(g0.x), bfhi(g0.x), bflo(g0.y), bfhi(g0.y), bflo(g0.z), bfhi(g0.z), bflo(g0.w), bfhi(g0.w),
                                    bflo(g1.x), bfhi(g1.x), bflo(g1.y), bfhi(g1.y), bflo(g1.z), bfhi(g1.z), bflo(g1.w), bfhi(g1.w)};
              float r[16];
#pragma unroll
              for (int i = 0; i < 16; ++i) r[i] = ov[i] * rn * ogr[i] * silu_f(gv[i]);
              u32x4 w0, w1; w0.x = pk2(r[0], r[1]); w0.y = pk2(r[2], r[3]); w0.z = pk2(r[4], r[5]); w0.w = pk2(r[6], r[7]);
              w1.x = pk2(r[8], r[9]); w1.y = pk2(r[10], r[11]); w1.z = pk2(r[12], r[13]); w1.w = pk2(r[14], r[15]);
              *(u32x4*)(CC + (size_t)row * DM + ccol + e0) = w0; *(u32x4*)(CC + (size_t)row * DM + ccol + e0 + 8) = w1;
          } else {
#pragma unroll
              for (int q4 = 0; q4 < 4; ++q4) *(f32x4*)(ot + 4 * q4) = (f32x4){ov[4 * q4], ov[4 * q4 + 1], ov[4 * q4 + 2], ov[4 * q4 + 3]};
          } }
        LBAR();
    }
    __syncthreads();
}

DI void mixer_phase(const Params& p, unsigned char* lds, int l, int rep) {
    asm volatile("" : "+s"(l));
    const int tid = ltid();
    unsigned* ctr = (unsigned*)(KWS + OFF_CTL) + 64 * (l + 1 + 4 * rep);
    volatile int* s_item = (volatile int*)(lds + LDS_CTL_OFF);
    const bool with_ctx = l < NLAYER - 1;
    const int nitems = 64 + 1024 + (with_ctx ? 64 : 0);
    for (;;) {
        if (tid == 0) *s_item = (int)atomicAdd(ctr, 1u);
        __syncthreads();
        const int it = __builtin_amdgcn_readfirstlane(*s_item);
        __syncthreads();
        if (it >= nitems) break;
        if (rep > 0 && ((REP_MIX_ONLY == 1 && it >= 64) || (REP_MIX_ONLY == 2 && it < 64))) continue;
        if (it < 64) { if (PH(11)) scan_unit(p, lds, l, it >> 5, (it >> 2) & 7, it & 3, it); }
        else { int type, b, hd, qrow0, NT;
            if (it < 64 + 1024) { const int u = it - 64, rem = u & 511, qb = rem & 15; type = u >> 9; b = rem >> 6; hd = (rem >> 4) & 3; qrow0 = b * SEQL + 256 * qb; NT = POSN / 64; }
            else { const int u = it - 1088; type = u >> 5; b = (u >> 2) & 7; hd = u & 3; qrow0 = ML + b * CTXL; NT = CTXL / 64; }
            if (type == 0) { if (PH(12)) attn_unit<0>(p, lds, l, b, hd, qrow0, NT); } else { if (PH(13)) attn_unit<1>(p, lds, l, b, hd, qrow0, NT); } }
    }
}

#define LAS __attribute__((address_space(3)))
#define XB_TMO      128
#define XB_XCNT(j)  (256  + 64 * (j))
#define XB_XSUB(j)  (1280 + 64 * (j))
#define XB_XGEN(j)  (2304 + 64 * (j))
#define XB_TOP      3328
#define XB_TOPGEN   3392
#define XCD_BAR_WORDS 3456
#define XB_SPIN_CAP (1u << 18)

__device__ __forceinline__ unsigned xb_ld(unsigned* p)              { return __hip_atomic_load(p, __ATOMIC_RELAXED, __HIP_MEMORY_SCOPE_AGENT); }
__device__ __forceinline__ unsigned xb_add(unsigned* p, unsigned v) { return __hip_atomic_fetch_add(p, v, __ATOMIC_RELAXED, __HIP_MEMORY_SCOPE_AGENT); }
__device__ __forceinline__ unsigned xb_xcc_id() { return (unsigned)__builtin_amdgcn_s_getreg((3 << 11) | 20) & 0xFu; }
#define XB_SPIN(cond, bar) do { unsigned _sp = 0; while (cond) { __builtin_amdgcn_s_sleep(1); \
    if ((++_sp & 255u) == 0u) { if (xb_ld(&(bar)[XB_TMO])) break; if (_sp > XB_SPIN_CAP) { atomicAdd(&(bar)[XB_TMO], 1u); break; } } } } while (0)

struct XcdBarrier {
    unsigned* bar; unsigned x;
    volatile LAS unsigned* st;
};

__device__ __forceinline__ XcdBarrier xcd_barrier_post(unsigned* bar, volatile LAS unsigned* st) {
    XcdBarrier b; b.bar = bar; b.x = xb_xcc_id(); b.st = st;
    if (threadIdx.x == 0) (void)xb_add(&bar[XB_XCNT(b.x)], 1u);
    return b;
}
__device__ __forceinline__ void xcd_barrier_complete(unsigned* bar, unsigned x, unsigned& nloc, unsigned& nx) {
    const unsigned G = gridDim.x * gridDim.y * gridDim.z;
    unsigned sum, cnt, mine, sp = 0u;
    for (;;) {
        sum = 0u; cnt = 0u; mine = 0u;
#pragma unroll
        for (unsigned j = 0; j < 16; ++j) { const unsigned c = xb_ld(&bar[XB_XCNT(j)]); sum += c; cnt += (c > 0u) ? 1u : 0u; mine = (j == x) ? c : mine; }
        if (sum == G) break;
        __builtin_amdgcn_s_sleep(1);
        if ((++sp & 255u) == 0u) { if (xb_ld(&bar[XB_TMO])) break; if (sp > XB_SPIN_CAP) { atomicAdd(&bar[XB_TMO], 1u); break; } }
    }
    nloc = mine > 0u ? mine : 1u; nx = cnt > 0u ? cnt : 1u;
}

__device__ __forceinline__ void xcd_barrier(const XcdBarrier& b) {
    asm volatile("s_waitcnt vmcnt(0)" ::: "memory");
    __syncthreads();
    if (threadIdx.x == 0) {
        unsigned* bar = b.bar;
        __builtin_amdgcn_s_waitcnt(0);
        unsigned nloc = b.st[0], nx = b.st[1];
        if (nloc == 0u) { xcd_barrier_complete(bar, b.x, nloc, nx); b.st[0] = nloc; b.st[1] = nx; }
        const unsigned old = xb_add(&bar[XB_XSUB(b.x)], 1u);
        const unsigned gen = old / nloc;
        if (old + 1u == (gen + 1u) * nloc) {
            __builtin_amdgcn_fence(__ATOMIC_RELEASE, "agent");
            asm volatile("s_waitcnt vmcnt(0)" ::: "memory");
            const unsigned og = xb_add(&bar[XB_TOP], 1u);
            const unsigned tg = og / nx;
            if (og + 1u == (tg + 1u) * nx) xb_add(&bar[XB_TOPGEN], 1u);
            else XB_SPIN(xb_ld(&bar[XB_TOPGEN]) == tg, bar);
            __builtin_amdgcn_fence(__ATOMIC_ACQUIRE, "agent");
            xb_add(&bar[XB_XGEN(b.x)], 1u);
            asm volatile("s_waitcnt vmcnt(0)" ::: "memory");
        } else {
            XB_SPIN(xb_ld(&bar[XB_XGEN(b.x)]) == gen, bar);
            __builtin_amdgcn_fence(__ATOMIC_ACQUIRE, "agent");
            asm volatile("s_waitcnt vmcnt(0)" ::: "memory");
        }
    }
    __syncthreads();
}

template <class T> DI T* opq(T* q) { asm volatile("" : "+s"(q)); return q; }
__global__ void __launch_bounds__(512, 2) mega(Params p) {
    extern __shared__ __attribute__((aligned(16))) unsigned char lds[];
    cg::grid_group grid = cg::this_grid();
    { volatile LAS unsigned* z = (volatile LAS unsigned*)((LAS unsigned char*)lds + LDS_CTL_OFF); if (threadIdx.x < 16) z[threadIdx.x] = 0u; }
    __syncthreads();
#if USE_CG_SYNC
#define GSYNC() grid.sync()
#else
#define GSYNC() xcd_barrier(xbar)
#endif
    PG8_LAS unsigned char* lds3 = (PG8_LAS unsigned char*)lds;
    const int G = gridDim.x, c = blockIdx.x;
#define WSB(off) (opq(KWS) + (off))
#define WGT(off) ((bf16_t*)(opq(KWS) + OFF_W + (off)))

    if (PH(0)) phase0(p, lds);
    grid.sync();
    const XcdBarrier xbar = xcd_barrier_post((unsigned*)(KWS + OFF_BAR), (volatile LAS unsigned*)((LAS unsigned char*)lds + LDS_CTL_OFF + 32));
#pragma unroll 1
    for (int l = 0; l < NLAYER; ++l) {
        const bool with_ctx = l < NLAYER - 1;
        const int Mrows = with_ctx ? MT : ML;
        if (PH(1)) {
            const float* ng = opq(KIN(I_NORMG)) + (size_t)l * 4 * DM; const float* MODS = (const float*)WSB(OFF_MODS); const float* ml = MODS + (size_t)l * 9 * 6144;
            bf16_t* HC = (bf16_t*)WSB(OFF_HC); float* XC = (float*)WSB(OFF_XCTX); float* outp = opq(KOUT);
            if (l == 0) rowpass(0, MT, c, G, KIN(I_X), KIN(I_CTX), nullptr, nullptr, nullptr, nullptr, nullptr, HC, ng, ml, ml + 1024);
            else {
                if (c < 32) { pg8::Gemm g{(const bf16_t*)WSB(OFF_PA) + (size_t)ML * FFH, WGT(W_F2), MC, DM, FFH, FFH}; pg8::StaticOrder S; S.init(MC, DM, G, c);
                    pg8::EpiY E{(bf16_t*)WSB(OFF_Y) + (size_t)ML * DM, DM};
                    pg8::gemm_phase<pg8::EpiY, pg8::StaticOrder, true, true>(lds3, g, S, E); }
                else { rowpass(0, ML, c - 32, G - 32, outp, XC, outp, XC, (const bf16_t*)WSB(OFF_Y), MODS + (size_t)(l - 1) * 9 * 6144 + 5 * 1024, ng - DM, HC, ng, ml, ml + 1024);
                    if (PH(2)) convert_weights(p, l, lds, 1, c - 32, G - 32); }
                GSYNC();
                rowpass(ML, MT, c, G, outp, XC, outp, XC, (const bf16_t*)WSB(OFF_Y), MODS + (size_t)(l - 1) * 9 * 6144 + 5 * 1024, ng - DM, HC, ng, ml, ml + 1024);
            }
        }
        for (int rep = 0; rep < REP_CONV; ++rep) { if (PH(2)) convert_weights(p, l, lds, l == 0 ? 3 : 2, c, G); }
        for (int rep = 0; rep < REP_RP0; ++rep) { const float* ng = opq(KIN(I_NORMG)); const float* ml = (const float*)WSB(OFF_MODS); rowpass(0, MT, c, G, KIN(I_X), KIN(I_CTX), nullptr, nullptr, nullptr, nullptr, nullptr, (bf16_t*)WSB(OFF_Y), ng, ml, ml + 1024); }
        GSYNC();
        for (int rep = 0; rep < REP_SYNC; ++rep) GSYNC();
        for (int rep = 0; rep < REP_G3; ++rep) { if (rep) GSYNC();
        if (PH(3)) { pg8::Gemm g{(const bf16_t*)WSB(OFF_HC), WGT(W_IN), MT, INWP, DM, DM}; pg8::StaticOrder S; S.init(MT, INWP, G, c);
          const float* rc = (const float*)WSB(OFF_ROPE);
          pg8::EpiProj E{(bf16_t*)WSB(OFF_PA), (bf16_t*)WSB(OFF_VT), (float*)WSB(OFF_STQ), (float*)WSB(OFF_STKV), rc, rc + 4096 * 16, lds + LDS_CTL_OFF + 256};
          pg8::gemm_phase<pg8::EpiProj, pg8::StaticOrder, true, true>(lds3, g, S, E); } }
        GSYNC();
        for (int rep = 0; rep < REP_C; ++rep) {
        if (PH(4)) { int Kq = 256; asm volatile("" : "+s"(Kq)); pg8::Gemm g{(const bf16_t*)WSB(OFF_PA) + 768, WGT(W_UQ), MT, 512, Kq, INWP}; pg8::StaticOrder S; S.init(MT, 512, G, c);
          const float* rc = (const float*)WSB(OFF_ROPE);
          pg8::EpiUpQ E{(bf16_t*)WSB(OFF_MLAQ), (const float*)WSB(OFF_STQ), rc, rc + 4096 * 16};
          pg8::gemm_phase<pg8::EpiUpQ, pg8::StaticOrder, true, true>(lds3, g, S, E); }
        if (PH(5)) { int Kq = 128; asm volatile("" : "+s"(Kq)); pg8::Gemm g{(const bf16_t*)WSB(OFF_PA) + 1024, WGT(W_UKV), MT, 512, Kq, INWP}; pg8::StaticOrder S; S.init(MT, 512, G, (c + G / 2) % G);
          pg8::EpiUpKV E{(bf16_t*)WSB(OFF_MLAK), (bf16_t*)WSB(OFF_VT), (const float*)WSB(OFF_STKV), lds + LDS_CTL_OFF + 256};
          pg8::gemm_phase<pg8::EpiUpKV, pg8::StaticOrder, true, true>(lds3, g, S, E); }
        GSYNC(); }
        for (int rep = 0; rep < REP_MIX; ++rep) { if (PH(6)) mixer_phase(p, lds, l, rep); GSYNC(); }
        for (int rep = 0; rep < REP_G7; ++rep) { if (rep) GSYNC();
        if (PH(7)) { pg8::Gemm g{(const bf16_t*)WSB(OFF_HC), WGT(W_OUT), Mrows, DM, DM, DM}; pg8::StaticOrder S; S.init(Mrows, DM, G, c);
          pg8::EpiY E{(bf16_t*)WSB(OFF_Y), DM};
          pg8::gemm_phase<pg8::EpiY, pg8::StaticOrder, true, true>(lds3, g, S, E); } }
        GSYNC();
        if (PH(8)) {
            const float* ng = opq(KIN(I_NORMG)) + (size_t)l * 4 * DM; const float* ml = (const float*)WSB(OFF_MODS) + (size_t)l * 9 * 6144;
            float* XC = (float*)WSB(OFF_XCTX); float* outp = opq(KOUT);
            rowpass(0, Mrows, c, G, l == 0 ? KIN(I_X) : outp, l == 0 ? KIN(I_CTX) : XC, outp, XC, (const bf16_t*)WSB(OFF_Y), ml + 2 * 1024, ng + DM, (bf16_t*)WSB(OFF_HC), ng + 2 * DM, ml + 3 * 1024, ml + 4 * 1024);
        }
        GSYNC();
        for (int rep = 0; rep < REP_G9; ++rep) { if (rep) GSYNC();
        if (PH(9)) { pg8::Gemm g{(const bf16_t*)WSB(OFF_HC), WGT(W_F1), Mrows, 2 * FFH, DM, DM}; pg8::StaticOrder S; S.init(Mrows, 2 * FFH, G, c);
          pg8::EpiSwiglu E{(bf16_t*)WSB(OFF_PA)};
          pg8::gemm_phase<pg8::EpiSwiglu, pg8::StaticOrder, true, true>(lds3, g, S, E); } }
        GSYNC();
        for (int rep = 0; rep < REP_G10; ++rep) { if (rep) GSYNC();
        if (PH(10)) { pg8::Gemm g{(const bf16_t*)WSB(OFF_PA), WGT(W_F2), ML, DM, FFH, FFH}; pg8::StaticOrder S; S.init(ML, DM, G, c);
          pg8::EpiY E{(bf16_t*)WSB(OFF_Y), DM};
          pg8::gemm_phase<pg8::EpiY, pg8::StaticOrder, true, true>(lds3, g, S, E); } }
        GSYNC();
    }
    { float* XC = (float*)WSB(OFF_XCTX); float* outp = opq(KOUT);
      rowpass(0, ML, c, G, outp, XC, outp, XC, (const bf16_t*)WSB(OFF_Y), (const float*)WSB(OFF_MODS) + (size_t)3 * 9 * 6144 + 5 * 1024, KIN(I_NORMG) + (size_t)3 * 4 * DM + 3 * DM, nullptr, nullptr, nullptr, nullptr); }
}

extern "C" void kernel_launch(void* const* d_in, const int* in_sizes, int n_in, void* d_out, int out_size, void* d_ws, size_t ws_size, hipStream_t stream) {
    static int grid_blocks = 0;
    if (!grid_blocks) {
        if (n_in != 22 || ws_size < WS_END2) { fprintf(stderr, "kernel_launch: unexpected n_in %d or ws_size %zu (need %zu)\n", n_in, ws_size, (size_t)WS_END2); grid_blocks = -1; return; }
        int dev = 0, cus = 0, per_cu = 0;
        (void)hipGetDevice(&dev);
        (void)hipDeviceGetAttribute(&cus, hipDeviceAttributeMultiprocessorCount, dev);
        (void)hipFuncSetAttribute((const void*)mega, hipFuncAttributeMaxDynamicSharedMemorySize, LDS_BYTES);
        (void)hipOccupancyMaxActiveBlocksPerMultiprocessor(&per_cu, (const void*)mega, 512, LDS_BYTES);
        if (per_cu < 1) per_cu = 1;
        grid_blocks = cus * per_cu;
    }
    if (grid_blocks < 0) return;
    Params p{};
    for (int i = 0; i < 22; ++i) p.in[i] = (const float*)d_in[i];
    p.out = (float*)d_out; p.ws = (unsigned char*)d_ws;
    void* args[] = {&p};
    hipError_t e = hipLaunchCooperativeKernel((const void*)mega, dim3(grid_blocks), dim3(512), args, LDS_BYTES, stream);
    if (e != hipSuccess) fprintf(stderr, "cooperative launch failed: %s (grid %d)\n", hipGetErrorString(e), grid_blocks);
}
```

```cpp
#include <hip/hip_runtime.h>
#include <hip/hip_cooperative_groups.h>
#include <cstdio>
#include <cstdint>
namespace cg = cooperative_groups;
namespace pg8 {
#define PG8_LAS __attribute__((address_space(3)))
typedef unsigned short bf16_t;
typedef short bf16x8 __attribute__((ext_vector_type(8)));
typedef float f32x4 __attribute__((ext_vector_type(4)));
typedef unsigned u32x4 __attribute__((ext_vector_type(4)));
constexpr int BM = 256, BK = 64, HALF = 128, HTB = HALF * BK * 2  , STAGE_BYTES = 8 * HTB, NXCD = 8, WGM = 8;

__host__ __device__ __forceinline__ int lds_byte(int r, int c) { const int st = (r >> 4) * 2 + (c >> 5), rr = r & 15, cc = c & 31, ob = rr * 64 + cc * 2; return st * 1024 + (ob ^ (((ob >> 9) & 1) << 5)); }
__host__ __device__ __forceinline__ void stage_rc(int b, int& R, int& C) { const int st = b / 1024, sb = b % 1024, swz = sb ^ (((sb >> 9) & 1) << 5); R = (st >> 1) * 16 + swz / 64; C = (st & 1) * 32 + (swz % 64) / 2; }
__host__ __device__ __forceinline__ int perm32(int rho) { const int n = rho >> 4, i = rho & 15; return 8 * (i >> 2) + 4 * n + (i & 3); }

struct Unit { int pm, pn; };
struct Gemm { const bf16_t* A; const bf16_t* Bt; int M, N, K, lda; };

struct StaticOrder {
    int nM, nN, nwg, G, c;
    __host__ __device__ void init(int M, int N, int G_, int c_) { nM = M / BM; nN = N / BM; nwg = nM * nN; G = G_; c = c_; }
    __host__ __device__ bool next(int i, Unit& u) const {
        const long L = (long)i * G + c; if (L >= nwg) return false;
        int wgid = (int)L; { const int q = nwg / NXCD, r = nwg % NXCD, xcd = wgid % NXCD, off = wgid / NXCD; wgid = (xcd < r ? xcd * (q + 1) : r * (q + 1) + (xcd - r) * q) + off; }
        const int nig = WGM * nN, gid = wgid / nig, fm = gid * WGM, gsz = (nM - fm) < WGM ? (nM - fm) : WGM;
        u.pm = fm + ((wgid % nig) % gsz); u.pn = (wgid % nig) / gsz; return true;
    }
    __device__ __forceinline__ void a_ready(const Unit&) const {}
    __device__ __forceinline__ void done(const Unit&) const {}
};

__device__ __forceinline__ unsigned cvt_pk_bf16(float lo, float hi) { unsigned r; asm volatile("v_cvt_pk_bf16_f32 %0, %1, %2" : "=v"(r) : "v"(lo), "v"(hi)); return r; }
typedef float f32x2 __attribute__((ext_vector_type(2)));
template <class Epi, class Sched, bool ALIGN_EPI = false, bool SP2 = false>
__device__ __forceinline__ void gemm_phase(PG8_LAS unsigned char* lds, const Gemm g, const Sched& S, const Epi& E) {
    int tid_ = threadIdx.x; asm volatile("" : "+v"(tid_)); const int tid = tid_, wid = __builtin_amdgcn_readfirstlane(tid >> 6), lane = tid & 63, wr = wid >> 2, wc = wid & 3, fr = lane & 15, fq = lane >> 4;
    const int K = g.K, nt = K / BK;
    unsigned voffA[2], voffB[2];
#pragma unroll
    for (int i = 0; i < 2; ++i) { int R, C; stage_rc(tid * 16 + i * 8192, R, C); const int Rb = Epi::PERM ? ((R & ~31) + perm32(R & 31)) : R;
        voffA[i] = (unsigned)(R * g.lda + C) * 2u; voffB[i] = (unsigned)(Rb * K + C) * 2u; }
    const size_t kstep = (size_t)(BK * 2);
    const size_t hstepB = (size_t)HALF * K * 2, hstepA = (size_t)HALF * g.lda * 2;
    const size_t tstepB = 2 * hstepB, tstepA = 2 * hstepA;
    const unsigned ldsw = (unsigned)wid * 1024u;
    const int aoff = lds_byte(wr * 64 + fr, fq * 8), boff = lds_byte(wc * 32 + fr, fq * 8);
#define PG8_SA(b, h) (((b) * 2 + (h)) * HTB)
#define PG8_SB(b, h) ((4 + (b) * 2 + (h)) * HTB)
#define PG8_STAGE(bufoff, gbase, voff) do { _Pragma("unroll") for (int _i = 0; _i < 2; ++_i) \
        __builtin_amdgcn_global_load_lds((const unsigned*)((const char*)(gbase) + (voff)[_i]), (PG8_LAS unsigned*)(lds + (bufoff) + ldsw + _i * 8192), 16, 0, 0); } while (0)
#define PG8_LDA(dst, b, h) do { _Pragma("unroll") for (int m = 0; m < 4; ++m) _Pragma("unroll") for (int k = 0; k < 2; ++k) dst[m][k] = *(const PG8_LAS bf16x8*)(lds + PG8_SA(b, h) + aoff + m * 2048 + k * 1024); } while (0)
#define PG8_LDB(dst, b, h) do { _Pragma("unroll") for (int n = 0; n < 2; ++n) _Pragma("unroll") for (int k = 0; k < 2; ++k) dst[n][k] = *(const PG8_LAS bf16x8*)(lds + PG8_SB(b, h) + boff + n * 2048 + k * 1024); } while (0)
#define PG8_MMA(ai, bj, At, Bt) do { __builtin_amdgcn_s_setprio(1); _Pragma("unroll") for (int m = 0; m < 4; ++m) _Pragma("unroll") for (int n = 0; n < 2; ++n) _Pragma("unroll") for (int k = 0; k < 2; ++k) \
        acc[ai][bj][m][n] = __builtin_amdgcn_mfma_f32_16x16x32_bf16(Bt[n][k], At[m][k], acc[ai][bj][m][n], 0, 0, 0); __builtin_amdgcn_s_setprio(0); } while (0)
#define PG8_WAIT_V(n) asm volatile("s_waitcnt vmcnt(" #n ")" ::: "memory")
#define PG8_WAIT_L(n) asm volatile("s_waitcnt lgkmcnt(" #n ")" ::: "memory")
#define PG8_BAR __builtin_amdgcn_s_barrier()
#define PG8_SCHED __builtin_amdgcn_sched_barrier(0)
    Unit cur, nxt; int ui = 0;
    if (!S.next(0, cur)) return;
    f32x4 acc[2][2][4][2];
#pragma unroll
    for (int a = 0; a < 2; ++a)
#pragma unroll
        for (int b = 0; b < 2; ++b)
#pragma unroll
            for (int m = 0; m < 4; ++m)
#pragma unroll
                for (int n = 0; n < 2; ++n) acc[a][b][m][n] = (f32x4){0.f, 0.f, 0.f, 0.f};
    bf16x8 At[4][2], B0[2][2], B1[2][2];
    const char* cA = (const char*)g.A + (size_t)cur.pm * tstepA; const char* cB = (const char*)g.Bt + (size_t)cur.pn * tstepB;
    S.a_ready(cur);
    if constexpr (SP2) {
        PG8_STAGE(PG8_SB(0, 0), cB, voffB); PG8_STAGE(PG8_SB(0, 1), cB + hstepB, voffB); PG8_STAGE(PG8_SA(0, 0), cA, voffA); PG8_STAGE(PG8_SA(0, 1), cA + hstepA, voffA);
        if (wr == 1) PG8_BAR;
        PG8_WAIT_V(2); PG8_BAR;
        PG8_STAGE(PG8_SB(1, 0), cB + kstep, voffB); PG8_STAGE(PG8_SA(1, 0), cA + kstep, voffA); PG8_STAGE(PG8_SB(1, 1), cB + hstepB + kstep, voffB);
        PG8_WAIT_V(6); PG8_BAR;
    } else {
        PG8_STAGE(PG8_SB(0, 0), cB, voffB); PG8_STAGE(PG8_SA(0, 0), cA, voffA); PG8_STAGE(PG8_SB(0, 1), cB + hstepB, voffB); PG8_STAGE(PG8_SA(0, 1), cA + hstepA, voffA);
        if (wr == 1) PG8_BAR;
        PG8_WAIT_V(4); PG8_BAR;
        PG8_STAGE(PG8_SB(1, 0), cB + kstep, voffB); PG8_STAGE(PG8_SA(1, 0), cA + kstep, voffA); PG8_STAGE(PG8_SB(1, 1), cB + hstepB + kstep, voffB);
        PG8_WAIT_V(6); PG8_BAR;
    }
    for (;;) {
        const bool has_next = S.next(ui + 1, nxt);
        const char* nA = has_next ? (const char*)g.A + (size_t)nxt.pm * tstepA : cA; const char* nB = has_next ? (const char*)g.Bt + (size_t)nxt.pn * tstepB : cB;
        for (int t = 0; t < nt; t += 2) {
            const bool last = (t == nt - 2);
            const char* a1 = cA + (size_t)(t + 1) * kstep;
            const char* a2 = last ? nA : cA + (size_t)(t + 2) * kstep; const char* b2 = last ? nB : cB + (size_t)(t + 2) * kstep;
            const char* a3 = a2 + kstep; const char* b3 = b2 + kstep;
            if (last && has_next) S.a_ready(nxt);
            if constexpr (SP2) {
            PG8_LDB(B0, 0, 0); PG8_LDB(B1, 0, 1); PG8_SCHED; PG8_LDA(At, 0, 0); PG8_STAGE(PG8_SA(1, 1), a1 + hstepA, voffA);
            PG8_WAIT_V(8); PG8_WAIT_L(0); PG8_BAR; PG8_MMA(0, 0, At, B0); PG8_MMA(0, 1, At, B1); PG8_BAR; PG8_SCHED;
            PG8_LDA(At, 0, 1); PG8_STAGE(PG8_SB(0, 0), b2, voffB); PG8_STAGE(PG8_SB(0, 1), b2 + hstepB, voffB); PG8_STAGE(PG8_SA(0, 0), a2, voffA);
            PG8_WAIT_V(8); PG8_WAIT_L(0); PG8_BAR; PG8_MMA(1, 0, At, B0); PG8_MMA(1, 1, At, B1); PG8_BAR; PG8_SCHED;
            PG8_LDB(B0, 1, 0); PG8_LDB(B1, 1, 1); PG8_SCHED; PG8_LDA(At, 1, 0); PG8_STAGE(PG8_SA(0, 1), a2 + hstepA, voffA);
            PG8_WAIT_V(8); PG8_WAIT_L(0); PG8_BAR; PG8_MMA(0, 0, At, B0); PG8_MMA(0, 1, At, B1); PG8_BAR; PG8_SCHED;
            PG8_LDA(At, 1, 1); PG8_STAGE(PG8_SB(1, 0), b3, voffB); PG8_STAGE(PG8_SB(1, 1), b3 + hstepB, voffB); PG8_STAGE(PG8_SA(1, 0), a3, voffA);
            PG8_WAIT_V(8); PG8_WAIT_L(0); PG8_BAR; PG8_MMA(1, 0, At, B0); PG8_MMA(1, 1, At, B1); PG8_BAR; PG8_SCHED;
            } else {
            PG8_LDB(B0, 0, 0); PG8_SCHED; PG8_LDA(At, 0, 0); PG8_STAGE(PG8_SA(1, 1), a1 + hstepA, voffA);
            PG8_WAIT_L(8); PG8_BAR; PG8_WAIT_L(0); PG8_MMA(0, 0, At, B0); PG8_BAR; PG8_SCHED;
            PG8_LDB(B1, 0, 1); PG8_STAGE(PG8_SB(0, 0), b2, voffB);
            PG8_BAR; PG8_WAIT_L(0); PG8_MMA(0, 1, At, B1); PG8_BAR;
            PG8_LDA(At, 0, 1); PG8_STAGE(PG8_SA(0, 0), a2, voffA);
            PG8_BAR; PG8_WAIT_L(0); PG8_MMA(1, 0, At, B0); PG8_BAR; PG8_SCHED;
            PG8_STAGE(PG8_SB(0, 1), b2 + hstepB, voffB);
            PG8_WAIT_V(6); PG8_BAR; PG8_MMA(1, 1, At, B1); PG8_BAR;
            PG8_LDB(B0, 1, 0); PG8_SCHED; PG8_LDA(At, 1, 0); PG8_STAGE(PG8_SA(0, 1), a2 + hstepA, voffA);
            PG8_WAIT_L(8); PG8_BAR; PG8_WAIT_L(0); PG8_MMA(0, 0, At, B0); PG8_BAR; PG8_SCHED;
            PG8_LDB(B1, 1, 1); PG8_STAGE(PG8_SB(1, 0), b3, voffB);
            PG8_BAR; PG8_WAIT_L(0); PG8_MMA(0, 1, At, B1); PG8_BAR;
            PG8_LDA(At, 1, 1); PG8_STAGE(PG8_SA(1, 0), a3, voffA);
            PG8_BAR; PG8_WAIT_L(0); PG8_MMA(1, 0, At, B0); PG8_BAR; PG8_SCHED;
            PG8_STAGE(PG8_SB(1, 1), b3 + hstepB, voffB);
            PG8_WAIT_V(6); PG8_BAR; PG8_MMA(1, 1, At, B1); PG8_BAR;
            }
        }
        if constexpr (ALIGN_EPI) { if (wr == 0) PG8_BAR; }
        if constexpr (!Epi::AFTER_DRAIN) { E(acc, cur, wr, wc, fr, fq); S.done(cur); }
        if (!has_next) break;
#pragma unroll
        for (int a = 0; a < 2; ++a)
#pragma unroll
            for (int b = 0; b < 2; ++b)
#pragma unroll
                for (int m = 0; m < 4; ++m)
#pragma unroll
                    for (int n = 0; n < 2; ++n) acc[a][b][m][n] = (f32x4){0.f, 0.f, 0.f, 0.f};
        cur = nxt; cA = nA; cB = nB; ++ui;
        if constexpr (ALIGN_EPI) { if (wr == 1) PG8_BAR; }
    }
    PG8_WAIT_V(0);
    if constexpr (!ALIGN_EPI) { if (wr == 0) PG8_BAR; }
    PG8_BAR;
    if constexpr (Epi::AFTER_DRAIN) { E.fused(acc, cur, wr, wc, fr, fq, lds, wid, lane); S.done(cur); }
#undef PG8_SA
#undef PG8_SB
#undef PG8_STAGE
#undef PG8_LDA
#undef PG8_LDB
#undef PG8_MMA
#undef PG8_WAIT_V
#undef PG8_WAIT_L
#undef PG8_BAR
#undef PG8_SCHED
}
}

typedef unsigned short bf16_t;
typedef short bf16x8 __attribute__((ext_vector_type(8)));
typedef short s16x4 __attribute__((ext_vector_type(4)));
typedef float f32x4 __attribute__((ext_vector_type(4)));
typedef float f32x16 __attribute__((ext_vector_type(16)));
typedef unsigned u32x4 __attribute__((ext_vector_type(4)));
typedef unsigned u32x2 __attribute__((ext_vector_type(2)));
typedef float f32x2_t __attribute__((ext_vector_type(2)));
typedef __bf16 bf16x2_t __attribute__((ext_vector_type(2)));
#define DI __device__ __forceinline__
template <class T> DI T* opq2(T* q) { asm volatile("" : "+s"(q)); return q; }
DI int ltid() { int t = threadIdx.x; asm volatile("" : "+v"(t)); return t; }

constexpr int NB = 8, SEQL = 4096, CTXL = 256, DM = 1024, NLAYER = 4;
constexpr int ML = NB * SEQL, MC = NB * CTXL, MT = ML + MC;
constexpr int POSN = SEQL + CTXL;
constexpr int INW = 2752, INWP = 2816, FFH = 2816;
constexpr float EPS = 1e-6f;
constexpr float LOG2E = 1.4426950408889634f;

constexpr size_t OFF_CTL = 0;
constexpr size_t OFF_MODS = 4096;
constexpr size_t OFF_ROPE = OFF_MODS + 884736;
constexpr size_t OFF_STQ = OFF_ROPE + 524288;
constexpr size_t OFF_STKV = OFF_STQ + 1114112;
constexpr size_t OFF_XCTX = OFF_STKV + 557056;
constexpr size_t OFF_W = OFF_XCTX + 8388608;
constexpr size_t W_IN = 0, W_OUT = 5767168, W_F1 = 7864320, W_F2 = 19398656, W_UQ = 25165824, W_UKV = 25427968, W_TOTAL = 25559040;
constexpr size_t OFF_HC = OFF_W + W_TOTAL;
constexpr size_t OFF_PA = OFF_HC + 71303168;
constexpr size_t OFF_Y = OFF_PA + 196083712;
constexpr size_t OFF_MLAQ = OFF_Y + 71303168;
constexpr size_t OFF_MLAK = OFF_MLAQ + 26738688;
constexpr size_t OFF_VT = OFF_MLAK + 17825792;
constexpr size_t VT_TYPE_ELEMS = (size_t)NB * 4 * 64 * POSN;
constexpr size_t WS_END = OFF_VT + 4 * VT_TYPE_ELEMS * 2;
constexpr size_t OFF_BAR = WS_END, WS_END2 = WS_END + 16384;
static_assert(WS_END2 <= 536870912, "workspace map");

#ifndef USE_CG_SYNC
#define USE_CG_SYNC 0
#endif
#ifndef REP_SYNC
#define REP_SYNC 0
#endif
#ifndef REP_C
#define REP_C 1
#endif
#ifndef REP_CONV
#define REP_CONV 1
#endif
#ifndef REP_RP0
#define REP_RP0 0
#endif
#ifndef REP_MIX_ONLY
#define REP_MIX_ONLY 0
#endif
#ifndef REP_MIX
#define REP_MIX 1
#endif
#ifndef REP_GEMM
#define REP_GEMM 1
#endif
#ifndef REP_G3
#define REP_G3 REP_GEMM
#endif
#ifndef REP_G7
#define REP_G7 REP_GEMM
#endif
#ifndef REP_G9
#define REP_G9 REP_GEMM
#endif
#ifndef REP_G10
#define REP_G10 REP_GEMM
#endif
#ifndef PHMASK
#define PHMASK 0xFFFF
#endif
#define PH(k) ((PHMASK >> (k)) & 1)
constexpr int LDS_BYTES = 147456;
constexpr int LDS_CTL_OFF = 131072;

struct Params { const float* in[22]; float* out; unsigned char* ws; };
enum { I_X = 0, I_C, I_CTX, I_CCTX, I_ADAW, I_ADAB, I_NORMG, I_WIN, I_DLAM, I_DNORM, I_MQN, I_MKVN, I_WUQ, I_WUKV, I_GWG, I_GBG, I_GNORM, I_RDEC, I_RNORM, I_WOUT, I_FIN, I_FOUT };

typedef const unsigned char __attribute__((address_space(4)))* kaptr_t;
DI kaptr_t kargs() { kaptr_t ka = (kaptr_t)__builtin_amdgcn_kernarg_segment_ptr(); asm volatile("" : "+s"(ka)); return ka; }
#define KIN(k) (*(const float* const __attribute__((address_space(4)))*)(kargs() + 8 * (k)))
#define KOUT (*(float* const __attribute__((address_space(4)))*)(kargs() + 8 * 22))
#define KWS (*(unsigned char* const __attribute__((address_space(4)))*)(kargs() + 8 * 23))
DI unsigned pk2(float lo, float hi) { f32x2_t v = {lo, hi}; bf16x2_t b = __builtin_convertvector(v, bf16x2_t); return __builtin_bit_cast(unsigned, b); }
DI unsigned f2bf(float f) { return pk2(f, f) & 0xffffu; }
DI float bflo(unsigned w) { return __uint_as_float(w << 16); }
DI float bfhi(unsigned w) { return __uint_as_float(w & 0xffff0000u); }
DI int crow(int i, int h) { return (i & 3) + 8 * (i >> 2) + 4 * h; }
DI float wave_sum(float v) {
#pragma unroll
    for (int o = 1; o < 64; o <<= 1) v += __shfl_xor(v, o);
    return v;
}
DI float silu_f(float x) { return x * __builtin_amdgcn_rcpf(1.f + __expf(-x)); }
DI float logsig_f(float x) { return fminf(x, 0.f) - __logf(1.f + __expf(-fabsf(x))); }
#define LBAR() asm volatile("s_waitcnt lgkmcnt(0)\n\ts_barrier" ::: "memory")
#define MFMA32(a, b, c) __builtin_amdgcn_mfma_f32_32x32x16_bf16((a), (b), (c), 0, 0, 0)

DI void row_bpos(int row, int& b, int& pos) { if (row < ML) { b = row >> 12; pos = CTXL + (row & 4095); } else { const int r = row - ML; b = r >> 8; pos = r & 255; } }
DI int pos_row(int b, int pos) { return pos < CTXL ? ML + b * CTXL + pos : b * SEQL + pos - CTXL; }

namespace pg8 {
struct EpiY {
    static constexpr bool PERM = true, AFTER_DRAIN = false;
    bf16_t* O; int ldc;
    __device__ __forceinline__ void operator()(const f32x4 (&acc)[2][2][4][2], const Unit& u, int wr, int wc, int fr, int fq) const {
        const int row0 = u.pm * BM + wr * 64 + fr, col0 = u.pn * BM + wc * 32 + 8 * fq;
#pragma unroll
        for (int ai = 0; ai < 2; ++ai)
#pragma unroll
            for (int m = 0; m < 4; ++m) { bf16_t* rowp = O + (size_t)(row0 + ai * HALF + m * 16) * ldc + col0;
#pragma unroll
                for (int bj = 0; bj < 2; ++bj) { const f32x4 v0 = acc[ai][bj][m][0], v1 = acc[ai][bj][m][1];
                    u32x4 w; w.x = pk2(v0[0], v0[1]); w.y = pk2(v0[2], v0[3]); w.z = pk2(v1[0], v1[1]); w.w = pk2(v1[2], v1[3]);
                    *(u32x4*)(rowp + bj * HALF) = w; } }
    }
};
struct EpiSwiglu {
    static constexpr bool PERM = true, AFTER_DRAIN = false;
    bf16_t* O;
    __device__ __forceinline__ void operator()(const f32x4 (&acc)[2][2][4][2], const Unit& u, int wr, int wc, int fr, int fq) const {
        const int row0 = u.pm * BM + wr * 64 + fr, col0 = u.pn * HALF + wc * 32 + 8 * fq;
#pragma unroll
        for (int ai = 0; ai < 2; ++ai)
#pragma unroll
            for (int m = 0; m < 4; ++m) { bf16_t* rowp = O + (size_t)(row0 + ai * HALF + m * 16) * FFH + col0;
                float r[8];
#pragma unroll
                for (int n = 0; n < 2; ++n)
#pragma unroll
                    for (int i = 0; i < 4; ++i) { const float g = acc[ai][0][m][n][i], up = acc[ai][1][m][n][i]; r[4 * n + i] = g * __builtin_amdgcn_rcpf(1.f + __expf(-g)) * up; }
                u32x4 w; w.x = pk2(r[0], r[1]); w.y = pk2(r[2], r[3]); w.z = pk2(r[4], r[5]); w.w = pk2(r[6], r[7]);
                *(u32x4*)rowp = w; }
    }
};
DI void rope_pair(f32x4& a, f32x4& b, const float* rc, const float* rs, int row, int fq) {
    if (row < ML) { const int t = row & 4095; const f32x4 c = *(const f32x4*)(rc + t * 16 + 4 * fq), s = *(const f32x4*)(rs + t * 16 + 4 * fq);
        const f32x4 x1 = a, x2 = b; a = x1 * c - x2 * s; b = x1 * s + x2 * c; }
}
DI void store4(bf16_t* p, const f32x4& v) { u32x2 w; w.x = pk2(v[0], v[1]); w.y = pk2(v[2], v[3]); *(u32x2*)p = w; }
DI void store_vt(bf16_t* VT, int type, int hd, int e0, int row, const f32x4& v) {
    int b, pos; row_bpos(row, b, pos);
    pos = (pos & ~12) | ((pos & 4) << 1) | ((pos & 8) >> 1);
    bf16_t* q = VT + ((size_t)((type * NB + b) * 4 + hd) * 64 + e0) * POSN + pos;
#pragma unroll
    for (int i = 0; i < 4; ++i) q[(size_t)i * POSN] = (bf16_t)f2bf(v[i]);
}
DI void store_vt_tile(bf16_t* VT, int type, int hd, int e0, int row0, const f32x4& v0, const f32x4& v1, bf16_t* scr, int fr, int c0, int c1, int lane) {
    const int pr = (fr & ~12) | ((fr & 4) << 1) | ((fr & 8) >> 1);
#pragma unroll
    for (int i = 0; i < 4; ++i) { scr[(c0 + i) * 24 + pr] = (bf16_t)f2bf(v0[i]); scr[(c1 + i) * 24 + pr] = (bf16_t)f2bf(v1[i]); }
    asm volatile("s_waitcnt lgkmcnt(0)" ::: "memory");
    const int col = lane >> 1, half = lane & 1;
    const u32x4 w = *(const u32x4*)(scr + col * 24 + 8 * half);
    int b, pos; row_bpos(row0, b, pos);
    *(u32x4*)(VT + ((size_t)((type * NB + b) * 4 + hd) * 64 + e0 + col) * POSN + pos + 8 * half) = w;
    asm volatile("s_waitcnt lgkmcnt(0)" ::: "memory");
}
struct EpiProj {
    static constexpr bool PERM = true, AFTER_DRAIN = false;
    bf16_t* PROJ; bf16_t* VT; float* stq; float* stkv; const float* rc; const float* rs; unsigned char* scr;
    __device__ __forceinline__ void operator()(const f32x4 (&acc)[2][2][4][2], const Unit& u, int wr, int wc, int fr, int fq) const {
#pragma unroll
        for (int bj = 0; bj < 2; ++bj) {
            const int g = u.pn * 8 + bj * 4 + wc;
            if (g >= 86) continue;
            const int colbase = g * 32;
            int kind = 0; float scale = 1.f; int vtype = 0, vc0 = 0, slot = 0;
            if (g < 8) { kind = 1; scale = 0.17677669529663687f * LOG2E; }
            else if (g < 16) { kind = 1; }
            else if (g < 24) { kind = 2; vtype = 0; vc0 = colbase - 512; }
            else if (g < 32) { kind = 3; slot = g - 24; }
            else if (g < 36) { kind = 4; slot = g - 32; }
            else if (g == 36) { kind = 1; }
            else if (g < 41) { kind = 0; scale = 0.17677669529663687f; }
            else if (g < 45) { kind = 0; }
            else if (g < 53) { kind = 2; vtype = 2; vc0 = colbase - 1440; }
            else if (g < 62) { kind = 0; }
            else if (g < 66) { kind = 1; scale = 0.17677669529663687f; }
            else if (g < 70) { kind = 1; }
            else if (g < 78) { kind = 2; vtype = 3; vc0 = colbase - 2240; }
            else { kind = 0; }
#pragma unroll
            for (int ai = 0; ai < 2; ++ai)
#pragma unroll
                for (int m = 0; m < 4; ++m) {
                    const int row = u.pm * BM + ai * HALF + wr * 64 + m * 16 + fr;
                    f32x4 v0 = acc[ai][bj][m][0], v1 = acc[ai][bj][m][1];
                    if (kind == 1) {
                        f32x4 w0, w1;
#pragma unroll
                        for (int i = 0; i < 4; ++i) { w0[i] = __shfl_xor(v0[i], 32); w1[i] = __shfl_xor(v1[i], 32); }
                        if (row < ML) { const int t = row & 4095; const float* cb = rc + t * 16 + 8 * (fq & 1); const float* sb = rs + t * 16 + 8 * (fq & 1);
                            const f32x4 c0 = *(const f32x4*)cb, c1 = *(const f32x4*)(cb + 4), s0 = *(const f32x4*)sb, s1 = *(const f32x4*)(sb + 4);
                            if (fq < 2) { v0 = v0 * c0 - w0 * s0; v1 = v1 * c1 - w1 * s1; } else { v0 = w0 * s0 + v0 * c0; v1 = w1 * s1 + v1 * c1; } }
                    }
                    v0 = v0 * scale; v1 = v1 * scale;
                    if (kind == 2) {
                        store_vt_tile(VT, vtype, vc0 >> 6, vc0 & 63, row - fr, v0, v1, (bf16_t*)(scr + (wr * 4 + wc) * 1536), fr, 8 * fq, 8 * fq + 4, fr + 16 * fq);
                    } else {
                        { u32x4 ww; ww.x = pk2(v0[0], v0[1]); ww.y = pk2(v0[2], v0[3]); ww.z = pk2(v1[0], v1[1]); ww.w = pk2(v1[2], v1[3]);
                          *(u32x4*)(PROJ + (size_t)row * INWP + colbase + 8 * fq) = ww; }
                        if (kind >= 3) {
                            float ss = (v0[0] * v0[0] + v0[1] * v0[1]) + (v0[2] * v0[2] + v0[3] * v0[3]) + (v1[0] * v1[0] + v1[1] * v1[1]) + (v1[2] * v1[2] + v1[3] * v1[3]);
                            ss += __shfl_xor(ss, 16); ss += __shfl_xor(ss, 32);
                            if (fq == 0) { if (kind == 3) stq[(size_t)row * 8 + slot] = ss; else stkv[(size_t)row * 4 + slot] = ss; }
                        }
                    }
                }
        }
    }
};
struct EpiUpQ {
    static constexpr bool PERM = false, AFTER_DRAIN = false;
    bf16_t* MQ; const float* stq; const float* rc; const float* rs;
    __device__ __forceinline__ void operator()(const f32x4 (&acc)[2][2][4][2], const Unit& u, int wr, int wc, int fr, int fq) const {
#pragma unroll
        for (int ai = 0; ai < 2; ++ai)
#pragma unroll
            for (int m = 0; m < 4; ++m) {
                const int row = u.pm * BM + ai * HALF + wr * 64 + m * 16 + fr;
                const f32x4 s0 = *(const f32x4*)(stq + (size_t)row * 8), s1 = *(const f32x4*)(stq + (size_t)row * 8 + 4);
                const float ss = ((s0[0] + s0[1]) + (s0[2] + s0[3])) + ((s1[0] + s1[1]) + (s1[2] + s1[3]));
                const float sc = rsqrtf(ss * (1.f / 256.f) + EPS) * (0.10206207261596575f * LOG2E);
#pragma unroll
                for (int bj = 0; bj < 2; ++bj) {
                    const int g = u.pn * 8 + bj * 4 + wc;
                    if (g >= 12) continue;
                    f32x4 v0 = acc[ai][bj][m][0], v1 = acc[ai][bj][m][1];
                    if ((g % 3) == 2) rope_pair(v0, v1, rc, rs, row, fq);
                    v0 = v0 * sc; v1 = v1 * sc;
                    bf16_t* pp = MQ + (size_t)row * 384 + g * 32 + 4 * fq;
                    store4(pp, v0); store4(pp + 16, v1);
                }
                asm volatile("" ::: "memory");
            }
    }
};
struct EpiUpKV {
    static constexpr bool PERM = false, AFTER_DRAIN = false;
    bf16_t* MK; bf16_t* VT; const float* stkv; unsigned char* scr;
    __device__ __forceinline__ void operator()(const f32x4 (&acc)[2][2][4][2], const Unit& u, int wr, int wc, int fr, int fq) const {
#pragma unroll
        for (int ai = 0; ai < 2; ++ai)
#pragma unroll
            for (int m = 0; m < 4; ++m) {
                const int row = u.pm * BM + ai * HALF + wr * 64 + m * 16 + fr;
                const f32x4 s0 = *(const f32x4*)(stkv + (size_t)row * 4);
                const float sc = rsqrtf(((s0[0] + s0[1]) + (s0[2] + s0[3])) * (1.f / 128.f) + EPS);
#pragma unroll
                for (int bj = 0; bj < 2; ++bj) {
                    const int g = u.pn * 8 + bj * 4 + wc, hd = g >> 2, part = g & 3;
                    const f32x4 v0 = acc[ai][bj][m][0] * sc, v1 = acc[ai][bj][m][1] * sc;
                    if (part < 2) { bf16_t* pp = MK + (size_t)row * 256 + hd * 64 + part * 32 + 4 * fq; store4(pp, v0); store4(pp + 16, v1); }
                    else { store_vt_tile(VT, 1, hd, (part - 2) * 32, row - fr, v0, v1, (bf16_t*)(scr + (wr * 4 + wc) * 1536), fr, 4 * fq, 16 + 4 * fq, fr + 16 * fq); }
                }
                asm volatile("" ::: "memory");
            }
    }
};
}

DI void phase0(const Params& p, unsigned char* lds) {
    const int tid = ltid(); const size_t gt = (size_t)blockIdx.x * 512 + tid, gn = (size_t)gridDim.x * 512;
    if (blockIdx.x == 0) { for (int i = tid; i < 1024; i += 512) ((unsigned*)(KWS + OFF_CTL))[i] = 0u;
        for (int i = tid; i < 4096; i += 512) ((unsigned*)(KWS + OFF_BAR))[i] = 0u; }
    float* rc = (float*)(KWS + OFF_ROPE); float* rs = rc + 4096 * 16;
    for (size_t i = gt; i < 65536; i += gn) { const int t = (int)(i >> 4), jj = (int)(i & 15), k = jj & 7;
        const float freq = powf(10000.f, -(float)k * 0.125f); const float pos = jj < 8 ? (float)(t >> 6) : (float)(t & 63); const float a = pos * freq;
        rc[i] = cosf(a); rs[i] = sinf(a); }
    float* S = (float*)lds;
    float* red = S + 9216;
    for (int i = tid; i < 9216; i += 512) { const int r = i >> 10, k = i & 1023; const float c = r < 8 ? KIN(I_C)[r * 1024 + k] : KIN(I_CCTX)[k]; S[i] = c / (1.f + expf(-c)); }
    __syncthreads();
    float* MODS = (float*)(KWS + OFF_MODS);
    for (int item = blockIdx.x; item < 768; item += gridDim.x) {
        const int l = item / 192, n0 = (item % 192) * 32, kg = tid >> 5, c = tid & 31;
        const float* W = KIN(I_ADAW) + (size_t)l * 1024 * 6144 + n0 + c;
        float acc[9];
#pragma unroll
        for (int r = 0; r < 9; ++r) acc[r] = 0.f;
#pragma unroll 8
        for (int kk = 0; kk < 64; ++kk) { const int k = kg * 64 + kk; const float w = __builtin_nontemporal_load(W + (size_t)k * 6144);
#pragma unroll
            for (int r = 0; r < 9; ++r) acc[r] += S[r * 1024 + k] * w; }
#pragma unroll
        for (int r = 0; r < 9; ++r) red[(kg * 9 + r) * 32 + c] = acc[r];
        __syncthreads();
        for (int o = tid; o < 288; o += 512) { const int r = o >> 5, cc = o & 31; float sacc = 0.f;
#pragma unroll
            for (int k2 = 0; k2 < 16; ++k2) sacc += red[(k2 * 9 + r) * 32 + cc];
            MODS[(size_t)(l * 9 + r) * 6144 + n0 + cc] = sacc + KIN(I_ADAB)[l * 6144 + n0 + cc]; }
        __syncthreads();
    }
}

DI void tr_item(const float* W, int K, int N, bf16_t* WT, int k0, int n0, int drow0, const float* kscale, float* scr, int lane) {
#pragma unroll 8
    for (int i = 0; i < 32; ++i) { const int kk = 2 * i + (lane >> 5); float v = __builtin_nontemporal_load(W + (size_t)(k0 + kk) * N + n0 + (lane & 31)); if (kscale) v *= kscale[k0 + kk]; scr[kk * 33 + (lane & 31)] = v; }
    asm volatile("s_waitcnt lgkmcnt(0)" ::: "memory");
    const int c = lane & 7;
#pragma unroll
    for (int j = 0; j < 4; ++j) { const int n = (lane >> 3) + 8 * j; const float* s = scr + (8 * c) * 33 + n;
        u32x4 o; o.x = pk2(s[0 * 33], s[1 * 33]); o.y = pk2(s[2 * 33], s[3 * 33]); o.z = pk2(s[4 * 33], s[5 * 33]); o.w = pk2(s[6 * 33], s[7 * 33]);
        *(u32x4*)(WT + (size_t)(drow0 + n) * K + k0 + 8 * c) = o; }
    asm volatile("s_waitcnt lgkmcnt(0)" ::: "memory");
}
DI void convert_weights(const Params& p, int l, unsigned char* lds, int mask, int vblock, int vgrid) {
    asm volatile("" : "+s"(l));
    const int tid = ltid(), wave = tid >> 6, lane = tid & 63; const int gw = vblock * 8 + wave, NGW = vgrid * 8;
    float* scr = (float*)lds + wave * 2112;
    bf16_t* Wb = (bf16_t*)(KWS + OFF_W);
    bf16_t* WT_IN = Wb + W_IN / 2; bf16_t* WT_OUT = Wb + W_OUT / 2; bf16_t* WT_F1 = Wb + W_F1 / 2; bf16_t* WT_F2 = Wb + W_F2 / 2; bf16_t* WT_UQ = Wb + W_UQ / 2; bf16_t* WT_UKV = Wb + W_UKV / 2;
    for (int it = gw; it < 6192; it += NGW) {
        int r = it;
        { const bool isf2 = (it >= 4704 && it < 6112); if (!((mask >> (isf2 ? 1 : 0)) & 1)) continue; }
        if (r < 1376) { tr_item(KIN(I_WIN) + (size_t)l * 1024 * INW, 1024, INW, WT_IN, 64 * (r / 86), 32 * (r % 86), 32 * (r % 86), nullptr, scr, lane); continue; } r -= 1376;
        if (r < 512) { tr_item(KIN(I_WOUT) + (size_t)l * 1024 * 1024, 1024, 1024, WT_OUT, 64 * (r / 32), 32 * (r % 32), 32 * (r % 32), nullptr, scr, lane); continue; } r -= 512;
        if (r < 2816) { const int n0 = 32 * (r % 176); const int j = n0 < FFH ? n0 : n0 - FFH; const int drow = 256 * (j / 128) + (j % 128) + (n0 < FFH ? 0 : 128);
            tr_item(KIN(I_FIN) + (size_t)l * 1024 * 5632, 1024, 5632, WT_F1, 64 * (r / 176), n0, drow, nullptr, scr, lane); continue; } r -= 2816;
        if (r < 1408) { tr_item(KIN(I_FOUT) + (size_t)l * FFH * 1024, FFH, 1024, WT_F2, 64 * (r / 32), 32 * (r % 32), 32 * (r % 32), nullptr, scr, lane); continue; } r -= 1408;
        if (r < 48) { tr_item(KIN(I_WUQ) + (size_t)l * 256 * 384, 256, 384, WT_UQ, 64 * (r / 12), 32 * (r % 12), 32 * (r % 12), KIN(I_MQN) + l * 256, scr, lane); continue; } r -= 48;
        tr_item(KIN(I_WUKV) + (size_t)l * 128 * 512, 128, 512, WT_UKV, 64 * (r / 16), 32 * (r % 16), 32 * (r % 16), KIN(I_MKVN) + l * 128, scr, lane);
    }
    if (!(mask & 1)) return;
    const size_t gt = (size_t)vblock * 512 + tid, gn = (size_t)vgrid * 512; unsigned zz = 0u; asm volatile("" : "+v"(zz)); const u32x4 z = {zz, zz, zz, zz};
    for (size_t i = gt; i < 8192; i += gn) ((u32x4*)(WT_IN + (size_t)INW * 1024))[i] = z;
    for (size_t i = gt; i < 4096; i += gn) ((u32x4*)(WT_UQ + (size_t)384 * 256))[i] = z;
}

DI void rowpass(int row_begin, int row_end, int vblock, int vgrid, const float* xinL, const float* xinC, float* xoutL, float* xoutC, const bf16_t* Y, const float* mgate, const float* gpost,
                bf16_t* H, const float* gpre, const float* mshift, const float* mscale) {
    const int tid = ltid(), wave = tid >> 6, lane = tid & 63; const int gw = vblock * 8 + wave, NGW = vgrid * 8;
    f32x4 vn[4]; u32x2 yn[4];
    auto fetch = [&](int row) {
        const float* xr = row < ML ? xinL + (size_t)row * DM : xinC + (size_t)(row - ML) * DM;
#pragma unroll
        for (int j = 0; j < 4; ++j) vn[j] = __builtin_nontemporal_load((const f32x4*)(xr + 4 * lane + 256 * j));
        if (Y) {
#pragma unroll
            for (int j = 0; j < 4; ++j) yn[j] = __builtin_nontemporal_load((const u32x2*)(Y + (size_t)row * DM + 4 * lane + 256 * j)); }
    };
    f32x4 gpo[4], gpr[4], gat[4], shf[4], scl[4];
#pragma unroll
    for (int j = 0; j < 4; ++j) { gpo[j] = Y ? *(const f32x4*)(gpost + 4 * lane + 256 * j) : (f32x4){0.f, 0.f, 0.f, 0.f}; gpr[j] = H ? *(const f32x4*)(gpre + 4 * lane + 256 * j) : (f32x4){0.f, 0.f, 0.f, 0.f};
        gat[j] = gpo[j]; shf[j] = gpo[j]; scl[j] = gpo[j]; }
    int mb_cur = -1;
    int row = row_begin + gw;
    if (row < row_end) fetch(row);
    for (; row < row_end; row += NGW) {
        const int mb = row < ML ? (row >> 12) : 8;
        f32x4 v[4]; u32x2 yw[4];
#pragma unroll
        for (int j = 0; j < 4; ++j) { v[j] = vn[j]; yw[j] = yn[j]; }
        if (row + NGW < row_end) fetch(row + NGW);
        if (mb != mb_cur) {
            mb_cur = mb;
#pragma unroll
            for (int j = 0; j < 4; ++j) { const int c = 4 * lane + 256 * j;
                if (Y) gat[j] = *(const f32x4*)(mgate + (size_t)mb * 6144 + c);
                if (H) { shf[j] = *(const f32x4*)(mshift + (size_t)mb * 6144 + c); scl[j] = *(const f32x4*)(mscale + (size_t)mb * 6144 + c) + 1.f; } }
        }
        if (Y) {
            f32x4 y[4]; float ss = 0.f;
#pragma unroll
            for (int j = 0; j < 4; ++j) { const u32x2 w = yw[j]; y[j] = (f32x4){bflo(w.x), bfhi(w.x), bflo(w.y), bfhi(w.y)};
                ss += (y[j][0] * y[j][0] + y[j][1] * y[j][1]) + (y[j][2] * y[j][2] + y[j][3] * y[j][3]); }
            const float ry = rsqrtf(wave_sum(ss) * (1.f / DM) + EPS);
            float* xo = row < ML ? xoutL + (size_t)row * DM : xoutC + (size_t)(row - ML) * DM;
#pragma unroll
            for (int j = 0; j < 4; ++j) { v[j] = v[j] + gat[j] * (y[j] * ry * gpo[j]); __builtin_nontemporal_store(v[j], (f32x4*)(xo + 4 * lane + 256 * j)); }
        }
        if (H) {
            float ss = 0.f;
#pragma unroll
            for (int j = 0; j < 4; ++j) ss += (v[j][0] * v[j][0] + v[j][1] * v[j][1]) + (v[j][2] * v[j][2] + v[j][3] * v[j][3]);
            const float rx = rsqrtf(wave_sum(ss) * (1.f / DM) + EPS);
#pragma unroll
            for (int j = 0; j < 4; ++j) { const int c = 4 * lane + 256 * j;
                const f32x4 hv = v[j] * rx * gpr[j] * scl[j] + shf[j]; u32x2 w; w.x = pk2(hv[0], hv[1]); w.y = pk2(hv[2], hv[3]); *(u32x2*)(H + (size_t)row * DM + c) = w; }
        }
    }
}

template <int TYPE>
DI void attn_unit(const Params& p, unsigned char* lds, int l, int b, int hd, int qrow0, int NT) {
    asm volatile("" : "+s"(l), "+s"(b), "+s"(hd), "+s"(qrow0), "+s"(NT));
    constexpr int NMAP = TYPE == 0 ? 2 : 1, KS = TYPE == 0 ? 2 : 6, DQ = NMAP * KS * 16, KP = DQ + 8, CPR = DQ / 8;
    constexpr int TK = TYPE == 0 ? 64 : 128, VP = TK + 8, KCH = TK * CPR / 512, VCPR = TK / 8, VCH = 64 * VCPR / 512;
    const int tid = ltid(), lane = tid & 63, w = tid >> 6, r32 = lane & 31, h = lane >> 5;
    bf16_t* Kl = (bf16_t*)lds;
    bf16_t* Vl = (bf16_t*)(lds + 2 * TK * KP * 2);
    const bf16_t* PROJ = (const bf16_t*)(KWS + OFF_PA);
    const bf16_t* MQ = (const bf16_t*)(KWS + OFF_MLAQ);
    const bf16_t* MK = (const bf16_t*)(KWS + OFF_MLAK);
    const bf16_t* VTb = (const bf16_t*)(KWS + OFF_VT) + ((size_t)((TYPE * NB + b) * 4 + hd) * 64) * POSN;
    bf16_t* CC = (bf16_t*)(KWS + OFF_HC);
    bf16x8 qf[NMAP][KS];
    const int qrow = qrow0 + 32 * w + r32;
#pragma unroll
    for (int mp = 0; mp < NMAP; ++mp)
#pragma unroll
        for (int s = 0; s < KS; ++s)
            qf[mp][s] = TYPE == 0 ? *(const bf16x8*)(PROJ + (size_t)qrow * INWP + 64 * hd + mp * 32 + 16 * s + 8 * h)
                                  : *(const bf16x8*)(MQ + (size_t)qrow * 384 + 96 * hd + 16 * s + 8 * h);
    float mrun[NMAP], lsum[NMAP]; f32x16 o[NMAP][2];
#pragma unroll
    for (int mp = 0; mp < NMAP; ++mp) { mrun[mp] = 0.f; lsum[mp] = 0.f;
#pragma unroll
        for (int i = 0; i < 16; ++i) { o[mp][0][i] = 0.f; o[mp][1][i] = 0.f; } }
    u32x4 kreg[KCH], vreg[VCH];
    auto gload = [&](int t) {
#pragma unroll
        for (int i = 0; i < KCH; ++i) { const int c = tid + 512 * i, kr = c / CPR, cc = c % CPR; const int grow = pos_row(b, TK * t + kr);
            if (TYPE == 0) kreg[i] = *(const u32x4*)(PROJ + (size_t)grow * INWP + 256 + 64 * hd + 8 * cc);
            else kreg[i] = cc < 8 ? *(const u32x4*)(MK + (size_t)grow * 256 + 64 * hd + 8 * cc) : *(const u32x4*)(PROJ + (size_t)grow * INWP + 1152 + 8 * (cc - 8)); }
#pragma unroll
        for (int i = 0; i < VCH; ++i) { const int c = tid + 512 * i, e = c / VCPR, jc = c % VCPR; vreg[i] = *(const u32x4*)(VTb + (size_t)e * POSN + TK * t + 8 * jc); }
    };
    auto lstore = [&](int buf) {
#pragma unroll
        for (int i = 0; i < KCH; ++i) { const int c = tid + 512 * i, kr = c / CPR, cc = c % CPR; *(u32x4*)(Kl + (size_t)buf * TK * KP + kr * KP + 8 * cc) = kreg[i]; }
#pragma unroll
        for (int i = 0; i < VCH; ++i) { const int c = tid + 512 * i, e = c / VCPR, jc = c % VCPR; *(u32x4*)(Vl + (size_t)buf * 64 * VP + e * VP + 8 * jc) = vreg[i]; }
    };
    const int NTI = NT * 64 / TK;
    gload(0); lstore(0); __syncthreads();
    bool shifted = false;
    for (int t = 0; t < NTI; ++t) {
        const int buf = t & 1;
        if (t + 1 < NTI) gload(t + 1);
        const bf16_t* Kb = Kl + (size_t)buf * TK * KP; const bf16_t* Vb = Vl + (size_t)buf * 64 * VP;
        bf16x8 pbd[2][4];
        f32x16 a0, a1, b0, b1;
        auto kfrag = [&](int st, int half, int s) { return TYPE == 0 ? *(const bf16x8*)(Kb + (32 * half + r32) * KP + st * 32 + 16 * s + 8 * h)
                                                                       : *(const bf16x8*)(Kb + (64 * st + 32 * half + r32) * KP + 16 * s + 8 * h); };
        auto vfrag = [&](int st, int eb, int s) { return *(const bf16x8*)(Vb + (32 * eb + r32) * VP + (TYPE == 0 ? 0 : 64 * st) + 16 * s + 8 * h); };
        auto sub_ref = [&](f32x16& x0, f32x16& x1, int mi) {
            if (__builtin_expect(shifted, 0)) { asm volatile("" ::: "memory");
#pragma unroll
                for (int i = 0; i < 16; ++i) { x0[i] -= mrun[mi]; x1[i] -= mrun[mi]; } } };
        auto pack8 = [&](const f32x16& x, int base) { u32x4 tt; tt.x = pk2(x[base], x[base + 1]); tt.y = pk2(x[base + 2], x[base + 3]); tt.z = pk2(x[base + 4], x[base + 5]); tt.w = pk2(x[base + 6], x[base + 7]); return __builtin_bit_cast(bf16x8, tt); };
        auto slow = [&](int st, f32x16& x0, f32x16& x1, float& ps) {
            const int mi = TYPE == 0 ? st : 0;
#pragma unroll
            for (int i = 0; i < 16; ++i) { x0[i] = 0.f; x1[i] = 0.f; }
#pragma unroll
            for (int s2 = 0; s2 < KS; ++s2) { x0 = MFMA32(kfrag(st, 0, s2), qf[mi][s2], x0); x1 = MFMA32(kfrag(st, 1, s2), qf[mi][s2], x1); }
            sub_ref(x0, x1, mi);
            float tm = fmaxf(x0[0], x1[0]);
#pragma unroll
            for (int i = 1; i < 16; ++i) tm = fmaxf(tm, fmaxf(x0[i], x1[i]));
            tm = fmaxf(tm, __shfl_xor(tm, 32));
            const bool first = (t == 0) && (TYPE == 0 || st == 0);
            const float dl = first ? tm : fmaxf(tm, 0.f);
            mrun[mi] += dl;
            if (!first) { const float alpha = __builtin_amdgcn_exp2f(-dl); lsum[mi] *= alpha;
#pragma unroll
                for (int i = 0; i < 16; ++i) { o[mi][0][i] *= alpha; o[mi][1][i] *= alpha; } }
            ps = 0.f;
#pragma unroll
            for (int i = 0; i < 16; ++i) { x0[i] = __builtin_amdgcn_exp2f(x0[i] - dl); x1[i] = __builtin_amdgcn_exp2f(x1[i] - dl); ps += x0[i] + x1[i]; }
            shifted = true;
        };
        constexpr int M0 = 0, M1 = TYPE == 0 ? 1 : 0;
#pragma unroll
        for (int i = 0; i < 16; ++i) { a0[i] = 0.f; a1[i] = 0.f; b0[i] = 0.f; b1[i] = 0.f; }
#pragma unroll
        for (int s2 = 0; s2 < KS; ++s2) { a0 = MFMA32(kfrag(0, 0, s2), qf[M0][s2], a0); a1 = MFMA32(kfrag(0, 1, s2), qf[M0][s2], a1); }
        sub_ref(a0, a1, M0);
        float psa = 0.f;
#pragma unroll
        for (int n = 0; n < 2 * KS; ++n) {
            if (n & 1) b1 = MFMA32(kfrag(1, 1, n >> 1), qf[M1][n >> 1], b1); else b0 = MFMA32(kfrag(1, 0, n >> 1), qf[M1][n >> 1], b0);
#pragma unroll
            for (int r = (32 * n) / (2 * KS); r < (32 * (n + 1)) / (2 * KS); ++r) {
                if (r < 16) { a0[r] = __builtin_amdgcn_exp2f(a0[r]); psa += a0[r]; } else { a1[r - 16] = __builtin_amdgcn_exp2f(a1[r - 16]); psa += a1[r - 16]; } }
        }
        {   const bool firstA = (t == 0);
            if (__builtin_expect(__any(!(psa <= 1e13f) || (firstA && psa < 1e-13f)), 0)) slow(0, a0, a1, psa); }
        lsum[M0] += psa;
        pbd[0][0] = pack8(a0, 0); pbd[0][1] = pack8(a0, 8); pbd[0][2] = pack8(a1, 0); pbd[0][3] = pack8(a1, 8);
        sub_ref(b0, b1, M1);
        float psb = 0.f;
#pragma unroll
        for (int eb = 0; eb < 2; ++eb)
#pragma unroll
            for (int s2 = 0; s2 < 4; ++s2) {
                o[M0][eb] = MFMA32(vfrag(0, eb, s2), pbd[0][s2], o[M0][eb]);
                const int q4 = (eb * 4 + s2) * 4;
#pragma unroll
                for (int i = 0; i < 4; ++i) { const int r = q4 + i; if (r < 16) { b0[r] = __builtin_amdgcn_exp2f(b0[r]); psb += b0[r]; } else { b1[r - 16] = __builtin_amdgcn_exp2f(b1[r - 16]); psb += b1[r - 16]; } }
            }
        {   const bool firstB = (t == 0) && TYPE == 0;
            if (__builtin_expect(__any(!(psb <= 1e13f) || (firstB && psb < 1e-13f)), 0)) slow(1, b0, b1, psb); }
        lsum[M1] += psb;
        pbd[1][0] = pack8(b0, 0); pbd[1][1] = pack8(b0, 8); pbd[1][2] = pack8(b1, 0); pbd[1][3] = pack8(b1, 8);
#pragma unroll
        for (int eb = 0; eb < 2; ++eb)
#pragma unroll
            for (int s2 = 0; s2 < 4; ++s2) o[M1][eb] = MFMA32(vfrag(1, eb, s2), pbd[1][s2], o[M1][eb]);
        if (t + 1 < NTI) lstore(buf ^ 1);
        __syncthreads();
    }
    float inv[NMAP];
#pragma unroll
    for (int mp = 0; mp < NMAP; ++mp) { const float lt = lsum[mp] + __shfl_xor(lsum[mp], 32); inv[mp] = 1.f / lt; }
    if (TYPE == 1) {
        bf16_t* op = CC + (size_t)qrow * DM + 256 + 64 * hd;
#pragma unroll
        for (int eb = 0; eb < 2; ++eb)
#pragma unroll
            for (int g = 0; g < 4; ++g) { const f32x4 v = {o[0][eb][4 * g] * inv[0], o[0][eb][4 * g + 1] * inv[0], o[0][eb][4 * g + 2] * inv[0], o[0][eb][4 * g + 3] * inv[0]};
                pg8::store4(op + 32 * eb + 8 * g + 4 * h, v); }
    } else {
        int l2 = l; asm volatile("" : "+s"(l2));
        const float* dl = opq2(KIN(I_DLAM)) + l2 * 128; float d1 = 0.f, d2 = 0.f;
        for (int i = 0; i < 32; ++i) { d1 += dl[i] * dl[32 + i]; d2 += dl[64 + i] * dl[96 + i]; }
        float c08 = 0.8f, c06 = 0.6f; asm volatile("" : "+v"(c08), "+v"(c06));
        const float lam_init = c08 - c06 * __expf(-0.3f * (float)l2);
        const float lam = __expf(d1) - __expf(d2) + lam_init;
        const float* sg = opq2(KIN(I_DNORM)) + l2 * 64;
        float ss = 0.f; const float li1 = lam * inv[NMAP - 1];
#pragma unroll
        for (int eb = 0; eb < 2; ++eb)
#pragma unroll
            for (int i = 0; i < 16; ++i) { const float v = o[0][eb][i] * inv[0] - li1 * o[NMAP - 1][eb][i]; o[0][eb][i] = v; ss += v * v; }
        ss += __shfl_xor(ss, 32);
        const float rn = rsqrtf(ss * (1.f / 64.f) + EPS) * (1.f - lam_init);
        bf16_t* op = CC + (size_t)qrow * DM + 64 * hd;
#pragma unroll
        for (int eb = 0; eb < 2; ++eb)
#pragma unroll
            for (int g = 0; g < 4; ++g) { const int e0 = 32 * eb + 8 * g + 4 * h; const f32x4 gg = *(const f32x4*)(sg + e0);
                const f32x4 v = {o[0][eb][4 * g] * rn * gg[0], o[0][eb][4 * g + 1] * rn * gg[1], o[0][eb][4 * g + 2] * rn * gg[2], o[0][eb][4 * g + 3] * rn * gg[3]};
                pg8::store4(op + e0, v); }
    }
}

DI void scan_unit(const Params& p, unsigned char* lds, int l, int mixer, int b, int hd, int item) {
    asm volatile("" : "+s"(l), "+s"(mixer), "+s"(b), "+s"(hd), "+s"(item));
    const int tid = ltid(), dir = tid >> 8, td = tid & 255, lane = tid & 63, wd = (tid >> 6) & 3, r32 = lane & 31, h = lane >> 5;
    unsigned char* L = lds + dir * 55296;
    bf16_t* QT = (bf16_t*)(L);
    bf16_t* KT = (bf16_t*)(L + 5120);
    bf16_t* KH = (bf16_t*)(L + 10240);
    bf16_t* ST = (bf16_t*)(L + 14848);
    bf16_t* VTt = (bf16_t*)(L + 19968);
    bf16_t* SC = (bf16_t*)(L + 29184);
    float* OL = (float*)(L + 19968);
    float* BB = (float*)(L + 38400);
    float* SEG = (float*)(L + 46592);
    float* BEND = (float*)(L + 47616);
    float* WG = (float*)(L + 47744);
    float* GT = (float*)(L + 49920);
    const bf16_t* PROJ = (const bf16_t*)(KWS + OFF_PA);
    bf16_t* CC = (bf16_t*)(KWS + OFF_HC);
    float* OTMP = (float*)(KWS + OFF_Y) + (size_t)item * 68 * 4096;
    const int qcol = (mixer == 0 ? 1184 : 1984) + 32 * hd, kcol = (mixer == 0 ? 1312 : 2112) + 32 * hd, ogcol = (mixer == 0 ? 1696 : 2496) + 64 * hd;
    const int ccol = 512 + 256 * mixer + 64 * hd;
    const bf16_t* VTb = (const bf16_t*)(KWS + OFF_VT) + ((size_t)(((mixer == 0 ? 2 : 3) * NB + b) * 4 + hd) * 64) * POSN;
    const float* og = (mixer == 0 ? KIN(I_GNORM) : KIN(I_RNORM)) + l * 64;
    float lg = 0.f;
    float ogr[16];
#pragma unroll
    for (int i = 0; i < 16; ++i) ogr[i] = og[16 * (td & 3) + i];
    float wg[16], wb = 0.f;
#pragma unroll
    for (int r = 0; r < 16; ++r) wg[r] = 0.f;
    if (mixer == 0) {
        const float* gw = KIN(I_GWG) + (size_t)((l * 2 + dir) * 16) * 128 + 32 * hd + (td & 31);
#pragma unroll
        for (int r = 0; r < 16; ++r) wg[r] = gw[r * 128];
        wb = KIN(I_GBG)[(l * 2 + dir) * 128 + 32 * hd + (td & 31)];
    } else lg = logsig_f(KIN(I_RDEC)[(l * 2 + dir) * 4 + hd]);
    for (int idx = td; idx < 64 * 40; idx += 256) ST[idx] = 0;
    f32x16 Sacc;
#pragma unroll
    for (int i = 0; i < 16; ++i) Sacc[i] = 0.f;
    u32x4 qreg, kreg, vreg0, vreg1, greg;
    auto chunk_of = [&](int s) { return dir == 0 ? s : (s < 4 ? 3 - s : 71 - s); };
    auto chunk_row0 = [&](int g) { return g < 4 ? ML + b * CTXL + 64 * g : b * SEQL + 64 * (g - 4); };
    auto gload = [&](int s) {
        const int g = chunk_of(s), row0 = chunk_row0(g);
        qreg = *(const u32x4*)(PROJ + (size_t)(row0 + (td >> 2)) * INWP + qcol + 8 * (td & 3));
        kreg = *(const u32x4*)(PROJ + (size_t)(row0 + (td >> 2)) * INWP + kcol + 8 * (td & 3));
        vreg0 = *(const u32x4*)(VTb + (size_t)(td >> 3) * POSN + 64 * g + 8 * (td & 7));
        vreg1 = *(const u32x4*)(VTb + (size_t)(32 + (td >> 3)) * POSN + 64 * g + 8 * (td & 7));
        if (mixer == 0 && td < 128) greg = *(const u32x4*)(PROJ + (size_t)(row0 + (td >> 1)) * INWP + 1952 + 16 * dir + 8 * (td & 1));
    };
    gload(0);
    __syncthreads();
    for (int s = 0; s < 68; ++s) {
        const int g = chunk_of(s), row0 = chunk_row0(g);
        *(u32x4*)(VTt + (td >> 3) * 72 + 8 * (td & 7)) = vreg0;
        *(u32x4*)(VTt + (32 + (td >> 3)) * 72 + 8 * (td & 7)) = vreg1;
        if (mixer == 0 && td < 128) { float* gp = GT + (td >> 1) * 16 + 8 * (td & 1);
            gp[0] = bflo(greg.x); gp[1] = bfhi(greg.x); gp[2] = bflo(greg.y); gp[3] = bfhi(greg.y); gp[4] = bflo(greg.z); gp[5] = bfhi(greg.z); gp[6] = bflo(greg.w); gp[7] = bfhi(greg.w); }
        const u32x4 qc = qreg, kc = kreg;
        if (s + 1 < 68) gload(s + 1);
        const int s_other = dir == 0 ? (g < 4 ? 3 - g : 71 - g) : g;
        const bool fin = s_other < s;
        float* ot = OTMP + (size_t)g * 4096 + (td >> 2) * 64 + 16 * (td & 3);
        f32x4 pf0, pf1, pf2, pf3; u32x4 g0, g1;
        LBAR();
        { const int d = td & 31, seg = td >> 5; float a[8];
          if (mixer == 0) {
#pragma unroll
              for (int i = 0; i < 8; ++i) { const float* gr = GT + (8 * seg + i) * 16;
                  const f32x4 x0 = *(const f32x4*)gr, x1 = *(const f32x4*)(gr + 4), x2 = *(const f32x4*)(gr + 8), x3 = *(const f32x4*)(gr + 12);
                  float acc = wb;
                  acc += x0[0] * wg[0]; acc += x0[1] * wg[1]; acc += x0[2] * wg[2]; acc += x0[3] * wg[3];
                  acc += x1[0] * wg[4]; acc += x1[1] * wg[5]; acc += x1[2] * wg[6]; acc += x1[3] * wg[7];
                  acc += x2[0] * wg[8]; acc += x2[1] * wg[9]; acc += x2[2] * wg[10]; acc += x2[3] * wg[11];
                  acc += x3[0] * wg[12]; acc += x3[1] * wg[13]; acc += x3[2] * wg[14]; acc += x3[3] * wg[15];
                  a[i] = logsig_f(acc) * (1.f / 16.f); }
          } else {
#pragma unroll
              for (int i = 0; i < 8; ++i) a[i] = lg;
          }
          float run = 0.f;
          if (dir == 0) {
#pragma unroll
              for (int i = 0; i < 8; ++i) { run += a[i]; a[i] = run; }
          } else {
#pragma unroll
              for (int i = 7; i >= 0; --i) { run += a[i]; a[i] = run; }
          }
          SEG[seg * 32 + d] = run;
          LBAR();
          float off = 0.f, tot = 0.f;
#pragma unroll
          for (int s2 = 0; s2 < 8; ++s2) { const float sv = SEG[s2 * 32 + d]; tot += sv; if (dir == 0 ? (s2 < seg) : (s2 > seg)) off += sv; }
#pragma unroll
          for (int i = 0; i < 8; ++i) BB[(8 * seg + i) * 32 + d] = a[i] + off;
          if (seg == 0) { BEND[d] = tot; BEND[32 + d] = __expf(tot); } }
        LBAR();
        { const int j = td >> 2, cc = td & 3;
          float qv[8] = {bflo(qc.x), bfhi(qc.x), bflo(qc.y), bfhi(qc.y), bflo(qc.z), bfhi(qc.z), bflo(qc.w), bfhi(qc.w)};
          float kv[8] = {bflo(kc.x), bfhi(kc.x), bflo(kc.y), bfhi(kc.y), bflo(kc.z), bfhi(kc.z), bflo(kc.w), bfhi(kc.w)};
          float k1[8];
#pragma unroll
          for (int i = 0; i < 8; ++i) { const int d = 8 * cc + i; const float bv = BB[j * 32 + d], ee = BEND[32 + d];
              const float eb = __expf(bv), en = __builtin_amdgcn_rcpf(eb); qv[i] *= eb; k1[i] = kv[i] * en; KH[d * 72 + ((j & ~12) | ((j & 4) << 1) | ((j & 8) >> 1))] = (bf16_t)f2bf(kv[i] * (ee * en)); }
          u32x4 wq, wk; wq.x = pk2(qv[0], qv[1]); wq.y = pk2(qv[2], qv[3]); wq.z = pk2(qv[4], qv[5]); wq.w = pk2(qv[6], qv[7]);
          wk.x = pk2(k1[0], k1[1]); wk.y = pk2(k1[2], k1[3]); wk.z = pk2(k1[4], k1[5]); wk.w = pk2(k1[6], k1[7]);
          *(u32x4*)(QT + j * 40 + 8 * cc) = wq; *(u32x4*)(KT + j * 40 + 8 * cc) = wk; }
        __syncthreads();
        if (fin) { pf0 = *(const f32x4*)(ot); pf1 = *(const f32x4*)(ot + 4); pf2 = *(const f32x4*)(ot + 8); pf3 = *(const f32x4*)(ot + 12);
            const bf16_t* gp = PROJ + (size_t)(row0 + (td >> 2)) * INWP + ogcol + 16 * (td & 3); g0 = *(const u32x4*)gp; g1 = *(const u32x4*)(gp + 8); }
        { const int jb = wd >> 1, ib = wd & 1; const bool skip = dir == 0 ? (jb > ib) : (jb < ib);
          f32x16 pa;
#pragma unroll
          for (int i = 0; i < 16; ++i) pa[i] = 0.f;
          if (!skip) {
#pragma unroll
              for (int s2 = 0; s2 < 2; ++s2) { const bf16x8 a = *(const bf16x8*)(KT + (32 * jb + r32) * 40 + 16 * s2 + 8 * h), bq = *(const bf16x8*)(QT + (32 * ib + r32) * 40 + 16 * s2 + 8 * h);
                  pa = MFMA32(a, bq, pa); }
          }
          const int itok = 32 * ib + r32;
#pragma unroll
          for (int gq = 0; gq < 4; ++gq) { f32x4 v;
#pragma unroll
              for (int i = 0; i < 4; ++i) { const int j = 32 * jb + 8 * gq + 4 * h + i; const bool keep = dir == 0 ? (j <= itok) : (j >= itok); v[i] = keep ? pa[4 * gq + i] : 0.f; }
              pg8::store4(SC + itok * 72 + 32 * jb + 16 * (gq >> 1) + 8 * h + 4 * (gq & 1), v); } }
        LBAR();
        f32x16 oacc;
        { const int eb = wd >> 1, ib = wd & 1;
#pragma unroll
          for (int i = 0; i < 16; ++i) oacc[i] = 0.f;
#pragma unroll
          for (int s2 = 0; s2 < 4; ++s2) { const bf16x8 a = *(const bf16x8*)(VTt + (32 * eb + r32) * 72 + 16 * s2 + 8 * h), bb = *(const bf16x8*)(SC + (32 * ib + r32) * 72 + 16 * s2 + 8 * h);
              oacc = MFMA32(a, bb, oacc); }
#pragma unroll
          for (int s2 = 0; s2 < 2; ++s2) { const bf16x8 a = *(const bf16x8*)(ST + (32 * eb + r32) * 40 + 16 * s2 + 8 * h), bb = *(const bf16x8*)(QT + (32 * ib + r32) * 40 + 16 * s2 + 8 * h);
              oacc = MFMA32(a, bb, oacc); }
          if (wd < 2) { const float dec = BEND[32 + r32];
#pragma unroll
              for (int i = 0; i < 16; ++i) Sacc[i] *= dec;
#pragma unroll
              for (int s2 = 0; s2 < 4; ++s2) { const bf16x8 a = *(const bf16x8*)(VTt + (32 * wd + r32) * 72 + 16 * s2 + 8 * h), bb = *(const bf16x8*)(KH + r32 * 72 + 16 * s2 + 8 * h);
                  Sacc = MFMA32(a, bb, Sacc); } } }
        LBAR();
        { const int eb = wd >> 1, ib = wd & 1;
#pragma unroll
          for (int gq = 0; gq < 4; ++gq) *(f32x4*)(OL + (32 * ib + r32) * 68 + 32 * eb + 8 * gq + 4 * h) = (f32x4){oacc[4 * gq], oacc[4 * gq + 1], oacc[4 * gq + 2], oacc[4 * gq + 3]};
          if (wd < 2) {
#pragma unroll
              for (int i = 0; i < 16; ++i) ST[(32 * wd + crow(i, h)) * 40 + r32] = (bf16_t)f2bf(Sacc[i]); } }
        LBAR();
        { const int j = td >> 2, e0 = 16 * (td & 3); float ov[16];
#pragma unroll
          for (int q4 = 0; q4 < 4; ++q4) { const f32x4 v = *(const f32x4*)(OL + j * 68 + e0 + 4 * q4); ov[4 * q4] = v[0]; ov[4 * q4 + 1] = v[1]; ov[4 * q4 + 2] = v[2]; ov[4 * q4 + 3] = v[3]; }
          if (fin) {
              float ss = 0.f;
              const float pv[16] = {pf0[0], pf0[1], pf0[2], pf0[3], pf1[0], pf1[1], pf1[2], pf1[3], pf2[0], pf2[1], pf2[2], pf2[3], pf3[0], pf3[1], pf3[2], pf3[3]};
#pragma unroll
              for (int i = 0; i < 16; ++i) { ov[i] += pv[i]; ss += ov[i] * ov[i]; }
              ss += __shfl_xor(ss, 1); ss += __shfl_xor(ss, 2);
              const float rn = rsqrtf(ss * (1.f / 64.f) + EPS);
              const int row = row0 + j;
              const float gv[16] = {bflo(g0.x), bfhi(g0.x), bflo(g0.y), bfhi(g0.y), bflo(g0.z), bfhi(g0.z), bflo(g0.w), bfhi(g0.w),
                                    bflo(g1.x), bfhi(g1.x), bflo(g1.y), bfhi(g1.y), bflo(g1.z), bfhi(g1.z), bflo(g1.w), bfhi(g1.w)};
              float r[16];
#pragma unroll
              for (int i = 0; i < 16; ++i) r[i] = ov[i] * rn * ogr[i] * silu_f(gv[i]);
              u32x4 w0, w1; w0.x = pk2(r[0], r[1]); w0.y = pk2(r[2], r[3]); w0.z = pk2(r[4], r[5]); w0.w = pk2(r[6], r[7]);
              w1.x = pk2(r[8], r[9]); w1.y = pk2(r[10], r[11]); w1.z = pk2(r[12], r[13]); w1.w = pk2(r[14], r[15]);
              *(u32x4*)(CC + (size_t)row * DM + ccol + e0) = w0; *(u32x4*)(CC + (size_t)row * DM + ccol + e0 + 8) = w1;
          } else {
#pragma unroll
              for (int q4 = 0; q4 < 4; ++q4) *(f32x4*)(ot + 4 * q4) = (f32x4){ov[4 * q4], ov[4 * q4 + 1], ov[4 * q4 + 2], ov[4 * q4 + 3]};
          } }
        LBAR();
    }
    __syncthreads();
}

DI void mixer_phase(const Params& p, unsigned char* lds, int l, int rep) {
    asm volatile("" : "+s"(l));
    const int tid = ltid();
    unsigned* ctr = (unsigned*)(KWS + OFF_CTL) + 64 * (l + 1 + 4 * rep);
    volatile int* s_item = (volatile int*)(lds + LDS_CTL_OFF);
    const bool with_ctx = l < NLAYER - 1;
    const int nitems = 64 + 1024 + (with_ctx ? 64 : 0);
    for (;;) {
        if (tid == 0) *s_item = (int)atomicAdd(ctr, 1u);
        __syncthreads();
        const int it = __builtin_amdgcn_readfirstlane(*s_item);
        __syncthreads();
        if (it >= nitems) break;
        if (rep > 0 && ((REP_MIX_ONLY == 1 && it >= 64) || (REP_MIX_ONLY == 2 && it < 64))) continue;
        if (it < 64) { if (PH(11)) scan_unit(p, lds, l, it >> 5, (it >> 2) & 7, it & 3, it); }
        else { int type, b, hd, qrow0, NT;
            if (it < 64 + 1024) { const int u = it - 64, rem = u & 511, qb = rem & 15; type = u >> 9; b = rem >> 6; hd = (rem >> 4) & 3; qrow0 = b * SEQL + 256 * qb; NT = POSN / 64; }
            else { const int u = it - 1088; type = u >> 5; b = (u >> 2) & 7; hd = u & 3; qrow0 = ML + b * CTXL; NT = CTXL / 64; }
            if (type == 0) { if (PH(12)) attn_unit<0>(p, lds, l, b, hd, qrow0, NT); } else { if (PH(13)) attn_unit<1>(p, lds, l, b, hd, qrow0, NT); } }
    }
}

#define LAS __attribute__((address_space(3)))
#define XB_TMO      128
#define XB_XCNT(j)  (256  + 64 * (j))
#define XB_XSUB(j)  (1280 + 64 * (j))
#define XB_XGEN(j)  (2304 + 64 * (j))
#define XB_TOP      3328
#define XB_TOPGEN   3392
#define XCD_BAR_WORDS 3456
#define XB_SPIN_CAP (1u << 18)

__device__ __forceinline__ unsigned xb_ld(unsigned* p)              { return __hip_atomic_load(p, __ATOMIC_RELAXED, __HIP_MEMORY_SCOPE_AGENT); }
__device__ __forceinline__ unsigned xb_add(unsigned* p, unsigned v) { return __hip_atomic_fetch_add(p, v, __ATOMIC_RELAXED, __HIP_MEMORY_SCOPE_AGENT); }
__device__ __forceinline__ unsigned xb_xcc_id() { return (unsigned)__builtin_amdgcn_s_getreg((3 << 11) | 20) & 0xFu; }
#define XB_SPIN(cond, bar) do { unsigned _sp = 0; while (cond) { __builtin_amdgcn_s_sleep(1); \
    if ((++_sp & 255u) == 0u) { if (xb_ld(&(bar)[XB_TMO])) break; if (_sp > XB_SPIN_CAP) { atomicAdd(&(bar)[XB_TMO], 1u); break; } } } } while (0)

struct XcdBarrier {
    unsigned* bar; unsigned x;
    volatile LAS unsigned* st;
};

__device__ __forceinline__ XcdBarrier xcd_barrier_post(unsigned* bar, volatile LAS unsigned* st) {
    XcdBarrier b; b.bar = bar; b.x = xb_xcc_id(); b.st = st;
    if (threadIdx.x == 0) (void)xb_add(&bar[XB_XCNT(b.x)], 1u);
    return b;
}
__device__ __forceinline__ void xcd_barrier_complete(unsigned* bar, unsigned x, unsigned& nloc, unsigned& nx) {
    const unsigned G = gridDim.x * gridDim.y * gridDim.z;
    unsigned sum, cnt, mine, sp = 0u;
    for (;;) {
        sum = 0u; cnt = 0u; mine = 0u;
#pragma unroll
        for (unsigned j = 0; j < 16; ++j) { const unsigned c = xb_ld(&bar[XB_XCNT(j)]); sum += c; cnt += (c > 0u) ? 1u : 0u; mine = (j == x) ? c : mine; }
        if (sum == G) break;
        __builtin_amdgcn_s_sleep(1);
        if ((++sp & 255u) == 0u) { if (xb_ld(&bar[XB_TMO])) break; if (sp > XB_SPIN_CAP) { atomicAdd(&bar[XB_TMO], 1u); break; } }
    }
    nloc = mine > 0u ? mine : 1u; nx = cnt > 0u ? cnt : 1u;
}

__device__ __forceinline__ void xcd_barrier(const XcdBarrier& b) {
    asm volatile("s_waitcnt vmcnt(0)" ::: "memory");
    __syncthreads();
    if (threadIdx.x == 0) {
        unsigned* bar = b.bar;
        __builtin_amdgcn_s_waitcnt(0);
        unsigned nloc = b.st[0], nx = b.st[1];
        if (nloc == 0u) { xcd_barrier_complete(bar, b.x, nloc, nx); b.st[0] = nloc; b.st[1] = nx; }
        const unsigned old = xb_add(&bar[XB_XSUB(b.x)], 1u);
        const unsigned gen = old / nloc;
        if (old + 1u == (gen + 1u) * nloc) {
            __builtin_amdgcn_fence(__ATOMIC_RELEASE, "agent");
            asm volatile("s_waitcnt vmcnt(0)" ::: "memory");
            const unsigned og = xb_add(&bar[XB_TOP], 1u);
            const unsigned tg = og / nx;
            if (og + 1u == (tg + 1u) * nx) xb_add(&bar[XB_TOPGEN], 1u);
            else XB_SPIN(xb_ld(&bar[XB_TOPGEN]) == tg, bar);
            __builtin_amdgcn_fence(__ATOMIC_ACQUIRE, "agent");
            xb_add(&bar[XB_XGEN(b.x)], 1u);
            asm volatile("s_waitcnt vmcnt(0)" ::: "memory");
        } else {
            XB_SPIN(xb_ld(&bar[XB_XGEN(b.x)]) == gen, bar);
            __builtin_amdgcn_fence(__ATOMIC_ACQUIRE, "agent");
            asm volatile("s_waitcnt vmcnt(0)" ::: "memory");
        }
    }
    __syncthreads();
}

template <class T> DI T* opq(T* q) { asm volatile("" : "+s"(q)); return q; }
__global__ void __launch_bounds__(512, 2) mega(Params p) {
    extern __shared__ __attribute__((aligned(16))) unsigned char lds[];
    cg::grid_group grid = cg::this_grid();
    { volatile LAS unsigned* z = (volatile LAS unsigned*)((LAS unsigned char*)lds + LDS_CTL_OFF); if (threadIdx.x < 16) z[threadIdx.x] = 0u; }
    __syncthreads();
#if USE_CG_SYNC
#define GSYNC() grid.sync()
#else
#define GSYNC() xcd_barrier(xbar)
#endif
    PG8_LAS unsigned char* lds3 = (PG8_LAS unsigned char*)lds;
    const int G = gridDim.x, c = blockIdx.x;
#define WSB(off) (opq(KWS) + (off))
#define WGT(off) ((bf16_t*)(opq(KWS) + OFF_W + (off)))

    if (PH(0)) phase0(p, lds);
    grid.sync();
    const XcdBarrier xbar = xcd_barrier_post((unsigned*)(KWS + OFF_BAR), (volatile LAS unsigned*)((LAS unsigned char*)lds + LDS_CTL_OFF + 32));
#pragma unroll 1
    for (int l = 0; l < NLAYER; ++l) {
        const bool with_ctx = l < NLAYER - 1;
        const int Mrows = with_ctx ? MT : ML;
        if (PH(1)) {
            const float* ng = opq(KIN(I_NORMG)) + (size_t)l * 4 * DM; const float* MODS = (const float*)WSB(OFF_MODS); const float* ml = MODS + (size_t)l * 9 * 6144;
            bf16_t* HC = (bf16_t*)WSB(OFF_HC); float* XC = (float*)WSB(OFF_XCTX); float* outp = opq(KOUT);
            if (l == 0) rowpass(0, MT, c, G, KIN(I_X), KIN(I_CTX), nullptr, nullptr, nullptr, nullptr, nullptr, HC, ng, ml, ml + 1024);
            else {
                if (c < 32) { pg8::Gemm g{(const bf16_t*)WSB(OFF_PA) + (size_t)ML * FFH, WGT(W_F2), MC, DM, FFH, FFH}; pg8::StaticOrder S; S.init(MC, DM, G, c);
                    pg8::EpiY E{(bf16_t*)WSB(OFF_Y) + (size_t)ML * DM, DM};
                    pg8::gemm_phase<pg8::EpiY, pg8::StaticOrder, true, true>(lds3, g, S, E); }
                else { rowpass(0, ML, c - 32, G - 32, outp, XC, outp, XC, (const bf16_t*)WSB(OFF_Y), MODS + (size_t)(l - 1) * 9 * 6144 + 5 * 1024, ng - DM, HC, ng, ml, ml + 1024);
                    if (PH(2)) convert_weights(p, l, lds, 1, c - 32, G - 32); }
                GSYNC();
                rowpass(ML, MT, c, G, outp, XC, outp, XC, (const bf16_t*)WSB(OFF_Y), MODS + (size_t)(l - 1) * 9 * 6144 + 5 * 1024, ng - DM, HC, ng, ml, ml + 1024);
            }
        }
        for (int rep = 0; rep < REP_CONV; ++rep) { if (PH(2)) convert_weights(p, l, lds, l == 0 ? 3 : 2, c, G); }
        for (int rep = 0; rep < REP_RP0; ++rep) { const float* ng = opq(KIN(I_NORMG)); const float* ml = (const float*)WSB(OFF_MODS); rowpass(0, MT, c, G, KIN(I_X), KIN(I_CTX), nullptr, nullptr, nullptr, nullptr, nullptr, (bf16_t*)WSB(OFF_Y), ng, ml, ml + 1024); }
        GSYNC();
        for (int rep = 0; rep < REP_SYNC; ++rep) GSYNC();
        for (int rep = 0; rep < REP_G3; ++rep) { if (rep) GSYNC();
        if (PH(3)) { pg8::Gemm g{(const bf16_t*)WSB(OFF_HC), WGT(W_IN), MT, INWP, DM, DM}; pg8::StaticOrder S; S.init(MT, INWP, G, c);
          const float* rc = (const float*)WSB(OFF_ROPE);
          pg8::EpiProj E{(bf16_t*)WSB(OFF_PA), (bf16_t*)WSB(OFF_VT), (float*)WSB(OFF_STQ), (float*)WSB(OFF_STKV), rc, rc + 4096 * 16, lds + LDS_CTL_OFF + 256};
          pg8::gemm_phase<pg8::EpiProj, pg8::StaticOrder, true, true>(lds3, g, S, E); } }
        GSYNC();
        for (int rep = 0; rep < REP_C; ++rep) {
        if (PH(4)) { int Kq = 256; asm volatile("" : "+s"(Kq)); pg8::Gemm g{(const bf16_t*)WSB(OFF_PA) + 768, WGT(W_UQ), MT, 512, Kq, INWP}; pg8::StaticOrder S; S.init(MT, 512, G, c);
          const float* rc = (const float*)WSB(OFF_ROPE);
          pg8::EpiUpQ E{(bf16_t*)WSB(OFF_MLAQ), (const float*)WSB(OFF_STQ), rc, rc + 4096 * 16};
          pg8::gemm_phase<pg8::EpiUpQ, pg8::StaticOrder, true, true>(lds3, g, S, E); }
        if (PH(5)) { int Kq = 128; asm volatile("" : "+s"(Kq)); pg8::Gemm g{(const bf16_t*)WSB(OFF_PA) + 1024, WGT(W_UKV), MT, 512, Kq, INWP}; pg8::StaticOrder S; S.init(MT, 512, G, (c + G / 2) % G);
          pg8::EpiUpKV E{(bf16_t*)WSB(OFF_MLAK), (bf16_t*)WSB(OFF_VT), (const float*)WSB(OFF_STKV), lds + LDS_CTL_OFF + 256};
          pg8::gemm_phase<pg8::EpiUpKV, pg8::StaticOrder, true, true>(lds3, g, S, E); }
        GSYNC(); }
        for (int rep = 0; rep < REP_MIX; ++rep) { if (PH(6)) mixer_phase(p, lds, l, rep); GSYNC(); }
        for (int rep = 0; rep < REP_G7; ++rep) { if (rep) GSYNC();
        if (PH(7)) { pg8::Gemm g{(const bf16_t*)WSB(OFF_HC), WGT(W_OUT), Mrows, DM, DM, DM}; pg8::StaticOrder S; S.init(Mrows, DM, G, c);
          pg8::EpiY E{(bf16_t*)WSB(OFF_Y), DM};
          pg8::gemm_phase<pg8::EpiY, pg8::StaticOrder, true, true>(lds3, g, S, E); } }
        GSYNC();
        if (PH(8)) {
            const float* ng = opq(KIN(I_NORMG)) + (size_t)l * 4 * DM; const float* ml = (const float*)WSB(OFF_MODS) + (size_t)l * 9 * 6144;
            float* XC = (float*)WSB(OFF_XCTX); float* outp = opq(KOUT);
            rowpass(0, Mrows, c, G, l == 0 ? KIN(I_X) : outp, l == 0 ? KIN(I_CTX) : XC, outp, XC, (const bf16_t*)WSB(OFF_Y), ml + 2 * 1024, ng + DM, (bf16_t*)WSB(OFF_HC), ng + 2 * DM, ml + 3 * 1024, ml + 4 * 1024);
        }
        GSYNC();
        for (int rep = 0; rep < REP_G9; ++rep) { if (rep) GSYNC();
        if (PH(9)) { pg8::Gemm g{(const bf16_t*)WSB(OFF_HC), WGT(W_F1), Mrows, 2 * FFH, DM, DM}; pg8::StaticOrder S; S.init(Mrows, 2 * FFH, G, c);
          pg8::EpiSwiglu E{(bf16_t*)WSB(OFF_PA)};
          pg8::gemm_phase<pg8::EpiSwiglu, pg8::StaticOrder, true, true>(lds3, g, S, E); } }
        GSYNC();
        for (int rep = 0; rep < REP_G10; ++rep) { if (rep) GSYNC();
        if (PH(10)) { pg8::Gemm g{(const bf16_t*)WSB(OFF_PA), WGT(W_F2), ML, DM, FFH, FFH}; pg8::StaticOrder S; S.init(ML, DM, G, c);
          pg8::EpiY E{(bf16_t*)WSB(OFF_Y), DM};
          pg8::gemm_phase<pg8::EpiY, pg8::StaticOrder, true, true>(lds3, g, S, E); } }
        GSYNC();
    }
    { float* XC = (float*)WSB(OFF_XCTX); float* outp = opq(KOUT);
      rowpass(0, ML, c, G, outp, XC, outp, XC, (const bf16_t*)WSB(OFF_Y), (const float*)WSB(OFF_MODS) + (size_t)3 * 9 * 6144 + 5 * 1024, KIN(I_NORMG) + (size_t)3 * 4 * DM + 3 * DM, nullptr, nullptr, nullptr, nullptr); }
}

extern "C" void kernel_launch(void* const* d_in, const int* in_sizes, int n_in, void* d_out, int out_size, void* d_ws, size_t ws_size, hipStream_t stream) {
    static int grid_blocks = 0;
    if (!grid_blocks) {
        if (n_in != 22 || ws_size < WS_END2) { fprintf(stderr, "kernel_launch: unexpected n_in %d or ws_size %zu (need %zu)\n", n_in, ws_size, (size_t)WS_END2); grid_blocks = -1; return; }
        int dev = 0, cus = 0, per_cu = 0;
        (void)hipGetDevice(&dev);
        (void)hipDeviceGetAttribute(&cus, hipDeviceAttributeMultiprocessorCount, dev);
        (void)hipFuncSetAttribute((const void*)mega, hipFuncAttributeMaxDynamicSharedMemorySize, LDS_BYTES);
        (void)hipOccupancyMaxActiveBlocksPerMultiprocessor(&per_cu, (const void*)mega, 512, LDS_BYTES);
        if (per_cu < 1) per_cu = 1;
        grid_blocks = cus * per_cu;
    }
    if (grid_blocks < 0) return;
    Params p{};
    for (int i = 0; i < 22; ++i) p.in[i] = (const float*)d_in[i];
    p.out = (float*)d_out; p.ws = (unsigned char*)d_ws;
    void* args[] = {&p};
    hipError_t e = hipLaunchCooperativeKernel((const void*)mega, dim3(grid_blocks), dim3(512), args, LDS_BYTES, stream);
    if (e != hipSuccess) fprintf(stderr, "cooperative launch failed: %s (grid %d)\n", hipGetErrorString(e), grid_blocks);
}
```

```cpp
#include <hip/hip_runtime.h>
#include <hip/hip_cooperative_groups.h>
#include <cstdio>
#include <cstdint>
namespace cg = cooperative_groups;
namespace pg8 {
#define PG8_LAS __attribute__((address_space(3)))
typedef unsigned short bf16_t;
typedef short bf16x8 __attribute__((ext_vector_type(8)));
typedef float f32x4 __attribute__((ext_vector_type(4)));
typedef unsigned u32x4 __attribute__((ext_vector_type(4)));
constexpr int BM = 256, BK = 64, HALF = 128, HTB = HALF * BK * 2  , STAGE_BYTES = 8 * HTB, NXCD = 8, WGM = 8;

__host__ __device__ __forceinline__ int lds_byte(int r, int c) { const int st = (r >> 4) * 2 + (c >> 5), rr = r & 15, cc = c & 31, ob = rr * 64 + cc * 2; return st * 1024 + (ob ^ (((ob >> 9) & 1) << 5)); }
__host__ __device__ __forceinline__ void stage_rc(int b, int& R, int& C) { const int st = b / 1024, sb = b % 1024, swz = sb ^ (((sb >> 9) & 1) << 5); R = (st >> 1) * 16 + swz / 64; C = (st & 1) * 32 + (swz % 64) / 2; }
__host__ __device__ __forceinline__ int perm32(int rho) { const int n = rho >> 4, i = rho & 15; return 8 * (i >> 2) + 4 * n + (i & 3); }

struct Unit { int pm, pn; };
struct Gemm { const bf16_t* A; const bf16_t* Bt; int M, N, K, lda; };

struct StaticOrder {
    int nM, nN, nwg, G, c;
    __host__ __device__ void init(int M, int N, int G_, int c_) { nM = M / BM; nN = N / BM; nwg = nM * nN; G = G_; c = c_; }
    __host__ __device__ bool next(int i, Unit& u) const {
        const long L = (long)i * G + c; if (L >= nwg) return false;
        int wgid = (int)L; { const int q = nwg / NXCD, r = nwg % NXCD, xcd = wgid % NXCD, off = wgid / NXCD; wgid = (xcd < r ? xcd * (q + 1) : r * (q + 1) + (xcd - r) * q) + off; }
        const int nig = WGM * nN, gid = wgid / nig, fm = gid * WGM, gsz = (nM - fm) < WGM ? (nM - fm) : WGM;
        u.pm = fm + ((wgid % nig) % gsz); u.pn = (wgid % nig) / gsz; return true;
    }
    __device__ __forceinline__ void a_ready(const Unit&) const {}
    __device__ __forceinline__ void done(const Unit&) const {}
};

__device__ __forceinline__ unsigned cvt_pk_bf16(float lo, float hi) { unsigned r; asm volatile("v_cvt_pk_bf16_f32 %0, %1, %2" : "=v"(r) : "v"(lo), "v"(hi)); return r; }
typedef float f32x2 __attribute__((ext_vector_type(2)));
template <class Epi, class Sched, bool ALIGN_EPI = false, bool SP2 = false>
__device__ __forceinline__ void gemm_phase(PG8_LAS unsigned char* lds, const Gemm g, const Sched& S, const Epi& E) {
    int tid_ = threadIdx.x; asm volatile("" : "+v"(tid_)); const int tid = tid_, wid = __builtin_amdgcn_readfirstlane(tid >> 6), lane = tid & 63, wr = wid >> 2, wc = wid & 3, fr = lane & 15, fq = lane >> 4;
    const int K = g.K, nt = K / BK;
    unsigned voffA[2], voffB[2];
#pragma unroll
    for (int i = 0; i < 2; ++i) { int R, C; stage_rc(tid * 16 + i * 8192, R, C); const int Rb = Epi::PERM ? ((R & ~31) + perm32(R & 31)) : R;
        voffA[i] = (unsigned)(R * g.lda + C) * 2u; voffB[i] = (unsigned)(Rb * K + C) * 2u; }
    const size_t kstep = (size_t)(BK * 2);
    const size_t hstepB = (size_t)HALF * K * 2, hstepA = (size_t)HALF * g.lda * 2;
    const size_t tstepB = 2 * hstepB, tstepA = 2 * hstepA;
    const unsigned ldsw = (unsigned)wid * 1024u;
    const int aoff = lds_byte(wr * 64 + fr, fq * 8), boff = lds_byte(wc * 32 + fr, fq * 8);
#define PG8_SA(b, h) (((b) * 2 + (h)) * HTB)
#define PG8_SB(b, h) ((4 + (b) * 2 + (h)) * HTB)
#define PG8_STAGE(bufoff, gbase, voff) do { _Pragma("unroll") for (int _i = 0; _i < 2; ++_i) \
        __builtin_amdgcn_global_load_lds((const unsigned*)((const char*)(gbase) + (voff)[_i]), (PG8_LAS unsigned*)(lds + (bufoff) + ldsw + _i * 8192), 16, 0, 0); } while (0)
#define PG8_LDA(dst, b, h) do { _Pragma("unroll") for (int m = 0; m < 4; ++m) _Pragma("unroll") for (int k = 0; k < 2; ++k) dst[m][k] = *(const PG8_LAS bf16x8*)(lds + PG8_SA(b, h) + aoff + m * 2048 + k * 1024); } while (0)
#define PG8_LDB(dst, b, h) do { _Pragma("unroll") for (int n = 0; n < 2; ++n) _Pragma("unroll") for (int k = 0; k < 2; ++k) dst[n][k] = *(const PG8_LAS bf16x8*)(lds + PG8_SB(b, h) + boff + n * 2048 + k * 1024); } while (0)
#define PG8_MMA(ai, bj, At, Bt) do { __builtin_amdgcn_s_setprio(1); _Pragma("unroll") for (int m = 0; m < 4; ++m) _Pragma("unroll") for (int n = 0; n < 2; ++n) _Pragma("unroll") for (int k = 0; k < 2; ++k) \
        acc[ai][bj][m][n] = __builtin_amdgcn_mfma_f32_16x16x32_bf16(Bt[n][k], At[m][k], acc[ai][bj][m][n], 0, 0, 0); __builtin_amdgcn_s_setprio(0); } while (0)
#define PG8_WAIT_V(n) asm volatile("s_waitcnt vmcnt(" #n ")" ::: "memory")
#define PG8_WAIT_L(n) asm volatile("s_waitcnt lgkmcnt(" #n ")" ::: "memory")
#define PG8_BAR __builtin_amdgcn_s_barrier()
#define PG8_SCHED __builtin_amdgcn_sched_barrier(0)
    Unit cur, nxt; int ui = 0;
    if (!S.next(0, cur)) return;
    f32x4 acc[2][2][4][2];
#pragma unroll
    for (int a = 0; a < 2; ++a)
#pragma unroll
        for (int b = 0; b < 2; ++b)
#pragma unroll
            for (int m = 0; m < 4; ++m)
#pragma unroll
                for (int n = 0; n < 2; ++n) acc[a][b][m][n] = (f32x4){0.f, 0.f, 0.f, 0.f};
    bf16x8 At[4][2], B0[2][2], B1[2][2];
    const char* cA = (const char*)g.A + (size_t)cur.pm * tstepA; const char* cB = (const char*)g.Bt + (size_t)cur.pn * tstepB;
    S.a_ready(cur);
    if constexpr (SP2) {
        PG8_STAGE(PG8_SB(0, 0), cB, voffB); PG8_STAGE(PG8_SB(0, 1), cB + hstepB, voffB); PG8_STAGE(PG8_SA(0, 0), cA, voffA); PG8_STAGE(PG8_SA(0, 1), cA + hstepA, voffA);
        if (wr == 1) PG8_BAR;
        PG8_WAIT_V(2); PG8_BAR;
        PG8_STAGE(PG8_SB(1, 0), cB + kstep, voffB); PG8_STAGE(PG8_SA(1, 0), cA + kstep, voffA); PG8_STAGE(PG8_SB(1, 1), cB + hstepB + kstep, voffB);
        PG8_WAIT_V(6); PG8_BAR;
    } else {
        PG8_STAGE(PG8_SB(0, 0), cB, voffB); PG8_STAGE(PG8_SA(0, 0), cA, voffA); PG8_STAGE(PG8_SB(0, 1), cB + hstepB, voffB); PG8_STAGE(PG8_SA(0, 1), cA + hstepA, voffA);
        if (wr == 1) PG8_BAR;
        PG8_WAIT_V(4); PG8_BAR;
        PG8_STAGE(PG8_SB(1, 0), cB + kstep, voffB); PG8_STAGE(PG8_SA(1, 0), cA + kstep, voffA); PG8_STAGE(PG8_SB(1, 1), cB + hstepB + kstep, voffB);
        PG8_WAIT_V(6); PG8_BAR;
    }
    for (;;) {
        const bool has_next = S.next(ui + 1, nxt);
        const char* nA = has_next ? (const char*)g.A + (size_t)nxt.pm * tstepA : cA; const char* nB = has_next ? (const char*)g.Bt + (size_t)nxt.pn * tstepB : cB;
        for (int t = 0; t < nt; t += 2) {
            const bool last = (t == nt - 2);
            const char* a1 = cA + (size_t)(t + 1) * kstep;
            const char* a2 = last ? nA : cA + (size_t)(t + 2) * kstep; const char* b2 = last ? nB : cB + (size_t)(t + 2) * kstep;
            const char* a3 = a2 + kstep; const char* b3 = b2 + kstep;
            if (last && has_next) S.a_ready(nxt);
            if constexpr (SP2) {
            PG8_LDB(B0, 0, 0); PG8_LDB(B1, 0, 1); PG8_SCHED; PG8_LDA(At, 0, 0); PG8_STAGE(PG8_SA(1, 1), a1 + hstepA, voffA);
            PG8_WAIT_V(8); PG8_WAIT_L(0); PG8_BAR; PG8_MMA(0, 0, At, B0); PG8_MMA(0, 1, At, B1); PG8_BAR; PG8_SCHED;
            PG8_LDA(At, 0, 1); PG8_STAGE(PG8_SB(0, 0), b2, voffB); PG8_STAGE(PG8_SB(0, 1), b2 + hstepB, voffB); PG8_STAGE(PG8_SA(0, 0), a2, voffA);
            PG8_WAIT_V(8); PG8_WAIT_L(0); PG8_BAR; PG8_MMA(1, 0, At, B0); PG8_MMA(1, 1, At, B1); PG8_BAR; PG8_SCHED;
            PG8_LDB(B0, 1, 0); PG8_LDB(B1, 1, 1); PG8_SCHED; PG8_LDA(At, 1, 0); PG8_STAGE(PG8_SA(0, 1), a2 + hstepA, voffA);
            PG8_WAIT_V(8); PG8_WAIT_L(0); PG8_BAR; PG8_MMA(0, 0, At, B0); PG8_MMA(0, 1, At, B1); PG8_BAR; PG8_SCHED;
            PG8_LDA(At, 1, 1); PG8_STAGE(PG8_SB(1, 0), b3, voffB); PG8_STAGE(PG8_SB(1, 1), b3 + hstepB, voffB); PG8_STAGE(PG8_SA(1, 0), a3, voffA);
            PG8_WAIT_V(8); PG8_WAIT_L(0); PG8_BAR; PG8_MMA(1, 0, At, B0); PG8_MMA(1, 1, At, B1); PG8_BAR; PG8_SCHED;
            } else {
            PG8_LDB(B0, 0, 0); PG8_SCHED; PG8_LDA(At, 0, 0); PG8_STAGE(PG8_SA(1, 1), a1 + hstepA, voffA);
            PG8_WAIT_L(8); PG8_BAR; PG8_WAIT_L(0); PG8_MMA(0, 0, At, B0); PG8_BAR; PG8_SCHED;
            PG8_LDB(B1, 0, 1); PG8_STAGE(PG8_SB(0, 0), b2, voffB);
            PG8_BAR; PG8_WAIT_L(0); PG8_MMA(0, 1, At, B1); PG8_BAR;
            PG8_LDA(At, 0, 1); PG8_STAGE(PG8_SA(0, 0), a2, voffA);
            PG8_BAR; PG8_WAIT_L(0); PG8_MMA(1, 0, At, B0); PG8_BAR; PG8_SCHED;
            PG8_STAGE(PG8_SB(0, 1), b2 + hstepB, voffB);
            PG8_WAIT_V(6); PG8_BAR; PG8_MMA(1, 1, At, B1); PG8_BAR;
            PG8_LDB(B0, 1, 0); PG8_SCHED; PG8_LDA(At, 1, 0); PG8_STAGE(PG8_SA(0, 1), a2 + hstepA, voffA);
            PG8_WAIT_L(8); PG8_BAR; PG8_WAIT_L(0); PG8_MMA(0, 0, At, B0); PG8_BAR; PG8_SCHED;
            PG8_LDB(B1, 1, 1); PG8_STAGE(PG8_SB(1, 0), b3, voffB);
            PG8_BAR; PG8_WAIT_L(0); PG8_MMA(0, 1, At, B1); PG8_BAR;
            PG8_LDA(At, 1, 1); PG8_STAGE(PG8_SA(1, 0), a3, voffA);
            PG8_BAR; PG8_WAIT_L(0); PG8_MMA(1, 0, At, B0); PG8_BAR; PG8_SCHED;
            PG8_STAGE(PG8_SB(1, 1), b3 + hstepB, voffB);
            PG8_WAIT_V(6); PG8_BAR; PG8_MMA(1, 1, At, B1); PG8_BAR;
            }
        }
        if constexpr (ALIGN_EPI) { if (wr == 0) PG8_BAR; }
        if constexpr (!Epi::AFTER_DRAIN) { E(acc, cur, wr, wc, fr, fq); S.done(cur); }
        if (!has_next) break;
#pragma unroll
        for (int a = 0; a < 2; ++a)
#pragma unroll
            for (int b = 0; b < 2; ++b)
#pragma unroll
                for (int m = 0; m < 4; ++m)
#pragma unroll
                    for (int n = 0; n < 2; ++n) acc[a][b][m][n] = (f32x4){0.f, 0.f, 0.f, 0.f};
        cur = nxt; cA = nA; cB = nB; ++ui;
        if constexpr (ALIGN_EPI) { if (wr == 1) PG8_BAR; }
    }
    PG8_WAIT_V(0);
    if constexpr (!ALIGN_EPI) { if (wr == 0) PG8_BAR; }
    PG8_BAR;
    if constexpr (Epi::AFTER_DRAIN) { E.fused(acc, cur, wr, wc, fr, fq, lds, wid, lane); S.done(cur); }
#undef PG8_SA
#undef PG8_SB
#undef PG8_STAGE
#undef PG8_LDA
#undef PG8_LDB
#undef PG8_MMA
#undef PG8_WAIT_V
#undef PG8_WAIT_L
#undef PG8_BAR
#undef PG8_SCHED
}
}

typedef unsigned short bf16_t;
typedef short bf16x8 __attribute__((ext_vector_type(8)));
typedef short s16x4 __attribute__((ext_vector_type(4)));
typedef float f32x4 __attribute__((ext_vector_type(4)));
typedef float f32x16 __attribute__((ext_vector_type(16)));
typedef unsigned u32x4 __attribute__((ext_vector_type(4)));
typedef unsigned u32x2 __attribute__((ext_vector_type(2)));
typedef float f32x2_t __attribute__((ext_vector_type(2)));
typedef __bf16 bf16x2_t __attribute__((ext_vector_type(2)));
#define DI __device__ __forceinline__
#define GAS1 __attribute__((address_space(1)))
template <class T> DI T* opq2(T* q) { asm volatile("" : "+s"(q)); return q; }
DI int ltid() { int t = threadIdx.x; asm volatile("" : "+v"(t)); return t; }

constexpr int NB = 8, SEQL = 4096, CTXL = 256, DM = 1024, NLAYER = 4;
constexpr int ML = NB * SEQL, MC = NB * CTXL, MT = ML + MC;
constexpr int POSN = SEQL + CTXL;
constexpr int INW = 2752, INWP = 2816, FFH = 2816;
constexpr float EPS = 1e-6f;
constexpr float LOG2E = 1.4426950408889634f;

constexpr size_t OFF_CTL = 0;
constexpr size_t OFF_MODS = 4096;
constexpr size_t OFF_ROPE = OFF_MODS + 884736;
constexpr size_t OFF_STQ = OFF_ROPE + 524288;
constexpr size_t OFF_STKV = OFF_STQ + 1114112;
constexpr size_t OFF_XCTX = OFF_STKV + 557056;
constexpr size_t OFF_W = OFF_XCTX + 8388608;
constexpr size_t W_IN = 0, W_OUT = 5767168, W_F1 = 7864320, W_F2 = 19398656, W_UQ = 25165824, W_UKV = 25427968, W_TOTAL = 25559040;
constexpr size_t OFF_HC = OFF_W + W_TOTAL;
constexpr size_t OFF_PA = OFF_HC + 71303168;
constexpr size_t OFF_Y = OFF_PA + 196083712;
constexpr size_t OFF_MLAQ = OFF_Y + 71303168;
constexpr size_t OFF_MLAK = OFF_MLAQ + 26738688;
constexpr size_t OFF_VT = OFF_MLAK + 17825792;
constexpr size_t VT_TYPE_ELEMS = (size_t)NB * 4 * 64 * POSN;
constexpr size_t WS_END = OFF_VT + 4 * VT_TYPE_ELEMS * 2;
constexpr size_t OFF_BAR = WS_END, WS_END2 = WS_END + 16384;
static_assert(WS_END2 <= 536870912, "workspace map");

#ifndef USE_CG_SYNC
#define USE_CG_SYNC 0
#endif
#ifndef REP_SYNC
#define REP_SYNC 0
#endif
#ifndef REP_C
#define REP_C 1
#endif
#ifndef REP_CONV
#define REP_CONV 1
#endif
#ifndef REP_RP0
#define REP_RP0 0
#endif
#ifndef REP_MIX_ONLY
#define REP_MIX_ONLY 0
#endif
#ifndef REP_MIX
#define REP_MIX 1
#endif
#ifndef REP_GEMM
#define REP_GEMM 1
#endif
#ifndef REP_G3
#define REP_G3 REP_GEMM
#endif
#ifndef REP_G7
#define REP_G7 REP_GEMM
#endif
#ifndef REP_G9
#define REP_G9 REP_GEMM
#endif
#ifndef REP_G10
#define REP_G10 REP_GEMM
#endif
#ifndef PHMASK
#define PHMASK 0xFFFF
#endif
#define PH(k) ((PHMASK >> (k)) & 1)
constexpr int LDS_BYTES = 147456;
constexpr int LDS_CTL_OFF = 131072;

struct Params { const float* in[22]; float* out; unsigned char* ws; };
enum { I_X = 0, I_C, I_CTX, I_CCTX, I_ADAW, I_ADAB, I_NORMG, I_WIN, I_DLAM, I_DNORM, I_MQN, I_MKVN, I_WUQ, I_WUKV, I_GWG, I_GBG, I_GNORM, I_RDEC, I_RNORM, I_WOUT, I_FIN, I_FOUT };

typedef const unsigned char __attribute__((address_space(4)))* kaptr_t;
DI kaptr_t kargs() { kaptr_t ka = (kaptr_t)__builtin_amdgcn_kernarg_segment_ptr(); asm volatile("" : "+s"(ka)); return ka; }
#define KIN(k) (*(const float* const __attribute__((address_space(4)))*)(kargs() + 8 * (k)))
#define KOUT (*(float* const __attribute__((address_space(4)))*)(kargs() + 8 * 22))
#define KWS (*(unsigned char* const __attribute__((address_space(4)))*)(kargs() + 8 * 23))
DI unsigned pk2(float lo, float hi) { f32x2_t v = {lo, hi}; bf16x2_t b = __builtin_convertvector(v, bf16x2_t); return __builtin_bit_cast(unsigned, b); }
DI unsigned f2bf(float f) { return pk2(f, f) & 0xffffu; }
DI float bflo(unsigned w) { return __uint_as_float(w << 16); }
DI float bfhi(unsigned w) { return __uint_as_float(w & 0xffff0000u); }
DI int crow(int i, int h) { return (i & 3) + 8 * (i >> 2) + 4 * h; }
DI float wave_sum(float v) {
#pragma unroll
    for (int o = 1; o < 64; o <<= 1) v += __shfl_xor(v, o);
    return v;
}
DI float silu_f(float x) { return x * __builtin_amdgcn_rcpf(1.f + __expf(-x)); }
DI float logsig_f(float x) { return fminf(x, 0.f) - __logf(1.f + __expf(-fabsf(x))); }
#define LBAR() asm volatile("s_waitcnt lgkmcnt(0)\n\ts_barrier" ::: "memory")
#define MFMA32(a, b, c) __builtin_amdgcn_mfma_f32_32x32x16_bf16((a), (b), (c), 0, 0, 0)

DI void row_bpos(int row, int& b, int& pos) { if (row < ML) { b = row >> 12; pos = CTXL + (row & 4095); } else { const int r = row - ML; b = r >> 8; pos = r & 255; } }
DI int pos_row(int b, int pos) { return pos < CTXL ? ML + b * CTXL + pos : b * SEQL + pos - CTXL; }

namespace pg8 {
struct EpiY {
    static constexpr bool PERM = true, AFTER_DRAIN = false;
    bf16_t* O; int ldc;
    __device__ __forceinline__ void operator()(const f32x4 (&acc)[2][2][4][2], const Unit& u, int wr, int wc, int fr, int fq) const {
        const int row0 = u.pm * BM + wr * 64 + fr, col0 = u.pn * BM + wc * 32 + 8 * fq;
#pragma unroll
        for (int ai = 0; ai < 2; ++ai)
#pragma unroll
            for (int m = 0; m < 4; ++m) { bf16_t* rowp = O + (size_t)(row0 + ai * HALF + m * 16) * ldc + col0;
#pragma unroll
                for (int bj = 0; bj < 2; ++bj) { const f32x4 v0 = acc[ai][bj][m][0], v1 = acc[ai][bj][m][1];
                    u32x4 w; w.x = pk2(v0[0], v0[1]); w.y = pk2(v0[2], v0[3]); w.z = pk2(v1[0], v1[1]); w.w = pk2(v1[2], v1[3]);
                    *(u32x4*)(rowp + bj * HALF) = w; } }
    }
};
struct EpiSwiglu {
    static constexpr bool PERM = true, AFTER_DRAIN = false;
    bf16_t* O;
    __device__ __forceinline__ void operator()(const f32x4 (&acc)[2][2][4][2], const Unit& u, int wr, int wc, int fr, int fq) const {
        const int row0 = u.pm * BM + wr * 64 + fr, col0 = u.pn * HALF + wc * 32 + 8 * fq;
#pragma unroll
        for (int ai = 0; ai < 2; ++ai)
#pragma unroll
            for (int m = 0; m < 4; ++m) { bf16_t* rowp = O + (size_t)(row0 + ai * HALF + m * 16) * FFH + col0;
                float r[8];
#pragma unroll
                for (int n = 0; n < 2; ++n)
#pragma unroll
                    for (int i = 0; i < 4; ++i) { const float g = acc[ai][0][m][n][i], up = acc[ai][1][m][n][i]; r[4 * n + i] = g * __builtin_amdgcn_rcpf(1.f + __expf(-g)) * up; }
                u32x4 w; w.x = pk2(r[0], r[1]); w.y = pk2(r[2], r[3]); w.z = pk2(r[4], r[5]); w.w = pk2(r[6], r[7]);
                *(u32x4*)rowp = w; }
    }
};
DI void rope_pair(f32x4& a, f32x4& b, const float* rc, const float* rs, int row, int fq) {
    if (row < ML) { const int t = row & 4095; const f32x4 c = *(const f32x4*)(rc + t * 16 + 4 * fq), s = *(const f32x4*)(rs + t * 16 + 4 * fq);
        const f32x4 x1 = a, x2 = b; a = x1 * c - x2 * s; b = x1 * s + x2 * c; }
}
DI void store4(bf16_t* p, const f32x4& v) { u32x2 w; w.x = pk2(v[0], v[1]); w.y = pk2(v[2], v[3]); *(u32x2*)p = w; }
DI void store_vt(bf16_t* VT, int type, int hd, int e0, int row, const f32x4& v) {
    int b, pos; row_bpos(row, b, pos);
    pos = (pos & ~12) | ((pos & 4) << 1) | ((pos & 8) >> 1);
    bf16_t* q = VT + ((size_t)((type * NB + b) * 4 + hd) * 64 + e0) * POSN + pos;
#pragma unroll
    for (int i = 0; i < 4; ++i) q[(size_t)i * POSN] = (bf16_t)f2bf(v[i]);
}
DI void store_vt_tile(bf16_t* VT, int type, int hd, int e0, int row0, const f32x4& v0, const f32x4& v1, bf16_t* scr, int fr, int c0, int c1, int lane) {
    const int pr = (fr & ~12) | ((fr & 4) << 1) | ((fr & 8) >> 1);
#pragma unroll
    for (int i = 0; i < 4; ++i) { scr[(c0 + i) * 24 + pr] = (bf16_t)f2bf(v0[i]); scr[(c1 + i) * 24 + pr] = (bf16_t)f2bf(v1[i]); }
    asm volatile("s_waitcnt lgkmcnt(0)" ::: "memory");
    const int col = lane >> 1, half = lane & 1;
    const u32x4 w = *(const u32x4*)(scr + col * 24 + 8 * half);
    int b, pos; row_bpos(row0, b, pos);
    *(u32x4*)(VT + ((size_t)((type * NB + b) * 4 + hd) * 64 + e0 + col) * POSN + pos + 8 * half) = w;
    asm volatile("s_waitcnt lgkmcnt(0)" ::: "memory");
}
struct EpiProj {
    static constexpr bool PERM = true, AFTER_DRAIN = false;
    bf16_t* PROJ; bf16_t* VT; float* stq; float* stkv; const float* rc; const float* rs; unsigned char* scr;
    __device__ __forceinline__ void operator()(const f32x4 (&acc)[2][2][4][2], const Unit& u, int wr, int wc, int fr, int fq) const {
#pragma unroll
        for (int bj = 0; bj < 2; ++bj) {
            const int g = u.pn * 8 + bj * 4 + wc;
            if (g >= 86) continue;
            const int colbase = g * 32;
            int kind = 0; float scale = 1.f; int vtype = 0, vc0 = 0, slot = 0;
            if (g < 8) { kind = 1; scale = 0.17677669529663687f * LOG2E; }
            else if (g < 16) { kind = 1; }
            else if (g < 24) { kind = 2; vtype = 0; vc0 = colbase - 512; }
            else if (g < 32) { kind = 3; slot = g - 24; }
            else if (g < 36) { kind = 4; slot = g - 32; }
            else if (g == 36) { kind = 1; }
            else if (g < 41) { kind = 0; scale = 0.17677669529663687f; }
            else if (g < 45) { kind = 0; }
            else if (g < 53) { kind = 2; vtype = 2; vc0 = colbase - 1440; }
            else if (g < 62) { kind = 0; }
            else if (g < 66) { kind = 1; scale = 0.17677669529663687f; }
            else if (g < 70) { kind = 1; }
            else if (g < 78) { kind = 2; vtype = 3; vc0 = colbase - 2240; }
            else { kind = 0; }
#pragma unroll
            for (int ai = 0; ai < 2; ++ai)
#pragma unroll
                for (int m = 0; m < 4; ++m) {
                    const int row = u.pm * BM + ai * HALF + wr * 64 + m * 16 + fr;
                    f32x4 v0 = acc[ai][bj][m][0], v1 = acc[ai][bj][m][1];
                    if (kind == 1) {
                        f32x4 w0, w1;
#pragma unroll
                        for (int i = 0; i < 4; ++i) { w0[i] = __shfl_xor(v0[i], 32); w1[i] = __shfl_xor(v1[i], 32); }
                        if (row < ML) { const int t = row & 4095; const float* cb = rc + t * 16 + 8 * (fq & 1); const float* sb = rs + t * 16 + 8 * (fq & 1);
                            const f32x4 c0 = *(const f32x4*)cb, c1 = *(const f32x4*)(cb + 4), s0 = *(const f32x4*)sb, s1 = *(const f32x4*)(sb + 4);
                            if (fq < 2) { v0 = v0 * c0 - w0 * s0; v1 = v1 * c1 - w1 * s1; } else { v0 = w0 * s0 + v0 * c0; v1 = w1 * s1 + v1 * c1; } }
                    }
                    v0 = v0 * scale; v1 = v1 * scale;
                    if (kind == 2) {
                        store_vt_tile(VT, vtype, vc0 >> 6, vc0 & 63, row - fr, v0, v1, (bf16_t*)(scr + (wr * 4 + wc) * 1536), fr, 8 * fq, 8 * fq + 4, fr + 16 * fq);
                    } else {
                        { u32x4 ww; ww.x = pk2(v0[0], v0[1]); ww.y = pk2(v0[2], v0[3]); ww.z = pk2(v1[0], v1[1]); ww.w = pk2(v1[2], v1[3]);
                          *(u32x4*)(PROJ + (size_t)row * INWP + colbase + 8 * fq) = ww; }
                        if (kind >= 3) {
                            float ss = (v0[0] * v0[0] + v0[1] * v0[1]) + (v0[2] * v0[2] + v0[3] * v0[3]) + (v1[0] * v1[0] + v1[1] * v1[1]) + (v1[2] * v1[2] + v1[3] * v1[3]);
                            ss += __shfl_xor(ss, 16); ss += __shfl_xor(ss, 32);
                            if (fq == 0) { if (kind == 3) stq[(size_t)row * 8 + slot] = ss; else stkv[(size_t)row * 4 + slot] = ss; }
                        }
                    }
                }
        }
    }
};
struct EpiUpQ {
    static constexpr bool PERM = false, AFTER_DRAIN = false;
    bf16_t* MQ; const float* stq; const float* rc; const float* rs;
    __device__ __forceinline__ void operator()(const f32x4 (&acc)[2][2][4][2], const Unit& u, int wr, int wc, int fr, int fq) const {
#pragma unroll
        for (int ai = 0; ai < 2; ++ai)
#pragma unroll
            for (int m = 0; m < 4; ++m) {
                const int row = u.pm * BM + ai * HALF + wr * 64 + m * 16 + fr;
                const f32x4 s0 = *(const f32x4*)(stq + (size_t)row * 8), s1 = *(const f32x4*)(stq + (size_t)row * 8 + 4);
                const float ss = ((s0[0] + s0[1]) + (s0[2] + s0[3])) + ((s1[0] + s1[1]) + (s1[2] + s1[3]));
                const float sc = rsqrtf(ss * (1.f / 256.f) + EPS) * (0.10206207261596575f * LOG2E);
#pragma unroll
                for (int bj = 0; bj < 2; ++bj) {
                    const int g = u.pn * 8 + bj * 4 + wc;
                    if (g >= 12) continue;
                    f32x4 v0 = acc[ai][bj][m][0], v1 = acc[ai][bj][m][1];
                    if ((g % 3) == 2) rope_pair(v0, v1, rc, rs, row, fq);
                    v0 = v0 * sc; v1 = v1 * sc;
                    bf16_t* pp = MQ + (size_t)row * 384 + g * 32 + 4 * fq;
                    store4(pp, v0); store4(pp + 16, v1);
                }
                asm volatile("" ::: "memory");
            }
    }
};
struct EpiUpKV {
    static constexpr bool PERM = false, AFTER_DRAIN = false;
    bf16_t* MK; bf16_t* VT; const float* stkv; unsigned char* scr;
    __device__ __forceinline__ void operator()(const f32x4 (&acc)[2][2][4][2], const Unit& u, int wr, int wc, int fr, int fq) const {
#pragma unroll
        for (int ai = 0; ai < 2; ++ai)
#pragma unroll
            for (int m = 0; m < 4; ++m) {
                const int row = u.pm * BM + ai * HALF + wr * 64 + m * 16 + fr;
                const f32x4 s0 = *(const f32x4*)(stkv + (size_t)row * 4);
                const float sc = rsqrtf(((s0[0] + s0[1]) + (s0[2] + s0[3])) * (1.f / 128.f) + EPS);
#pragma unroll
                for (int bj = 0; bj < 2; ++bj) {
                    const int g = u.pn * 8 + bj * 4 + wc, hd = g >> 2, part = g & 3;
                    const f32x4 v0 = acc[ai][bj][m][0] * sc, v1 = acc[ai][bj][m][1] * sc;
                    if (part < 2) { bf16_t* pp = MK + (size_t)row * 256 + hd * 64 + part * 32 + 4 * fq; store4(pp, v0); store4(pp + 16, v1); }
                    else { store_vt_tile(VT, 1, hd, (part - 2) * 32, row - fr, v0, v1, (bf16_t*)(scr + (wr * 4 + wc) * 1536), fr, 4 * fq, 16 + 4 * fq, fr + 16 * fq); }
                }
                asm volatile("" ::: "memory");
            }
    }
};
}

DI void phase0(const Params& p, unsigned char* lds) {
    const int tid = ltid(); const size_t gt = (size_t)blockIdx.x * 512 + tid, gn = (size_t)gridDim.x * 512;
    if (blockIdx.x == 0) { for (int i = tid; i < 1024; i += 512) ((unsigned*)(KWS + OFF_CTL))[i] = 0u;
        for (int i = tid; i < 4096; i += 512) ((unsigned*)(KWS + OFF_BAR))[i] = 0u; }
    float* rc = (float*)(KWS + OFF_ROPE); float* rs = rc + 4096 * 16;
    for (size_t i = gt; i < 65536; i += gn) { const int t = (int)(i >> 4), jj = (int)(i & 15), k = jj & 7;
        const float freq = powf(10000.f, -(float)k * 0.125f); const float pos = jj < 8 ? (float)(t >> 6) : (float)(t & 63); const float a = pos * freq;
        rc[i] = cosf(a); rs[i] = sinf(a); }
    float* S = (float*)lds;
    float* red = S + 9216;
    for (int i = tid; i < 9216; i += 512) { const int r = i >> 10, k = i & 1023; const float c = r < 8 ? KIN(I_C)[r * 1024 + k] : KIN(I_CCTX)[k]; S[i] = c / (1.f + expf(-c)); }
    __syncthreads();
    float* MODS = (float*)(KWS + OFF_MODS);
    for (int item = blockIdx.x; item < 768; item += gridDim.x) {
        const int l = item / 192, n0 = (item % 192) * 32, kg = tid >> 5, c = tid & 31;
        const float* W = KIN(I_ADAW) + (size_t)l * 1024 * 6144 + n0 + c;
        float acc[9];
#pragma unroll
        for (int r = 0; r < 9; ++r) acc[r] = 0.f;
#pragma unroll 8
        for (int kk = 0; kk < 64; ++kk) { const int k = kg * 64 + kk; const float w = __builtin_nontemporal_load(W + (size_t)k * 6144);
#pragma unroll
            for (int r = 0; r < 9; ++r) acc[r] += S[r * 1024 + k] * w; }
#pragma unroll
        for (int r = 0; r < 9; ++r) red[(kg * 9 + r) * 32 + c] = acc[r];
        __syncthreads();
        for (int o = tid; o < 288; o += 512) { const int r = o >> 5, cc = o & 31; float sacc = 0.f;
#pragma unroll
            for (int k2 = 0; k2 < 16; ++k2) sacc += red[(k2 * 9 + r) * 32 + cc];
            MODS[(size_t)(l * 9 + r) * 6144 + n0 + cc] = sacc + KIN(I_ADAB)[l * 6144 + n0 + cc]; }
        __syncthreads();
    }
}

DI void tr_item(const float* W, int K, int N, bf16_t* WT, int k0, int n0, int drow0, const float* kscale, float* scr, int lane) {
#pragma unroll 8
    for (int i = 0; i < 32; ++i) { const int kk = 2 * i + (lane >> 5); float v = __builtin_nontemporal_load(W + (size_t)(k0 + kk) * N + n0 + (lane & 31)); if (kscale) v *= kscale[k0 + kk]; scr[kk * 33 + (lane & 31)] = v; }
    asm volatile("s_waitcnt lgkmcnt(0)" ::: "memory");
    const int c = lane & 7;
#pragma unroll
    for (int j = 0; j < 4; ++j) { const int n = (lane >> 3) + 8 * j; const float* s = scr + (8 * c) * 33 + n;
        u32x4 o; o.x = pk2(s[0 * 33], s[1 * 33]); o.y = pk2(s[2 * 33], s[3 * 33]); o.z = pk2(s[4 * 33], s[5 * 33]); o.w = pk2(s[6 * 33], s[7 * 33]);
        *(u32x4*)(WT + (size_t)(drow0 + n) * K + k0 + 8 * c) = o; }
    asm volatile("s_waitcnt lgkmcnt(0)" ::: "memory");
}
DI void convert_weights(const Params& p, int l, unsigned char* lds, int mask, int vblock, int vgrid) {
    asm volatile("" : "+s"(l));
    const int tid = ltid(), wave = tid >> 6, lane = tid & 63; const int gw = vblock * 8 + wave, NGW = vgrid * 8;
    float* scr = (float*)lds + wave * 2112;
    bf16_t* Wb = (bf16_t*)(KWS + OFF_W);
    bf16_t* WT_IN = Wb + W_IN / 2; bf16_t* WT_OUT = Wb + W_OUT / 2; bf16_t* WT_F1 = Wb + W_F1 / 2; bf16_t* WT_F2 = Wb + W_F2 / 2; bf16_t* WT_UQ = Wb + W_UQ / 2; bf16_t* WT_UKV = Wb + W_UKV / 2;
    for (int it = gw; it < 6192; it += NGW) {
        int r = it;
        { const bool isf2 = (it >= 4704 && it < 6112); if (!((mask >> (isf2 ? 1 : 0)) & 1)) continue; }
        if (r < 1376) { tr_item(KIN(I_WIN) + (size_t)l * 1024 * INW, 1024, INW, WT_IN, 64 * (r / 86), 32 * (r % 86), 32 * (r % 86), nullptr, scr, lane); continue; } r -= 1376;
        if (r < 512) { tr_item(KIN(I_WOUT) + (size_t)l * 1024 * 1024, 1024, 1024, WT_OUT, 64 * (r / 32), 32 * (r % 32), 32 * (r % 32), nullptr, scr, lane); continue; } r -= 512;
        if (r < 2816) { const int n0 = 32 * (r % 176); const int j = n0 < FFH ? n0 : n0 - FFH; const int drow = 256 * (j / 128) + (j % 128) + (n0 < FFH ? 0 : 128);
            tr_item(KIN(I_FIN) + (size_t)l * 1024 * 5632, 1024, 5632, WT_F1, 64 * (r / 176), n0, drow, nullptr, scr, lane); continue; } r -= 2816;
        if (r < 1408) { tr_item(KIN(I_FOUT) + (size_t)l * FFH * 1024, FFH, 1024, WT_F2, 64 * (r / 32), 32 * (r % 32), 32 * (r % 32), nullptr, scr, lane); continue; } r -= 1408;
        if (r < 48) { tr_item(KIN(I_WUQ) + (size_t)l * 256 * 384, 256, 384, WT_UQ, 64 * (r / 12), 32 * (r % 12), 32 * (r % 12), KIN(I_MQN) + l * 256, scr, lane); continue; } r -= 48;
        tr_item(KIN(I_WUKV) + (size_t)l * 128 * 512, 128, 512, WT_UKV, 64 * (r / 16), 32 * (r % 16), 32 * (r % 16), KIN(I_MKVN) + l * 128, scr, lane);
    }
    if (!(mask & 1)) return;
    const size_t gt = (size_t)vblock * 512 + tid, gn = (size_t)vgrid * 512; unsigned zz = 0u; asm volatile("" : "+v"(zz)); const u32x4 z = {zz, zz, zz, zz};
    for (size_t i = gt; i < 8192; i += gn) ((u32x4*)(WT_IN + (size_t)INW * 1024))[i] = z;
    for (size_t i = gt; i < 4096; i += gn) ((u32x4*)(WT_UQ + (size_t)384 * 256))[i] = z;
}

DI void rowpass(int row_begin, int row_end, int vblock, int vgrid, const float* xinL, const float* xinC, float* xoutL, float* xoutC, const bf16_t* Y, const float* mgate, const float* gpost,
                bf16_t* H, const float* gpre, const float* mshift, const float* mscale) {
    const int tid = ltid(), wave = tid >> 6, lane = tid & 63; const int gw = vblock * 8 + wave, NGW = vgrid * 8;
    f32x4 vn[4]; u32x2 yn[4];
    auto fetch = [&](int row) {
        const float* xr = row < ML ? xinL + (size_t)row * DM : xinC + (size_t)(row - ML) * DM;
#pragma unroll
        for (int j = 0; j < 4; ++j) vn[j] = __builtin_nontemporal_load((const GAS1 f32x4*)(xr + 4 * lane + 256 * j));
        if (Y) {
#pragma unroll
            for (int j = 0; j < 4; ++j) yn[j] = __builtin_nontemporal_load((const GAS1 u32x2*)(Y + (size_t)row * DM + 4 * lane + 256 * j)); }
    };
    f32x4 gpo[4], gpr[4], gat[4], shf[4], scl[4];
#pragma unroll
    for (int j = 0; j < 4; ++j) { gpo[j] = Y ? *(const GAS1 f32x4*)(gpost + 4 * lane + 256 * j) : (f32x4){0.f, 0.f, 0.f, 0.f}; gpr[j] = H ? *(const GAS1 f32x4*)(gpre + 4 * lane + 256 * j) : (f32x4){0.f, 0.f, 0.f, 0.f};
        gat[j] = gpo[j]; shf[j] = gpo[j]; scl[j] = gpo[j]; }
    int mb_cur = -1;
    int row = row_begin + gw;
    if (row < row_end) fetch(row);
    for (; row < row_end; row += NGW) {
        const int mb = row < ML ? (row >> 12) : 8;
        f32x4 v[4]; u32x2 yw[4];
#pragma unroll
        for (int j = 0; j < 4; ++j) { v[j] = vn[j]; yw[j] = yn[j]; }
        if (row + NGW < row_end) fetch(row + NGW);
        if (mb != mb_cur) {
            mb_cur = mb;
#pragma unroll
            for (int j = 0; j < 4; ++j) { const int c = 4 * lane + 256 * j;
                if (Y) gat[j] = *(const GAS1 f32x4*)(mgate + (size_t)mb * 6144 + c);
                if (H) { shf[j] = *(const GAS1 f32x4*)(mshift + (size_t)mb * 6144 + c); scl[j] = *(const GAS1 f32x4*)(mscale + (size_t)mb * 6144 + c) + 1.f; } }
        }
        if (Y) {
            f32x4 y[4]; float ss = 0.f;
#pragma unroll
            for (int j = 0; j < 4; ++j) { const u32x2 w = yw[j]; y[j] = (f32x4){bflo(w.x), bfhi(w.x), bflo(w.y), bfhi(w.y)};
                ss += (y[j][0] * y[j][0] + y[j][1] * y[j][1]) + (y[j][2] * y[j][2] + y[j][3] * y[j][3]); }
            const float ry = rsqrtf(wave_sum(ss) * (1.f / DM) + EPS);
            float* xo = row < ML ? xoutL + (size_t)row * DM : xoutC + (size_t)(row - ML) * DM;
#pragma unroll
            for (int j = 0; j < 4; ++j) { v[j] = v[j] + gat[j] * (y[j] * ry * gpo[j]); __builtin_nontemporal_store(v[j], (GAS1 f32x4*)(xo + 4 * lane + 256 * j)); }
        }
        if (H) {
            float ss = 0.f;
#pragma unroll
            for (int j = 0; j < 4; ++j) ss += (v[j][0] * v[j][0] + v[j][1] * v[j][1]) + (v[j][2] * v[j][2] + v[j][3] * v[j][3]);
            const float rx = rsqrtf(wave_sum(ss) * (1.f / DM) + EPS);
#pragma unroll
            for (int j = 0; j < 4; ++j) { const int c = 4 * lane + 256 * j;
                const f32x4 hv = v[j] * rx * gpr[j] * scl[j] + shf[j]; u32x2 w; w.x = pk2(hv[0], hv[1]); w.y = pk2(hv[2], hv[3]); *(GAS1 u32x2*)(H + (size_t)row * DM + c) = w; }
        }
    }
}

template <int TYPE>
DI void attn_unit(const Params& p, unsigned char* lds, int l, int b, int hd, int qrow0, int NT) {
    asm volatile("" : "+s"(l), "+s"(b), "+s"(hd), "+s"(qrow0), "+s"(NT));
    constexpr int NMAP = TYPE == 0 ? 2 : 1, KS = TYPE == 0 ? 2 : 6, DQ = NMAP * KS * 16, KP = DQ + 8, CPR = DQ / 8;
    constexpr int TK = TYPE == 0 ? 64 : 128, VP = TK + 8, KCH = TK * CPR / 512, VCPR = TK / 8, VCH = 64 * VCPR / 512;
    const int tid = ltid(), lane = tid & 63, w = tid >> 6, r32 = lane & 31, h = lane >> 5;
    bf16_t* Kl = (bf16_t*)lds;
    bf16_t* Vl = (bf16_t*)(lds + 2 * TK * KP * 2);
    const bf16_t* PROJ = (const bf16_t*)(KWS + OFF_PA);
    const bf16_t* MQ = (const bf16_t*)(KWS + OFF_MLAQ);
    const bf16_t* MK = (const bf16_t*)(KWS + OFF_MLAK);
    const bf16_t* VTb = (const bf16_t*)(KWS + OFF_VT) + ((size_t)((TYPE * NB + b) * 4 + hd) * 64) * POSN;
    bf16_t* CC = (bf16_t*)(KWS + OFF_HC);
    bf16x8 qf[NMAP][KS];
    const int qrow = qrow0 + 32 * w + r32;
#pragma unroll
    for (int mp = 0; mp < NMAP; ++mp)
#pragma unroll
        for (int s = 0; s < KS; ++s)
            qf[mp][s] = TYPE == 0 ? *(const bf16x8*)(PROJ + (size_t)qrow * INWP + 64 * hd + mp * 32 + 16 * s + 8 * h)
                                  : *(const bf16x8*)(MQ + (size_t)qrow * 384 + 96 * hd + 16 * s + 8 * h);
    float mrun[NMAP], lsum[NMAP]; f32x16 o[NMAP][2];
#pragma unroll
    for (int mp = 0; mp < NMAP; ++mp) { mrun[mp] = 0.f; lsum[mp] = 0.f;
#pragma unroll
        for (int i = 0; i < 16; ++i) { o[mp][0][i] = 0.f; o[mp][1][i] = 0.f; } }
    u32x4 kreg[KCH], vreg[VCH];
    auto gload = [&](int t) {
#pragma unroll
        for (int i = 0; i < KCH; ++i) { const int c = tid + 512 * i, kr = c / CPR, cc = c % CPR; const int grow = pos_row(b, TK * t + kr);
            if (TYPE == 0) kreg[i] = *(const u32x4*)(PROJ + (size_t)grow * INWP + 256 + 64 * hd + 8 * cc);
            else kreg[i] = cc < 8 ? *(const u32x4*)(MK + (size_t)grow * 256 + 64 * hd + 8 * cc) : *(const u32x4*)(PROJ + (size_t)grow * INWP + 1152 + 8 * (cc - 8)); }
#pragma unroll
        for (int i = 0; i < VCH; ++i) { const int c = tid + 512 * i, e = c / VCPR, jc = c % VCPR; vreg[i] = *(const u32x4*)(VTb + (size_t)e * POSN + TK * t + 8 * jc); }
    };
    auto lstore = [&](int buf) {
#pragma unroll
        for (int i = 0; i < KCH; ++i) { const int c = tid + 512 * i, kr = c / CPR, cc = c % CPR; *(u32x4*)(Kl + (size_t)buf * TK * KP + kr * KP + 8 * cc) = kreg[i]; }
#pragma unroll
        for (int i = 0; i < VCH; ++i) { const int c = tid + 512 * i, e = c / VCPR, jc = c % VCPR; *(u32x4*)(Vl + (size_t)buf * 64 * VP + e * VP + 8 * jc) = vreg[i]; }
    };
    const int NTI = NT * 64 / TK;
    gload(0); lstore(0); __syncthreads();
    bool shifted = false;
    for (int t = 0; t < NTI; ++t) {
        const int buf = t & 1;
        if (t + 1 < NTI) gload(t + 1);
        const bf16_t* Kb = Kl + (size_t)buf * TK * KP; const bf16_t* Vb = Vl + (size_t)buf * 64 * VP;
        bf16x8 pbd[2][4];
        f32x16 a0, a1, b0, b1;
        auto kfrag = [&](int st, int half, int s) { return TYPE == 0 ? *(const bf16x8*)(Kb + (32 * half + r32) * KP + st * 32 + 16 * s + 8 * h)
                                                                       : *(const bf16x8*)(Kb + (64 * st + 32 * half + r32) * KP + 16 * s + 8 * h); };
        auto vfrag = [&](int st, int eb, int s) { return *(const bf16x8*)(Vb + (32 * eb + r32) * VP + (TYPE == 0 ? 0 : 64 * st) + 16 * s + 8 * h); };
        auto sub_ref = [&](f32x16& x0, f32x16& x1, int mi) {
            if (__builtin_expect(shifted, 0)) { asm volatile("" ::: "memory");
#pragma unroll
                for (int i = 0; i < 16; ++i) { x0[i] -= mrun[mi]; x1[i] -= mrun[mi]; } } };
        auto pack8 = [&](const f32x16& x, int base) { u32x4 tt; tt.x = pk2(x[base], x[base + 1]); tt.y = pk2(x[base + 2], x[base + 3]); tt.z = pk2(x[base + 4], x[base + 5]); tt.w = pk2(x[base + 6], x[base + 7]); return __builtin_bit_cast(bf16x8, tt); };
        auto slow = [&](int st, f32x16& x0, f32x16& x1, float& ps) {
            const int mi = TYPE == 0 ? st : 0;
#pragma unroll
            for (int i = 0; i < 16; ++i) { x0[i] = 0.f; x1[i] = 0.f; }
#pragma unroll
            for (int s2 = 0; s2 < KS; ++s2) { x0 = MFMA32(kfrag(st, 0, s2), qf[mi][s2], x0); x1 = MFMA32(kfrag(st, 1, s2), qf[mi][s2], x1); }
            sub_ref(x0, x1, mi);
            float tm = fmaxf(x0[0], x1[0]);
#pragma unroll
            for (int i = 1; i < 16; ++i) tm = fmaxf(tm, fmaxf(x0[i], x1[i]));
            tm = fmaxf(tm, __shfl_xor(tm, 32));
            const bool first = (t == 0) && (TYPE == 0 || st == 0);
            const float dl = first ? tm : fmaxf(tm, 0.f);
            mrun[mi] += dl;
            if (!first) { const float alpha = __builtin_amdgcn_exp2f(-dl); lsum[mi] *= alpha;
#pragma unroll
                for (int i = 0; i < 16; ++i) { o[mi][0][i] *= alpha; o[mi][1][i] *= alpha; } }
            ps = 0.f;
#pragma unroll
            for (int i = 0; i < 16; ++i) { x0[i] = __builtin_amdgcn_exp2f(x0[i] - dl); x1[i] = __builtin_amdgcn_exp2f(x1[i] - dl); ps += x0[i] + x1[i]; }
            shifted = true;
        };
        constexpr int M0 = 0, M1 = TYPE == 0 ? 1 : 0;
#pragma unroll
        for (int i = 0; i < 16; ++i) { a0[i] = 0.f; a1[i] = 0.f; b0[i] = 0.f; b1[i] = 0.f; }
#pragma unroll
        for (int s2 = 0; s2 < KS; ++s2) { a0 = MFMA32(kfrag(0, 0, s2), qf[M0][s2], a0); a1 = MFMA32(kfrag(0, 1, s2), qf[M0][s2], a1); }
        sub_ref(a0, a1, M0);
        float psa = 0.f;
#pragma unroll
        for (int n = 0; n < 2 * KS; ++n) {
            if (n & 1) b1 = MFMA32(kfrag(1, 1, n >> 1), qf[M1][n >> 1], b1); else b0 = MFMA32(kfrag(1, 0, n >> 1), qf[M1][n >> 1], b0);
#pragma unroll
            for (int r = (32 * n) / (2 * KS); r < (32 * (n + 1)) / (2 * KS); ++r) {
                if (r < 16) { a0[r] = __builtin_amdgcn_exp2f(a0[r]); psa += a0[r]; } else { a1[r - 16] = __builtin_amdgcn_exp2f(a1[r - 16]); psa += a1[r - 16]; } }
        }
        {   const bool firstA = (t == 0);
            if (__builtin_expect(__any(!(psa <= 1e13f) || (firstA && psa < 1e-13f)), 0)) slow(0, a0, a1, psa); }
        lsum[M0] += psa;
        pbd[0][0] = pack8(a0, 0); pbd[0][1] = pack8(a0, 8); pbd[0][2] = pack8(a1, 0); pbd[0][3] = pack8(a1, 8);
        sub_ref(b0, b1, M1);
        float psb = 0.f;
#pragma unroll
        for (int eb = 0; eb < 2; ++eb)
#pragma unroll
            for (int s2 = 0; s2 < 4; ++s2) {
                o[M0][eb] = MFMA32(vfrag(0, eb, s2), pbd[0][s2], o[M0][eb]);
                const int q4 = (eb * 4 + s2) * 4;
#pragma unroll
                for (int i = 0; i < 4; ++i) { const int r = q4 + i; if (r < 16) { b0[r] = __builtin_amdgcn_exp2f(b0[r]); psb += b0[r]; } else { b1[r - 16] = __builtin_amdgcn_exp2f(b1[r - 16]); psb += b1[r - 16]; } }
            }
        {   const bool firstB = (t == 0) && TYPE == 0;
            if (__builtin_expect(__any(!(psb <= 1e13f) || (firstB && psb < 1e-13f)), 0)) slow(1, b0, b1, psb); }
        lsum[M1] += psb;
        pbd[1][0] = pack8(b0, 0); pbd[1][1] = pack8(b0, 8); pbd[1][2] = pack8(b1, 0); pbd[1][3] = pack8(b1, 8);
#pragma unroll
        for (int eb = 0; eb < 2; ++eb)
#pragma unroll
            for (int s2 = 0; s2 < 4; ++s2) o[M1][eb] = MFMA32(vfrag(1, eb, s2), pbd[1][s2], o[M1][eb]);
        if (t + 1 < NTI) lstore(buf ^ 1);
        __syncthreads();
    }
    float inv[NMAP];
#pragma unroll
    for (int mp = 0; mp < NMAP; ++mp) { const float lt = lsum[mp] + __shfl_xor(lsum[mp], 32); inv[mp] = 1.f / lt; }
    if (TYPE == 1) {
        bf16_t* op = CC + (size_t)qrow * DM + 256 + 64 * hd;
#pragma unroll
        for (int eb = 0; eb < 2; ++eb)
#pragma unroll
            for (int g = 0; g < 4; ++g) { const f32x4 v = {o[0][eb][4 * g] * inv[0], o[0][eb][4 * g + 1] * inv[0], o[0][eb][4 * g + 2] * inv[0], o[0][eb][4 * g + 3] * inv[0]};
                pg8::store4(op + 32 * eb + 8 * g + 4 * h, v); }
    } else {
        int l2 = l; asm volatile("" : "+s"(l2));
        const float* dl = opq2(KIN(I_DLAM)) + l2 * 128; float d1 = 0.f, d2 = 0.f;
        for (int i = 0; i < 32; ++i) { d1 += dl[i] * dl[32 + i]; d2 += dl[64 + i] * dl[96 + i]; }
        float c08 = 0.8f, c06 = 0.6f; asm volatile("" : "+v"(c08), "+v"(c06));
        const float lam_init = c08 - c06 * __expf(-0.3f * (float)l2);
        const float lam = __expf(d1) - __expf(d2) + lam_init;
        const float* sg = opq2(KIN(I_DNORM)) + l2 * 64;
        float ss = 0.f; const float li1 = lam * inv[NMAP - 1];
#pragma unroll
        for (int eb = 0; eb < 2; ++eb)
#pragma unroll
            for (int i = 0; i < 16; ++i) { const float v = o[0][eb][i] * inv[0] - li1 * o[NMAP - 1][eb][i]; o[0][eb][i] = v; ss += v * v; }
        ss += __shfl_xor(ss, 32);
        const float rn = rsqrtf(ss * (1.f / 64.f) + EPS) * (1.f - lam_init);
        bf16_t* op = CC + (size_t)qrow * DM + 64 * hd;
#pragma unroll
        for (int eb = 0; eb < 2; ++eb)
#pragma unroll
            for (int g = 0; g < 4; ++g) { const int e0 = 32 * eb + 8 * g + 4 * h; const f32x4 gg = *(const f32x4*)(sg + e0);
                const f32x4 v = {o[0][eb][4 * g] * rn * gg[0], o[0][eb][4 * g + 1] * rn * gg[1], o[0][eb][4 * g + 2] * rn * gg[2], o[0][eb][4 * g + 3] * rn * gg[3]};
                pg8::store4(op + e0, v); }
    }
}

DI void scan_unit(const Params& p, unsigned char* lds, int l, int mixer, int b, int hd, int item) {
    asm volatile("" : "+s"(l), "+s"(mixer), "+s"(b), "+s"(hd), "+s"(item));
    const int tid = ltid(), dir = tid >> 8, td = tid & 255, lane = tid & 63, wd = (tid >> 6) & 3, r32 = lane & 31, h = lane >> 5;
    unsigned char* L = lds + dir * 55296;
    bf16_t* QT = (bf16_t*)(L);
    bf16_t* KT = (bf16_t*)(L + 5120);
    bf16_t* KH = (bf16_t*)(L + 10240);
    bf16_t* ST = (bf16_t*)(L + 14848);
    bf16_t* VTt = (bf16_t*)(L + 19968);
    bf16_t* SC = (bf16_t*)(L + 29184);
    float* OL = (float*)(L + 19968);
    float* BB = (float*)(L + 38400);
    float* SEG = (float*)(L + 46592);
    float* BEND = (float*)(L + 47616);
    float* WG = (float*)(L + 47744);
    float* GT = (float*)(L + 49920);
    const bf16_t* PROJ = (const bf16_t*)(KWS + OFF_PA);
    bf16_t* CC = (bf16_t*)(KWS + OFF_HC);
    float* OTMP = (float*)(KWS + OFF_Y) + (size_t)item * 68 * 4096;
    const int qcol = (mixer == 0 ? 1184 : 1984) + 32 * hd, kcol = (mixer == 0 ? 1312 : 2112) + 32 * hd, ogcol = (mixer == 0 ? 1696 : 2496) + 64 * hd;
    const int ccol = 512 + 256 * mixer + 64 * hd;
    const bf16_t* VTb = (const bf16_t*)(KWS + OFF_VT) + ((size_t)(((mixer == 0 ? 2 : 3) * NB + b) * 4 + hd) * 64) * POSN;
    const float* og = (mixer == 0 ? KIN(I_GNORM) : KIN(I_RNORM)) + l * 64;
    float lg = 0.f;
    float ogr[16];
#pragma unroll
    for (int i = 0; i < 16; ++i) ogr[i] = og[16 * (td & 3) + i];
    float wg[16], wb = 0.f;
#pragma unroll
    for (int r = 0; r < 16; ++r) wg[r] = 0.f;
    if (mixer == 0) {
        const float* gw = KIN(I_GWG) + (size_t)((l * 2 + dir) * 16) * 128 + 32 * hd + (td & 31);
#pragma unroll
        for (int r = 0; r < 16; ++r) wg[r] = gw[r * 128];
        wb = KIN(I_GBG)[(l * 2 + dir) * 128 + 32 * hd + (td & 31)];
    } else lg = logsig_f(KIN(I_RDEC)[(l * 2 + dir) * 4 + hd]);
    for (int idx = td; idx < 64 * 40; idx += 256) ST[idx] = 0;
    f32x16 Sacc;
#pragma unroll
    for (int i = 0; i < 16; ++i) Sacc[i] = 0.f;
    u32x4 qreg, kreg, vreg0, vreg1, greg;
    auto chunk_of = [&](int s) { return dir == 0 ? s : (s < 4 ? 3 - s : 71 - s); };
    auto chunk_row0 = [&](int g) { return g < 4 ? ML + b * CTXL + 64 * g : b * SEQL + 64 * (g - 4); };
    auto gload = [&](int s) {
        const int g = chunk_of(s), row0 = chunk_row0(g);
        qreg = *(const u32x4*)(PROJ + (size_t)(row0 + (td >> 2)) * INWP + qcol + 8 * (td & 3));
        kreg = *(const u32x4*)(PROJ + (size_t)(row0 + (td >> 2)) * INWP + kcol + 8 * (td & 3));
        vreg0 = *(const u32x4*)(VTb + (size_t)(td >> 3) * POSN + 64 * g + 8 * (td & 7));
        vreg1 = *(const u32x4*)(VTb + (size_t)(32 + (td >> 3)) * POSN + 64 * g + 8 * (td & 7));
        if (mixer == 0 && td < 128) greg = *(const u32x4*)(PROJ + (size_t)(row0 + (td >> 1)) * INWP + 1952 + 16 * dir + 8 * (td & 1));
    };
    gload(0);
    __syncthreads();
    for (int s = 0; s < 68; ++s) {
        const int g = chunk_of(s), row0 = chunk_row0(g);
        *(u32x4*)(VTt + (td >> 3) * 72 + 8 * (td & 7)) = vreg0;
        *(u32x4*)(VTt + (32 + (td >> 3)) * 72 + 8 * (td & 7)) = vreg1;
        if (mixer == 0 && td < 128) { float* gp = GT + (td >> 1) * 16 + 8 * (td & 1);
            gp[0] = bflo(greg.x); gp[1] = bfhi(greg.x); gp[2] = bflo(greg.y); gp[3] = bfhi(greg.y); gp[4] = bflo(greg.z); gp[5] = bfhi(greg.z); gp[6] = bflo(greg.w); gp[7] = bfhi(greg.w); }
        const u32x4 qc = qreg, kc = kreg;
        if (s + 1 < 68) gload(s + 1);
        const int s_other = dir == 0 ? (g < 4 ? 3 - g : 71 - g) : g;
        const bool fin = s_other < s;
        float* ot = OTMP + (size_t)g * 4096 + (td >> 2) * 64 + 16 * (td & 3);
        f32x4 pf0, pf1, pf2, pf3; u32x4 g0, g1;
        LBAR();
        { const int d = td & 31, seg = td >> 5; float a[8];
          if (mixer == 0) {
#pragma unroll
              for (int i = 0; i < 8; ++i) { const float* gr = GT + (8 * seg + i) * 16;
                  const f32x4 x0 = *(const f32x4*)gr, x1 = *(const f32x4*)(gr + 4), x2 = *(const f32x4*)(gr + 8), x3 = *(const f32x4*)(gr + 12);
                  float acc = wb;
                  acc += x0[0] * wg[0]; acc += x0[1] * wg[1]; acc += x0[2] * wg[2]; acc += x0[3] * wg[3];
                  acc += x1[0] * wg[4]; acc += x1[1] * wg[5]; acc += x1[2] * wg[6]; acc += x1[3] * wg[7];
                  acc += x2[0] * wg[8]; acc += x2[1] * wg[9]; acc += x2[2] * wg[10]; acc += x2[3] * wg[11];
                  acc += x3[0] * wg[12]; acc += x3[1] * wg[13]; acc += x3[2] * wg[14]; acc += x3[3] * wg[15];
                  a[i] = logsig_f(acc) * (1.f / 16.f); }
          } else {
#pragma unroll
              for (int i = 0; i < 8; ++i) a[i] = lg;
          }
          float run = 0.f;
          if (dir == 0) {
#pragma unroll
              for (int i = 0; i < 8; ++i) { run += a[i]; a[i] = run; }
          } else {
#pragma unroll
              for (int i = 7; i >= 0; --i) { run += a[i]; a[i] = run; }
          }
          SEG[seg * 32 + d] = run;
          LBAR();
          float off = 0.f, tot = 0.f;
#pragma unroll
          for (int s2 = 0; s2 < 8; ++s2) { const float sv = SEG[s2 * 32 + d]; tot += sv; if (dir == 0 ? (s2 < seg) : (s2 > seg)) off += sv; }
#pragma unroll
          for (int i = 0; i < 8; ++i) BB[(8 * seg + i) * 32 + d] = a[i] + off;
          if (seg == 0) { BEND[d] = tot; BEND[32 + d] = __expf(tot); } }
        LBAR();
        { const int j = td >> 2, cc = td & 3;
          float qv[8] = {bflo(qc.x), bfhi(qc.x), bflo(qc.y), bfhi(qc.y), bflo(qc.z), bfhi(qc.z), bflo(qc.w), bfhi(qc.w)};
          float kv[8] = {bflo(kc.x), bfhi(kc.x), bflo(kc.y), bfhi(kc.y), bflo(kc.z), bfhi(kc.z), bflo(kc.w), bfhi(kc.w)};
          float k1[8];
#pragma unroll
          for (int i = 0; i < 8; ++i) { const int d = 8 * cc + i; const float bv = BB[j * 32 + d], ee = BEND[32 + d];
              const float eb = __expf(bv), en = __builtin_amdgcn_rcpf(eb); qv[i] *= eb; k1[i] = kv[i] * en; KH[d * 72 + ((j & ~12) | ((j & 4) << 1) | ((j & 8) >> 1))] = (bf16_t)f2bf(kv[i] * (ee * en)); }
          u32x4 wq, wk; wq.x = pk2(qv[0], qv[1]); wq.y = pk2(qv[2], qv[3]); wq.z = pk2(qv[4], qv[5]); wq.w = pk2(qv[6], qv[7]);
          wk.x = pk2(k1[0], k1[1]); wk.y = pk2(k1[2], k1[3]); wk.z = pk2(k1[4], k1[5]); wk.w = pk2(k1[6], k1[7]);
          *(u32x4*)(QT + j * 40 + 8 * cc) = wq; *(u32x4*)(KT + j * 40 + 8 * cc) = wk; }
        __syncthreads();
        if (fin) { pf0 = *(const f32x4*)(ot); pf1 = *(const f32x4*)(ot + 4); pf2 = *(const f32x4*)(ot + 8); pf3 = *(const f32x4*)(ot + 12);
            const bf16_t* gp = PROJ + (size_t)(row0 + (td >> 2)) * INWP + ogcol + 16 * (td & 3); g0 = *(const u32x4*)gp; g1 = *(const u32x4*)(gp + 8); }
        { const int jb = wd >> 1, ib = wd & 1; const bool skip = dir == 0 ? (jb > ib) : (jb < ib);
          f32x16 pa;
#pragma unroll
          for (int i = 0; i < 16; ++i) pa[i] = 0.f;
          if (!skip) {
#pragma unroll
              for (int s2 = 0; s2 < 2; ++s2) { const bf16x8 a = *(const bf16x8*)(KT + (32 * jb + r32) * 40 + 16 * s2 + 8 * h), bq = *(const bf16x8*)(QT + (32 * ib + r32) * 40 + 16 * s2 + 8 * h);
                  pa = MFMA32(a, bq, pa); }
          }
          const int itok = 32 * ib + r32;
#pragma unroll
          for (int gq = 0; gq < 4; ++gq) { f32x4 v;
#pragma unroll
              for (int i = 0; i < 4; ++i) { const int j = 32 * jb + 8 * gq + 4 * h + i; const bool keep = dir == 0 ? (j <= itok) : (j >= itok); v[i] = keep ? pa[4 * gq + i] : 0.f; }
              pg8::store4(SC + itok * 72 + 32 * jb + 16 * (gq >> 1) + 8 * h + 4 * (gq & 1), v); } }
        LBAR();
        f32x16 oacc;
        { const int eb = wd >> 1, ib = wd & 1;
#pragma unroll
          for (int i = 0; i < 16; ++i) oacc[i] = 0.f;
#pragma unroll
          for (int s2 = 0; s2 < 4; ++s2) { const bf16x8 a = *(const bf16x8*)(VTt + (32 * eb + r32) * 72 + 16 * s2 + 8 * h), bb = *(const bf16x8*)(SC + (32 * ib + r32) * 72 + 16 * s2 + 8 * h);
              oacc = MFMA32(a, bb, oacc); }
#pragma unroll
          for (int s2 = 0; s2 < 2; ++s2) { const bf16x8 a = *(const bf16x8*)(ST + (32 * eb + r32) * 40 + 16 * s2 + 8 * h), bb = *(const bf16x8*)(QT + (32 * ib + r32) * 40 + 16 * s2 + 8 * h);
              oacc = MFMA32(a, bb, oacc); }
          if (wd < 2) { const float dec = BEND[32 + r32];
#pragma unroll
              for (int i = 0; i < 16; ++i) Sacc[i] *= dec;
#pragma unroll
              for (int s2 = 0; s2 < 4; ++s2) { const bf16x8 a = *(const bf16x8*)(VTt + (32 * wd + r32) * 72 + 16 * s2 + 8 * h), bb = *(const bf16x8*)(KH + r32 * 72 + 16 * s2 + 8 * h);
                  Sacc = MFMA32(a, bb, Sacc); } } }
        LBAR();
        { const int eb = wd >> 1, ib = wd & 1;
#pragma unroll
          for (int gq = 0; gq < 4; ++gq) *(f32x4*)(OL + (32 * ib + r32) * 68 + 32 * eb + 8 * gq + 4 * h) = (f32x4){oacc[4 * gq], oacc[4 * gq + 1], oacc[4 * gq + 2], oacc[4 * gq + 3]};
          if (wd < 2) {
#pragma unroll
              for (int i = 0; i < 16; ++i) ST[(32 * wd + crow(i, h)) * 40 + r32] = (bf16_t)f2bf(Sacc[i]); } }
        LBAR();
        { const int j = td >> 2, e0 = 16 * (td & 3); float ov[16];
#pragma unroll
          for (int q4 = 0; q4 < 4; ++q4) { const f32x4 v = *(const f32x4*)(OL + j * 68 + e0 + 4 * q4); ov[4 * q4] = v[0]; ov[4 * q4 + 1] = v[1]; ov[4 * q4 + 2] = v[2]; ov[4 * q4 + 3] = v[3]; }
          if (fin) {
              float ss = 0.f;
              const float pv[16] = {pf0[0], pf0[1], pf0[2], pf0[3], pf1[0], pf1[1], pf1[2], pf1[3], pf2[0], pf2[1], pf2[2], pf2[3], pf3[0], pf3[1], pf3[2], pf3[3]};
#pragma unroll
              for (int i = 0; i < 16; ++i) { ov[i] += pv[i]; ss += ov[i] * ov[i]; }
              ss += __shfl_xor(ss, 1); ss += __shfl_xor(ss, 2);
              const float rn = rsqrtf(ss * (1.f / 64.f) + EPS);
              const int row = row0 + j;
              const float gv[16] = {bflo(g0.x), bfhi(g0.x), bflo(g0.y), bfhi(g0.y), bflo(g0.z), bfhi(g0.z), bflo(g0.w), bfhi(g0.w),
                                    bflo(g1.x), bfhi(g1.x), bflo(g1.y), bfhi(g1.y), bflo(g1.z), bfhi(g1.z), bflo(g1.w), bfhi(g1.w)};
              float r[16];
#pragma unroll
              for (int i = 0; i < 16; ++i) r[i] = ov[i] * rn * ogr[i] * silu_f(gv[i]);
              u32x4 w0, w1; w0.x = pk2(r[0], r[1]); w0.y = pk2(r[2], r[3]); w0.z = pk2(r[4], r[5]); w0.w = pk2(r[6], r[7]);
              w1.x = pk2(r[8], r[9]); w1.y = pk2(r[10], r[11]); w1.z = pk2(r[12], r[13]); w1.w = pk2(r[14], r[15]);
              *(u32x4*)(CC + (size_t)row * DM + ccol + e0) = w0; *(u32x4*)(CC + (size_t)row * DM + ccol + e0 + 8) = w1;
          } else {
#pragma unroll
              for (int q4 = 0; q4 < 4; ++q4) *(f32x4*)(ot + 4 * q4) = (f32x4){ov[4 * q4], ov[4 * q4 + 1], ov[4 * q4 + 2], ov[4 * q4 + 3]};
          } }
        LBAR();
    }
    __syncthreads();
}

DI void mixer_phase(const Params& p, unsigned char* lds, int l, int rep) {
    asm volatile("" : "+s"(l));
    const int tid = ltid();
    unsigned* ctr = (unsigned*)(KWS + OFF_CTL) + 64 * (l + 1 + 4 * rep);
    volatile int* s_item = (volatile int*)(lds + LDS_CTL_OFF);
    const bool with_ctx = l < NLAYER - 1;
    const int nitems = 64 + 1024 + (with_ctx ? 64 : 0);
    for (;;) {
        if (tid == 0) *s_item = (int)atomicAdd(ctr, 1u);
        __syncthreads();
        const int it = __builtin_amdgcn_readfirstlane(*s_item);
        __syncthreads();
        if (it >= nitems) break;
        if (rep > 0 && ((REP_MIX_ONLY == 1 && it >= 64) || (REP_MIX_ONLY == 2 && it < 64))) continue;
        if (it < 64) { if (PH(11)) scan_unit(p, lds, l, it >> 5, (it >> 2) & 7, it & 3, it); }
        else { int type, b, hd, qrow0, NT;
            if (it < 64 + 1024) { const int u = it - 64, rem = u & 511, qb = rem & 15; type = u >> 9; b = rem >> 6; hd = (rem >> 4) & 3; qrow0 = b * SEQL + 256 * qb; NT = POSN / 64; }
            else { const int u = it - 1088; type = u >> 5; b = (u >> 2) & 7; hd = u & 3; qrow0 = ML + b * CTXL; NT = CTXL / 64; }
            if (type == 0) { if (PH(12)) attn_unit<0>(p, lds, l, b, hd, qrow0, NT); } else { if (PH(13)) attn_unit<1>(p, lds, l, b, hd, qrow0, NT); } }
    }
}

#define LAS __attribute__((address_space(3)))
#define XB_TMO      128
#define XB_XCNT(j)  (256  + 64 * (j))
#define XB_XSUB(j)  (1280 + 64 * (j))
#define XB_XGEN(j)  (2304 + 64 * (j))
#define XB_TOP      3328
#define XB_TOPGEN   3392
#define XCD_BAR_WORDS 3456
#define XB_SPIN_CAP (1u << 18)

__device__ __forceinline__ unsigned xb_ld(unsigned* p)              { return __hip_atomic_load(p, __ATOMIC_RELAXED, __HIP_MEMORY_SCOPE_AGENT); }
__device__ __forceinline__ unsigned xb_add(unsigned* p, unsigned v) { return __hip_atomic_fetch_add(p, v, __ATOMIC_RELAXED, __HIP_MEMORY_SCOPE_AGENT); }
__device__ __forceinline__ unsigned xb_xcc_id() { return (unsigned)__builtin_amdgcn_s_getreg((3 << 11) | 20) & 0xFu; }
#define XB_SPIN(cond, bar) do { unsigned _sp = 0; while (cond) { __builtin_amdgcn_s_sleep(1); \
    if ((++_sp & 255u) == 0u) { if (xb_ld(&(bar)[XB_TMO])) break; if (_sp > XB_SPIN_CAP) { atomicAdd(&(bar)[XB_TMO], 1u); break; } } } } while (0)

struct XcdBarrier {
    unsigned* bar; unsigned x;
    volatile LAS unsigned* st;
};

__device__ __forceinline__ XcdBarrier xcd_barrier_post(unsigned* bar, volatile LAS unsigned* st) {
    XcdBarrier b; b.bar = bar; b.x = xb_xcc_id(); b.st = st;
    if (threadIdx.x == 0) (void)xb_add(&bar[XB_XCNT(b.x)], 1u);
    return b;
}
__device__ __forceinline__ void xcd_barrier_complete(unsigned* bar, unsigned x, unsigned& nloc, unsigned& nx) {
    const unsigned G = gridDim.x * gridDim.y * gridDim.z;
    unsigned sum, cnt, mine, sp = 0u;
    for (;;) {
        sum = 0u; cnt = 0u; mine = 0u;
#pragma unroll
        for (unsigned j = 0; j < 16; ++j) { const unsigned c = xb_ld(&bar[XB_XCNT(j)]); sum += c; cnt += (c > 0u) ? 1u : 0u; mine = (j == x) ? c : mine; }
        if (sum == G) break;
        __builtin_amdgcn_s_sleep(1);
        if ((++sp & 255u) == 0u) { if (xb_ld(&bar[XB_TMO])) break; if (sp > XB_SPIN_CAP) { atomicAdd(&bar[XB_TMO], 1u); break; } }
    }
    nloc = mine > 0u ? mine : 1u; nx = cnt > 0u ? cnt : 1u;
}

__device__ __forceinline__ void xcd_barrier(const XcdBarrier& b) {
    asm volatile("s_waitcnt vmcnt(0)" ::: "memory");
    __syncthreads();
    if (threadIdx.x == 0) {
        unsigned* bar = b.bar;
        __builtin_amdgcn_s_waitcnt(0);
        unsigned nloc = b.st[0], nx = b.st[1];
        if (nloc == 0u) { xcd_barrier_complete(bar, b.x, nloc, nx); b.st[0] = nloc; b.st[1] = nx; }
        const unsigned old = xb_add(&bar[XB_XSUB(b.x)], 1u);
        const unsigned gen = old / nloc;
        if (old + 1u == (gen + 1u) * nloc) {
            __builtin_amdgcn_fence(__ATOMIC_RELEASE, "agent");
            asm volatile("s_waitcnt vmcnt(0)" ::: "memory");
            const unsigned og = xb_add(&bar[XB_TOP], 1u);
            const unsigned tg = og / nx;
            if (og + 1u == (tg + 1u) * nx) xb_add(&bar[XB_TOPGEN], 1u);
            else XB_SPIN(xb_ld(&bar[XB_TOPGEN]) == tg, bar);
            __builtin_amdgcn_fence(__ATOMIC_ACQUIRE, "agent");
            xb_add(&bar[XB_XGEN(b.x)], 1u);
            asm volatile("s_waitcnt vmcnt(0)" ::: "memory");
        } else {
            XB_SPIN(xb_ld(&bar[XB_XGEN(b.x)]) == gen, bar);
            __builtin_amdgcn_fence(__ATOMIC_ACQUIRE, "agent");
            asm volatile("s_waitcnt vmcnt(0)" ::: "memory");
        }
    }
    __syncthreads();
}

template <class T> DI T* opq(T* q) { asm volatile("" : "+s"(q)); return q; }
__global__ void __launch_bounds__(512, 2) mega(Params p) {
    extern __shared__ __attribute__((aligned(16))) unsigned char lds[];
    cg::grid_group grid = cg::this_grid();
    { volatile LAS unsigned* z = (volatile LAS unsigned*)((LAS unsigned char*)lds + LDS_CTL_OFF); if (threadIdx.x < 16) z[threadIdx.x] = 0u; }
    __syncthreads();
#if USE_CG_SYNC
#define GSYNC() grid.sync()
#else
#define GSYNC() xcd_barrier(xbar)
#endif
    PG8_LAS unsigned char* lds3 = (PG8_LAS unsigned char*)lds;
    const int G = gridDim.x, c = blockIdx.x;
#define WSB(off) (opq(KWS) + (off))
#define WGT(off) ((bf16_t*)(opq(KWS) + OFF_W + (off)))

    if (PH(0)) phase0(p, lds);
    grid.sync();
    const XcdBarrier xbar = xcd_barrier_post((unsigned*)(KWS + OFF_BAR), (volatile LAS unsigned*)((LAS unsigned char*)lds + LDS_CTL_OFF + 32));
#pragma unroll 1
    for (int l = 0; l < NLAYER; ++l) {
        const bool with_ctx = l < NLAYER - 1;
        const int Mrows = with_ctx ? MT : ML;
        if (PH(1)) {
            const float* ng = opq(KIN(I_NORMG)) + (size_t)l * 4 * DM; const float* MODS = (const float*)WSB(OFF_MODS); const float* ml = MODS + (size_t)l * 9 * 6144;
            bf16_t* HC = (bf16_t*)WSB(OFF_HC); float* XC = (float*)WSB(OFF_XCTX); float* outp = opq(KOUT);
            if (l == 0) rowpass(0, MT, c, G, KIN(I_X), KIN(I_CTX), nullptr, nullptr, nullptr, nullptr, nullptr, HC, ng, ml, ml + 1024);
            else {
                if (c < 32) { pg8::Gemm g{(const bf16_t*)WSB(OFF_PA) + (size_t)ML * FFH, WGT(W_F2), MC, DM, FFH, FFH}; pg8::StaticOrder S; S.init(MC, DM, G, c);
                    pg8::EpiY E{(bf16_t*)WSB(OFF_Y) + (size_t)ML * DM, DM};
                    pg8::gemm_phase<pg8::EpiY, pg8::StaticOrder, true, true>(lds3, g, S, E); }
                else { rowpass(0, ML, c - 32, G - 32, outp, XC, outp, XC, (const bf16_t*)WSB(OFF_Y), MODS + (size_t)(l - 1) * 9 * 6144 + 5 * 1024, ng - DM, HC, ng, ml, ml + 1024);
                    if (PH(2)) convert_weights(p, l, lds, 1, c - 32, G - 32); }
                GSYNC();
                rowpass(ML, MT, c, G, outp, XC, outp, XC, (const bf16_t*)WSB(OFF_Y), MODS + (size_t)(l - 1) * 9 * 6144 + 5 * 1024, ng - DM, HC, ng, ml, ml + 1024);
            }
        }
        for (int rep = 0; rep < REP_CONV; ++rep) { if (PH(2)) convert_weights(p, l, lds, l == 0 ? 3 : 2, c, G); }
        for (int rep = 0; rep < REP_RP0; ++rep) { const float* ng = opq(KIN(I_NORMG)); const float* ml = (const float*)WSB(OFF_MODS); rowpass(0, MT, c, G, KIN(I_X), KIN(I_CTX), nullptr, nullptr, nullptr, nullptr, nullptr, (bf16_t*)WSB(OFF_Y), ng, ml, ml + 1024); }
        GSYNC();
        for (int rep = 0; rep < REP_SYNC; ++rep) GSYNC();
        for (int rep = 0; rep < REP_G3; ++rep) { if (rep) GSYNC();
        if (PH(3)) { pg8::Gemm g{(const bf16_t*)WSB(OFF_HC), WGT(W_IN), MT, INWP, DM, DM}; pg8::StaticOrder S; S.init(MT, INWP, G, c);
          const float* rc = (const float*)WSB(OFF_ROPE);
          pg8::EpiProj E{(bf16_t*)WSB(OFF_PA), (bf16_t*)WSB(OFF_VT), (float*)WSB(OFF_STQ), (float*)WSB(OFF_STKV), rc, rc + 4096 * 16, lds + LDS_CTL_OFF + 256};
          pg8::gemm_phase<pg8::EpiProj, pg8::StaticOrder, true, true>(lds3, g, S, E); } }
        GSYNC();
        for (int rep = 0; rep < REP_C; ++rep) {
        if (PH(4)) { int Kq = 256; asm volatile("" : "+s"(Kq)); pg8::Gemm g{(const bf16_t*)WSB(OFF_PA) + 768, WGT(W_UQ), MT, 512, Kq, INWP}; pg8::StaticOrder S; S.init(MT, 512, G, c);
          const float* rc = (const float*)WSB(OFF_ROPE);
          pg8::EpiUpQ E{(bf16_t*)WSB(OFF_MLAQ), (const float*)WSB(OFF_STQ), rc, rc + 4096 * 16};
          pg8::gemm_phase<pg8::EpiUpQ, pg8::StaticOrder, true, true>(lds3, g, S, E); }
        if (PH(5)) { int Kq = 128; asm volatile("" : "+s"(Kq)); pg8::Gemm g{(const bf16_t*)WSB(OFF_PA) + 1024, WGT(W_UKV), MT, 512, Kq, INWP}; pg8::StaticOrder S; S.init(MT, 512, G, (c + G / 2) % G);
          pg8::EpiUpKV E{(bf16_t*)WSB(OFF_MLAK), (bf16_t*)WSB(OFF_VT), (const float*)WSB(OFF_STKV), lds + LDS_CTL_OFF + 256};
          pg8::gemm_phase<pg8::EpiUpKV, pg8::StaticOrder, true, true>(lds3, g, S, E); }
        GSYNC(); }
        for (int rep = 0; rep < REP_MIX; ++rep) { if (PH(6)) mixer_phase(p, lds, l, rep); GSYNC(); }
        for (int rep = 0; rep < REP_G7; ++rep) { if (rep) GSYNC();
        if (PH(7)) { pg8::Gemm g{(const bf16_t*)WSB(OFF_HC), WGT(W_OUT), Mrows, DM, DM, DM}; pg8::StaticOrder S; S.init(Mrows, DM, G, c);
          pg8::EpiY E{(bf16_t*)WSB(OFF_Y), DM};
          pg8::gemm_phase<pg8::EpiY, pg8::StaticOrder, true, true>(lds3, g, S, E); } }
        GSYNC();
        if (PH(8)) {
            const float* ng = opq(KIN(I_NORMG)) + (size_t)l * 4 * DM; const float* ml = (const float*)WSB(OFF_MODS) + (size_t)l * 9 * 6144;
            float* XC = (float*)WSB(OFF_XCTX); float* outp = opq(KOUT);
            rowpass(0, Mrows, c, G, l == 0 ? KIN(I_X) : outp, l == 0 ? KIN(I_CTX) : XC, outp, XC, (const bf16_t*)WSB(OFF_Y), ml + 2 * 1024, ng + DM, (bf16_t*)WSB(OFF_HC), ng + 2 * DM, ml + 3 * 1024, ml + 4 * 1024);
        }
        GSYNC();
        for (int rep = 0; rep < REP_G9; ++rep) { if (rep) GSYNC();
        if (PH(9)) { pg8::Gemm g{(const bf16_t*)WSB(OFF_HC), WGT(W_F1), Mrows, 2 * FFH, DM, DM}; pg8::StaticOrder S; S.init(Mrows, 2 * FFH, G, c);
          pg8::EpiSwiglu E{(bf16_t*)WSB(OFF_PA)};
          pg8::gemm_phase<pg8::EpiSwiglu, pg8::StaticOrder, true, true>(lds3, g, S, E); } }
        GSYNC();
        for (int rep = 0; rep < REP_G10; ++rep) { if (rep) GSYNC();
        if (PH(10)) { pg8::Gemm g{(const bf16_t*)WSB(OFF_PA), WGT(W_F2), ML, DM, FFH, FFH}; pg8::StaticOrder S; S.init(ML, DM, G, c);
          pg8::EpiY E{(bf16_t*)WSB(OFF_Y), DM};
          pg8::gemm_phase<pg8::EpiY, pg8::StaticOrder, true, true>(lds3, g, S, E); } }
        GSYNC();
    }
    { float* XC = (float*)WSB(OFF_XCTX); float* outp = opq(KOUT);
      rowpass(0, ML, c, G, outp, XC, outp, XC, (const bf16_t*)WSB(OFF_Y), (const float*)WSB(OFF_MODS) + (size_t)3 * 9 * 6144 + 5 * 1024, KIN(I_NORMG) + (size_t)3 * 4 * DM + 3 * DM, nullptr, nullptr, nullptr, nullptr); }
}

extern "C" void kernel_launch(void* const* d_in, const int* in_sizes, int n_in, void* d_out, int out_size, void* d_ws, size_t ws_size, hipStream_t stream) {
    static int grid_blocks = 0;
    if (!grid_blocks) {
        if (n_in != 22 || ws_size < WS_END2) { fprintf(stderr, "kernel_launch: unexpected n_in %d or ws_size %zu (need %zu)\n", n_in, ws_size, (size_t)WS_END2); grid_blocks = -1; return; }
        int dev = 0, cus = 0, per_cu = 0;
        (void)hipGetDevice(&dev);
        (void)hipDeviceGetAttribute(&cus, hipDeviceAttributeMultiprocessorCount, dev);
        (void)hipFuncSetAttribute((const void*)mega, hipFuncAttributeMaxDynamicSharedMemorySize, LDS_BYTES);
        (void)hipOccupancyMaxActiveBlocksPerMultiprocessor(&per_cu, (const void*)mega, 512, LDS_BYTES);
        if (per_cu < 1) per_cu = 1;
        grid_blocks = cus * per_cu;
    }
    if (grid_blocks < 0) return;
    Params p{};
    for (int i = 0; i < 22; ++i) p.in[i] = (const float*)d_in[i];
    p.out = (float*)d_out; p.ws = (unsigned char*)d_ws;
    void* args[] = {&p};
    hipError_t e = hipLaunchCooperativeKernel((const void*)mega, dim3(grid_blocks), dim3(512), args, LDS_BYTES, stream);
    if (e != hipSuccess) fprintf(stderr, "cooperative launch failed: %s (grid %d)\n", hipGetErrorString(e), grid_blocks);
}
```
